# Optimizing an MI355X kernel written in HIP

```python
import math
import jax
import jax.numpy as jnp
from jax import lax
import numpy as np

D_MODEL = 1024
BATCH = 8
SEQ = 2048
DEPTH = 4
DEC_BATCH = 128
DEC_SEQ = 1
PAST_LEN = 16384
PAGE_SIZE = 128

N_META = 16
N_MIXERS = 4
CHUNK = 16
NORM_EPS = 1e-6
LN_EPS = 1e-5

A_DK = 128
A_DV = 128
A_HEADS = D_MODEL // A_DK
A_W = A_HEADS * A_DK
A_VW = A_HEADS * A_DV
B_DK = 128
B_DV = 128
B_HEADS = D_MODEL // B_DK
B_W = B_HEADS * B_DK
B_VW = B_HEADS * B_DV
B_CONV = 2 * B_W + B_VW
CONV_W = 4
C_DK = 128
C_DV = 128
C_HEADS = D_MODEL // C_DV
C_W = C_HEADS * C_DK
C_VW = C_HEADS * C_DV
D_HEADS = 4
D_DK = D_MODEL // (2 * D_HEADS)
D_DV = D_MODEL // D_HEADS
D_W = D_HEADS * D_DK
D_VW = D_HEADS * D_DV
D_GATE_RANK = 16
D_GATE_NORM = 16.0
PEER_HEADS = 8
PEER_NKEYS = 128
PEER_EXPERTS = PEER_NKEYS * PEER_NKEYS
PEER_DQ = 256
PEER_TOPK = 16
PEER_BLOCK = 128
DN_ALPHA = (2 * DEPTH) ** 0.25
DN_BETA = (8 * DEPTH) ** -0.25
N_OCC_A = (DEPTH + 3) // 4
N_OCC_B = (DEPTH + 2) // 4
N_OCC_C = (DEPTH + 1) // 4
N_OCC_D = DEPTH // 4

kernel_name = 'hybrid_hgrn2_gdn_mlstm_gla_peer_decode_step'


def _split(x, sizes):
    return jnp.split(x, [int(c) for c in np.cumsum(sizes)[:-1]], axis=-1)


def _layernorm(x, g, b):
    xf = x.astype(jnp.float32)
    xc = xf - jnp.mean(xf, -1, keepdims=True)
    var = jnp.mean(xc * xc, -1, keepdims=True)
    return (xc * lax.rsqrt(var + LN_EPS) * g.astype(jnp.float32) + b.astype(jnp.float32)).astype(x.dtype)


def _rmsnorm(x, g):
    return x * lax.rsqrt(jnp.mean(x * x, -1, keepdims=True) + NORM_EPS) * g


def _headnorm(x, g):
    xc = x - jnp.mean(x, -1, keepdims=True)
    return xc * lax.rsqrt(jnp.mean(xc * xc, -1, keepdims=True) + NORM_EPS) * g


def _l2norm(x):
    return x * lax.rsqrt(jnp.sum(x * x, -1, keepdims=True) + NORM_EPS)


def _masks():
    idx = jnp.arange(CHUNK)
    return idx[:, None] >= idx[None, :], idx[:, None] > idx[None, :]


def _chunk(t, pad_val=0.0):
    T = t.shape[1]
    pad = (-T) % CHUNK
    t = jnp.pad(t, [(0, 0), (0, pad)] + [(0, 0)] * (t.ndim - 2), constant_values=pad_val)
    t = t.reshape((t.shape[0], -1, CHUNK) + t.shape[2:])
    return jnp.moveaxis(t, 1, 0)


def _unchunk(t, T):
    t = jnp.moveaxis(t, 0, 1)
    return t.reshape((t.shape[0], -1) + t.shape[3:])[:, :T]


def _gla_scan(q, k, v, logf, s0):
    T = q.shape[1]
    incl, _ = _masks()

    def step(s, xs):
        q_, k_, v_, g_ = xs
        b = jnp.cumsum(g_, axis=1)
        diff = b[:, :, None] - b[:, None, :]
        decay = jnp.exp(jnp.where(incl[None, :, :, None, None], diff, -jnp.inf))
        att = jnp.einsum('bthk,bshk,btshk->btsh', q_, k_, decay)
        o = jnp.einsum('btsh,bshv->bthv', att, v_) + jnp.einsum('bthk,bhkv->bthv', q_ * jnp.exp(b), s)
        b_end = b[:, -1]
        s = s * jnp.exp(b_end)[..., None] + jnp.einsum('bshk,bshv->bhkv', k_ * jnp.exp(b_end[:, None] - b), v_)
        return s, o

    s, o = lax.scan(step, s0, (_chunk(q), _chunk(k), _chunk(v), _chunk(logf)))
    return _unchunk(o, T), s


def _gdn_scan(q, k, v, log_a, beta, s0):
    T = q.shape[1]
    incl, strict = _masks()
    eye = jnp.eye(CHUNK, dtype=jnp.float32)

    def step(s, xs):
        q_, k_, v_, g_, beta_ = xs
        b = jnp.cumsum(g_, axis=1)
        diff = b[:, :, None] - b[:, None, :]
        decay = jnp.moveaxis(jnp.exp(jnp.where(incl[None, :, :, None], diff, -jnp.inf)), 3, 1)
        beta_h = jnp.moveaxis(beta_, 2, 1)
        b_h = jnp.moveaxis(b, 2, 1)
        kk = jnp.einsum('bthk,bshk->bhts', k_, k_)
        lhs = eye + jnp.where(strict, kk * decay * beta_h[..., :, None], 0.0)
        rhs = jnp.concatenate([beta_h[..., None] * jnp.moveaxis(v_, 2, 1),
                               (beta_h * jnp.exp(b_h))[..., None] * jnp.moveaxis(k_, 2, 1)], axis=-1)
        sol = lax.linalg.triangular_solve(lhs, rhs, left_side=True, lower=True, unit_diagonal=True)
        u, wk = sol[..., :v_.shape[-1]], sol[..., v_.shape[-1]:]
        v_new = u - jnp.einsum('bhck,bhkv->bhcv', wk, s)
        att = jnp.einsum('bthk,bshk->bhts', q_, k_) * decay
        o = jnp.einsum('bhts,bhsv->bthv', att, v_new) + jnp.einsum('bthk,bhkv->bthv', q_ * jnp.exp(b)[..., None], s)
        b_end = b[:, -1]
        s = s * jnp.exp(b_end)[..., None, None] + jnp.einsum(
            'bshk,bhsv->bhkv', k_ * jnp.exp(b_end[:, None] - b)[..., None], v_new)
        return s, o

    s, o = lax.scan(step, s0, (_chunk(q), _chunk(k), _chunk(v), _chunk(log_a), _chunk(beta)))
    return _unchunk(o, T), s


def _mlstm_scan(q, k, v, log_i, log_f, c0, n0, m0):
    T = q.shape[1]
    incl, _ = _masks()

    def step(carry, xs):
        c, n, m = carry
        q_, k_, v_, li, lf = xs
        b = jnp.cumsum(lf, axis=1)
        dmat = jnp.where(incl[None, :, :, None], b[:, :, None] - b[:, None, :] + li[:, None, :], -jnp.inf)
        m_inter = b + m[:, None]
        m_t = jnp.maximum(m_inter, jnp.max(dmat, axis=2))
        wts = jnp.exp(dmat - m_t[:, :, None])
        a_int = jnp.exp(m_inter - m_t)
        qk = jnp.einsum('bthk,bshk->btsh', q_, k_) * wts
        num = jnp.einsum('btsh,bshv->bthv', qk, v_) + a_int[..., None] * jnp.einsum('bthk,bhkv->bthv', q_, c)
        den = jnp.sum(qk, axis=2) + a_int * jnp.einsum('bthk,bhk->bth', q_, n)
        h = num / jnp.maximum(jnp.abs(den), jnp.exp(-m_t))[..., None]
        w_end = wts[:, -1]
        a_end = a_int[:, -1]
        c = a_end[..., None, None] * c + jnp.einsum('bsh,bshk,bshv->bhkv', w_end, k_, v_)
        n = a_end[..., None] * n + jnp.einsum('bsh,bshk->bhk', w_end, k_)
        return (c, n, m_t[:, -1]), h

    (c, n, m), h = lax.scan(step, (c0, n0, m0),
                            (_chunk(q), _chunk(k), _chunk(v), _chunk(log_i, -jnp.inf), _chunk(log_f)))
    return _unchunk(h, T), c, n, m


def _causal_conv(x, buf, w):
    T = x.shape[1]
    full = jnp.concatenate([buf.astype(x.dtype), x], axis=1)
    y = full[:, 0:T] * w[0]
    for j in range(1, CONV_W):
        y = y + full[:, j:j + T] * w[j]
    return y, full[:, T:]


def _hgrn2(x, w_in, lb, norm_g, w_out, s0):
    bsz, T, _ = x.shape
    q, f, i, g = _split(x @ w_in, [A_W, A_W, A_VW, A_VW])
    q = jax.nn.silu(q.astype(jnp.float32)).reshape(bsz, T, A_HEADS, A_DK)
    fg = lb + (1.0 - lb) * jax.nn.sigmoid(f.astype(jnp.float32))
    k = (1.0 - fg).reshape(bsz, T, A_HEADS, A_DK)
    logf = jnp.log(fg).reshape(bsz, T, A_HEADS, A_DK)
    v = i.astype(jnp.float32).reshape(bsz, T, A_HEADS, A_DV)
    o, s = _gla_scan(q, k, v, logf, s0.astype(jnp.float32))
    gate = jax.nn.silu(g.astype(jnp.float32)).reshape(bsz, T, A_HEADS, A_DV)
    o = (_rmsnorm(o, norm_g.astype(jnp.float32)) * gate).reshape(bsz, T, A_VW).astype(x.dtype)
    return o @ w_out, s.astype(s0.dtype)


def _gated_deltanet(x, w_in, conv_w, a_log, dt_bias, norm_g, w_out, s0, conv0):
    bsz, T, _ = x.shape
    qkv, a, b, g = _split(x @ w_in, [B_CONV, B_HEADS, B_HEADS, B_VW])
    qkv, conv_new = _causal_conv(qkv, conv0, conv_w)
    q, k, v = _split(jax.nn.silu(qkv.astype(jnp.float32)), [B_W, B_W, B_VW])
    q = _l2norm(q.reshape(bsz, T, B_HEADS, B_DK)) * B_DK ** -0.5
    k = _l2norm(k.reshape(bsz, T, B_HEADS, B_DK))
    v = v.reshape(bsz, T, B_HEADS, B_DV)
    log_a = -jnp.exp(a_log.astype(jnp.float32)) * jax.nn.softplus(a.astype(jnp.float32) + dt_bias.astype(jnp.float32))
    beta = jax.nn.sigmoid(b.astype(jnp.float32))
    o, s = _gdn_scan(q, k, v, log_a, beta, s0.astype(jnp.float32))
    gate = jax.nn.silu(g.astype(jnp.float32)).reshape(bsz, T, B_HEADS, B_DV)
    o = (_rmsnorm(o, norm_g.astype(jnp.float32)) * gate).reshape(bsz, T, B_VW).astype(x.dtype)
    return o @ w_out, s.astype(s0.dtype), conv_new.astype(conv0.dtype)


def _mlstm(x, w_in, b_i, b_f, norm_g, w_out, c0, n0, m0):
    bsz, T, _ = x.shape
    q, k, v, i, f, o = _split(x @ w_in, [C_W, C_W, C_VW, C_HEADS, C_HEADS, C_VW])
    q = q.astype(jnp.float32).reshape(bsz, T, C_HEADS, C_DK)
    k = k.astype(jnp.float32).reshape(bsz, T, C_HEADS, C_DK) * C_DK ** -0.5
    v = v.astype(jnp.float32).reshape(bsz, T, C_HEADS, C_DV)
    log_i = i.astype(jnp.float32) + b_i.astype(jnp.float32)
    log_f = jax.nn.log_sigmoid(f.astype(jnp.float32) + b_f.astype(jnp.float32))
    h, c, n, m = _mlstm_scan(q, k, v, log_i, log_f, c0.astype(jnp.float32), n0.astype(jnp.float32),
                             m0.astype(jnp.float32))
    h = _headnorm(h, norm_g.astype(jnp.float32).reshape(C_HEADS, C_DV))
    og = jax.nn.sigmoid(o.astype(jnp.float32)).reshape(bsz, T, C_HEADS, C_DV)
    y = (og * h).reshape(bsz, T, C_VW).astype(x.dtype) @ w_out
    return y, c.astype(c0.dtype), n.astype(n0.dtype), m.astype(m0.dtype)


def _gla(x, w_in, w_gate, b_gate, norm_g, w_out, s0):
    bsz, T, _ = x.shape
    q, k, v, g, r = _split(x @ w_in, [D_W, D_W, D_VW, D_VW, D_GATE_RANK])
    q = q.astype(jnp.float32).reshape(bsz, T, D_HEADS, D_DK) * D_DK ** -0.5
    k = k.astype(jnp.float32).reshape(bsz, T, D_HEADS, D_DK)
    v = v.astype(jnp.float32).reshape(bsz, T, D_HEADS, D_DV)
    logf = (jax.nn.log_sigmoid((r @ w_gate + b_gate).astype(jnp.float32)) / D_GATE_NORM).reshape(bsz, T, D_HEADS, D_DK)
    o, s = _gla_scan(q, k, v, logf, s0.astype(jnp.float32))
    gate = jax.nn.silu(g.astype(jnp.float32)).reshape(bsz, T, D_HEADS, D_DV)
    o = (_rmsnorm(o, norm_g.astype(jnp.float32)) * gate).reshape(bsz, T, D_VW).astype(x.dtype)
    return o @ w_out, s.astype(s0.dtype)


def _peer(x, w_q, keys1, keys2, u, v):
    n, d = x.shape
    pad = (-n) % PEER_BLOCK
    xb = jnp.pad(x, ((0, pad), (0, 0))).reshape(-1, PEER_BLOCK, d)
    half = PEER_DQ // 2
    k1 = keys1.astype(jnp.float32)
    k2 = keys2.astype(jnp.float32)

    def block(xt):
        q = (xt @ w_q).astype(jnp.float32).reshape(PEER_BLOCK, PEER_HEADS, 2, half)
        s1 = jnp.einsum('thd,kd->thk', q[:, :, 0], k1)
        s2 = jnp.einsum('thd,kd->thk', q[:, :, 1], k2)
        v1, i1 = lax.top_k(s1, PEER_TOPK)
        v2, i2 = lax.top_k(s2, PEER_TOPK)
        cand = (v1[..., :, None] + v2[..., None, :]).reshape(PEER_BLOCK, PEER_HEADS, PEER_TOPK * PEER_TOPK)
        cidx = (i1[..., :, None] * PEER_NKEYS + i2[..., None, :]).reshape(PEER_BLOCK, PEER_HEADS, PEER_TOPK * PEER_TOPK)
        top, pos = lax.top_k(cand, PEER_TOPK)
        eidx = jnp.take_along_axis(cidx, pos, axis=-1)
        gsm = jax.nn.softmax(top, axis=-1)
        act = jax.nn.gelu(jnp.einsum('thkd,td->thk', u[eidx], xt).astype(jnp.float32), approximate=False)
        return jnp.einsum('thk,thkd->td', (gsm * act).astype(xt.dtype), v[eidx])

    return lax.map(block, xb).reshape(-1, d)[:n]


def _trunk(h, st, w):
    bsz, T, _ = h.shape
    lb_all = jnp.cumsum(jax.nn.softmax(w['hgrn_lb'].astype(jnp.float32), axis=0), axis=0)
    new = {'hgrn_S': [], 'gdn_S': [], 'gdn_conv': [], 'mlstm_C': [], 'mlstm_n': [], 'mlstm_m': [], 'gla_S': []}
    for i in range(DEPTH):
        mix, j = i % N_MIXERS, i // N_MIXERS
        if mix == 0:
            y, s = _hgrn2(h, w['hgrn_w_in'][j], lb_all[i], w['hgrn_norm_g'][j], w['hgrn_w_out'][j], st['hgrn_S'][j])
            new['hgrn_S'].append(s)
        elif mix == 1:
            y, s, cv = _gated_deltanet(h, w['gdn_w_in'][j], w['gdn_conv_w'][j], w['gdn_a_log'][j], w['gdn_dt_bias'][j],
                                       w['gdn_norm_g'][j], w['gdn_w_out'][j], st['gdn_S'][j], st['gdn_conv'][j])
            new['gdn_S'].append(s)
            new['gdn_conv'].append(cv)
        elif mix == 2:
            y, c, nn_, m = _mlstm(h, w['mlstm_w_in'][j], w['mlstm_b_i'][j], w['mlstm_b_f'][j], w['mlstm_norm_g'][j],
                                  w['mlstm_w_out'][j], st['mlstm_C'][j], st['mlstm_n'][j], st['mlstm_m'][j])
            new['mlstm_C'].append(c)
            new['mlstm_n'].append(nn_)
            new['mlstm_m'].append(m)
        else:
            y, s = _gla(h, w['gla_w_in'][j], w['gla_w_gate'][j], w['gla_b_gate'][j], w['gla_norm_g'][j],
                        w['gla_w_out'][j], st['gla_S'][j])
            new['gla_S'].append(s)
        h = _layernorm(DN_ALPHA * h + y, w['ln_g'][i, 0], w['ln_b'][i, 0])
        f = _peer(h.reshape(bsz * T, D_MODEL), w['peer_w_q'][i], w['peer_keys1'][i], w['peer_keys2'][i],
                  w['peer_u'][i], w['peer_v'][i]).reshape(bsz, T, D_MODEL)
        h = _layernorm(DN_ALPHA * h + f, w['ln_g'][i, 1], w['ln_b'][i, 1])
    return h, {name: jnp.stack(vals) for name, vals in new.items()}


def setup_inputs(seed: int = 0) -> dict:
    key = jax.random.key(seed)
    ks = jax.random.split(key, 48)

    def nrm(i, shape, scale):
        return scale * jax.random.normal(ks[i], shape, jnp.float32)

    def gain(i, shape):
        return 1.0 + nrm(i, shape, 0.01)

    dt = jnp.exp(jax.random.uniform(ks[13], (N_OCC_B, B_HEADS), jnp.float32,
                                    math.log(1e-3), math.log(1e-1)))
    return {
        'x_prompt': nrm(0, (BATCH, SEQ, D_MODEL), 1.0),
        'x_sample': nrm(1, (DEC_BATCH, DEC_SEQ, D_MODEL), 1.0),
        'state_hgrn_S': nrm(2, (N_OCC_A, DEC_BATCH, A_HEADS, A_DK, A_DV), 0.5),
        'state_gdn_S': nrm(3, (N_OCC_B, DEC_BATCH, B_HEADS, B_DK, B_DV), 0.1),
        'state_gdn_conv': nrm(4, (N_OCC_B, DEC_BATCH, CONV_W - 1, B_CONV), 1.0),
        'state_mlstm_C': nrm(5, (N_OCC_C, DEC_BATCH, C_HEADS, C_DK, C_DV), 0.3),
        'state_mlstm_n': nrm(6, (N_OCC_C, DEC_BATCH, C_HEADS, C_DK), 0.3),
        'state_mlstm_m': nrm(7, (N_OCC_C, DEC_BATCH, C_HEADS), 1.0),
        'state_gla_S': nrm(8, (N_OCC_D, DEC_BATCH, D_HEADS, D_DK, D_DV), 0.3),
        'meta_tokens': nrm(9, (N_META, D_MODEL), 1.0),
        'hgrn_w_in': nrm(10, (N_OCC_A, D_MODEL, 2 * A_W + 2 * A_VW), D_MODEL ** -0.5),
        'hgrn_lb': nrm(11, (DEPTH + 1, A_W), 0.1),
        'hgrn_norm_g': gain(12, (N_OCC_A, A_DV)),
        'hgrn_w_out': nrm(14, (N_OCC_A, A_VW, D_MODEL), DN_BETA * A_VW ** -0.5),
        'gdn_w_in': nrm(15, (N_OCC_B, D_MODEL, B_CONV + 2 * B_HEADS + B_VW), D_MODEL ** -0.5),
        'gdn_conv_w': nrm(16, (N_OCC_B, CONV_W, B_CONV), CONV_W ** -0.5),
        'gdn_a_log': jnp.log(jax.random.uniform(ks[17], (N_OCC_B, B_HEADS), jnp.float32, 1.0, 16.0)),
        'gdn_dt_bias': dt + jnp.log(-jnp.expm1(-dt)),
        'gdn_norm_g': gain(18, (N_OCC_B, B_DV)),
        'gdn_w_out': nrm(19, (N_OCC_B, B_VW, D_MODEL), DN_BETA * B_VW ** -0.5),
        'mlstm_w_in': nrm(20, (N_OCC_C, D_MODEL, 2 * C_W + 2 * C_VW + 2 * C_HEADS), D_MODEL ** -0.5),
        'mlstm_b_i': nrm(21, (N_OCC_C, C_HEADS), 0.1),
        'mlstm_b_f': jnp.linspace(3.0, 6.0, C_HEADS, dtype=jnp.float32)[None] + nrm(22, (N_OCC_C, C_HEADS), 0.1),
        'mlstm_norm_g': gain(23, (N_OCC_C, C_VW)),
        'mlstm_w_out': nrm(24, (N_OCC_C, C_VW, D_MODEL), DN_BETA * C_VW ** -0.5),
        'gla_w_in': nrm(25, (N_OCC_D, D_MODEL, 2 * D_W + 2 * D_VW + D_GATE_RANK), D_MODEL ** -0.5),
        'gla_w_gate': nrm(26, (N_OCC_D, D_GATE_RANK, D_W), D_GATE_RANK ** -0.5),
        'gla_b_gate': nrm(27, (N_OCC_D, D_W), 0.01),
        'gla_norm_g': gain(28, (N_OCC_D, D_DV)),
        'gla_w_out': nrm(29, (N_OCC_D, D_VW, D_MODEL), DN_BETA * D_VW ** -0.5),
        'peer_w_q': nrm(30, (DEPTH, D_MODEL, PEER_HEADS * PEER_DQ), D_MODEL ** -0.5),
        'peer_keys1': nrm(31, (DEPTH, PEER_NKEYS, PEER_DQ // 2), (PEER_DQ // 2) ** -0.5),
        'peer_keys2': nrm(32, (DEPTH, PEER_NKEYS, PEER_DQ // 2), (PEER_DQ // 2) ** -0.5),
        'peer_u': nrm(33, (DEPTH, PEER_EXPERTS, D_MODEL), D_MODEL ** -0.5),
        'peer_v': nrm(34, (DEPTH, PEER_EXPERTS, D_MODEL), DN_BETA * PEER_HEADS ** -0.5),
        'ln_g': gain(35, (DEPTH, 2, D_MODEL)),
        'ln_b': nrm(36, (DEPTH, 2, D_MODEL), 0.01),
    }


def reference(x_prompt, x_sample, state_hgrn_S, state_gdn_S, state_gdn_conv, state_mlstm_C, state_mlstm_n,
              state_mlstm_m, state_gla_S, meta_tokens, hgrn_w_in, hgrn_lb, hgrn_norm_g, hgrn_w_out,
              gdn_w_in, gdn_conv_w, gdn_a_log, gdn_dt_bias, gdn_norm_g, gdn_w_out,
              mlstm_w_in, mlstm_b_i, mlstm_b_f, mlstm_norm_g, mlstm_w_out,
              gla_w_in, gla_w_gate, gla_b_gate, gla_norm_g, gla_w_out,
              peer_w_q, peer_keys1, peer_keys2, peer_u, peer_v, ln_g, ln_b):
    w = dict(hgrn_w_in=hgrn_w_in, hgrn_lb=hgrn_lb, hgrn_norm_g=hgrn_norm_g, hgrn_w_out=hgrn_w_out,
             gdn_w_in=gdn_w_in, gdn_conv_w=gdn_conv_w, gdn_a_log=gdn_a_log, gdn_dt_bias=gdn_dt_bias,
             gdn_norm_g=gdn_norm_g, gdn_w_out=gdn_w_out,
             mlstm_w_in=mlstm_w_in, mlstm_b_i=mlstm_b_i, mlstm_b_f=mlstm_b_f, mlstm_norm_g=mlstm_norm_g,
             mlstm_w_out=mlstm_w_out,
             gla_w_in=gla_w_in, gla_w_gate=gla_w_gate, gla_b_gate=gla_b_gate, gla_norm_g=gla_norm_g,
             gla_w_out=gla_w_out,
             peer_w_q=peer_w_q, peer_keys1=peer_keys1, peer_keys2=peer_keys2, peer_u=peer_u, peer_v=peer_v,
             ln_g=ln_g, ln_b=ln_b)

    bp = x_prompt.shape[0]
    dt = x_prompt.dtype
    meta = jnp.broadcast_to(meta_tokens.astype(dt)[None], (bp, N_META, D_MODEL))
    h_p = jnp.concatenate([meta, x_prompt], axis=1)
    zero_st = dict(
        hgrn_S=jnp.zeros((N_OCC_A, bp, A_HEADS, A_DK, A_DV), dt),
        gdn_S=jnp.zeros((N_OCC_B, bp, B_HEADS, B_DK, B_DV), dt),
        gdn_conv=jnp.zeros((N_OCC_B, bp, CONV_W - 1, B_CONV), dt),
        mlstm_C=jnp.zeros((N_OCC_C, bp, C_HEADS, C_DK, C_DV), dt),
        mlstm_n=jnp.zeros((N_OCC_C, bp, C_HEADS, C_DK), dt),
        mlstm_m=jnp.zeros((N_OCC_C, bp, C_HEADS), dt),
        gla_S=jnp.zeros((N_OCC_D, bp, D_HEADS, D_DK, D_DV), dt))
    h_p, p_st = _trunk(h_p, zero_st, w)
    y_prompt = h_p[:, N_META:]

    sample_st = dict(hgrn_S=state_hgrn_S, gdn_S=state_gdn_S, gdn_conv=state_gdn_conv, mlstm_C=state_mlstm_C,
                     mlstm_n=state_mlstm_n, mlstm_m=state_mlstm_m, gla_S=state_gla_S)
    y_sample, s_st = _trunk(x_sample, sample_st, w)

    return (y_prompt, y_sample,
            p_st['hgrn_S'], p_st['gdn_S'], p_st['gdn_conv'], p_st['mlstm_C'], p_st['mlstm_n'], p_st['mlstm_m'],
            p_st['gla_S'],
            s_st['hgrn_S'], s_st['gdn_S'], s_st['gdn_conv'], s_st['mlstm_C'], s_st['mlstm_n'], s_st['mlstm_m'],
            s_st['gla_S'])
```

```cpp
#include <hip/hip_runtime.h>
#include <hip/hip_cooperative_groups.h>
#include <cstdio>
#include <cstdint>
namespace cg = cooperative_groups;

#ifndef SINGLE_LAUNCH
#define SINGLE_LAUNCH 0
#endif

typedef unsigned short bf16_t;
typedef short bf16x8 __attribute__((ext_vector_type(8)));
typedef float f32x4 __attribute__((ext_vector_type(4)));
typedef __bf16 bf16x2 __attribute__((ext_vector_type(2)));
#define LDSP __attribute__((address_space(3)))

constexpr int D = 1024;
constexpr int NB_P = 8, T_P = 2064, NB_S = 128;
constexpr int ROWS_P = NB_P * T_P;
constexpr int MTOK = ROWS_P + NB_S;
constexpr int NSEQ = NB_P + NB_S;
constexpr int PLD = 4224;
constexpr int NEXP = 16384;
constexpr float DN_ALPHA = 1.6817928305074292f;
constexpr int NTH = 256;

constexpr size_t al256(size_t x) { return (x + 255) & ~(size_t)255; }
constexpr int WIN_ROWS0 = 0, WIN_ROWS1 = 4096, WIN_ROWS2 = 4096 + 4224, WIN_ROWS3 = 4096 + 2 * 4224, WIN_ROWS = 4096 + 2 * 4224 + 3200;
constexpr size_t OFF_WIN = 0;
constexpr size_t OFF_WOUT = OFF_WIN + al256((size_t)WIN_ROWS * 1024 * 2);
constexpr size_t OFF_WQ = OFF_WOUT + al256((size_t)4 * 1024 * 1024 * 2);
constexpr size_t OFF_KEYS = OFF_WQ + al256((size_t)4 * 2048 * 1024 * 2);
constexpr size_t OFF_UB = OFF_KEYS + al256((size_t)4 * 2 * 128 * 128 * 2);
constexpr size_t OFF_VB = OFF_UB + al256((size_t)4 * NEXP * 1024 * 2);
constexpr size_t OFF_LB = OFF_VB + al256((size_t)4 * NEXP * 1024 * 2);
constexpr size_t OFF_H = OFF_LB + al256(1024 * 4);
constexpr size_t OFF_HB = OFF_H + al256((size_t)MTOK * 1024 * 4);
constexpr size_t OFF_P = OFF_HB + al256((size_t)MTOK * 1024 * 2);
constexpr size_t OFF_Q = OFF_P;
constexpr size_t OFF_S1 = OFF_P + al256((size_t)MTOK * 2048 * 2);
constexpr size_t OFF_S2 = OFF_S1 + al256((size_t)128 * MTOK * 8 * 4);
constexpr size_t OFF_O = OFF_P + al256((size_t)MTOK * PLD * 4);
constexpr size_t OFF_A2 = OFF_O + al256((size_t)MTOK * 1024 * 4);
constexpr size_t OFF_TI = OFF_A2 + al256((size_t)MTOK * 1024 * 2);
constexpr size_t OFF_TW = OFF_TI + al256((size_t)MTOK * 128 * 4);
constexpr size_t WS_NEED = OFF_TW + al256((size_t)MTOK * 128 * 4);
static_assert(OFF_S2 + (size_t)128 * MTOK * 8 * 4 <= OFF_O, "alias overflow");

constexpr size_t OUT_YP = 0;
constexpr size_t OUT_YS = OUT_YP + (size_t)8 * 2048 * 1024;
constexpr size_t OUT_P_HGRN = OUT_YS + (size_t)128 * 1024;
constexpr size_t OUT_P_GDN = OUT_P_HGRN + (size_t)8 * 8 * 128 * 128;
constexpr size_t OUT_P_CONV = OUT_P_GDN + (size_t)8 * 8 * 128 * 128;
constexpr size_t OUT_P_MC = OUT_P_CONV + (size_t)8 * 3 * 3072;
constexpr size_t OUT_P_MN = OUT_P_MC + (size_t)8 * 8 * 128 * 128;
constexpr size_t OUT_P_MM = OUT_P_MN + (size_t)8 * 8 * 128;
constexpr size_t OUT_P_GLA = OUT_P_MM + (size_t)8 * 8;
constexpr size_t OUT_S_HGRN = OUT_P_GLA + (size_t)8 * 4 * 128 * 256;
constexpr size_t OUT_S_GDN = OUT_S_HGRN + (size_t)128 * 8 * 128 * 128;
constexpr size_t OUT_S_CONV = OUT_S_GDN + (size_t)128 * 8 * 128 * 128;
constexpr size_t OUT_S_MC = OUT_S_CONV + (size_t)128 * 3 * 3072;
constexpr size_t OUT_S_MN = OUT_S_MC + (size_t)128 * 8 * 128 * 128;
constexpr size_t OUT_S_MM = OUT_S_MN + (size_t)128 * 8 * 128;
constexpr size_t OUT_S_GLA = OUT_S_MM + (size_t)128 * 8;
constexpr size_t OUT_TOTAL = OUT_S_GLA + (size_t)128 * 4 * 128 * 256;

struct Params {
    const float* in[37];
    float* out;
    unsigned char* ws;
};

__device__ __forceinline__ bf16_t f2bf(float f) { unsigned u = __float_as_uint(f); u += 0x7fffu + ((u >> 16) & 1u); return (bf16_t)(u >> 16); }
__device__ __forceinline__ float bf2f(bf16_t h) { return __uint_as_float(((unsigned)h) << 16); }
__device__ __forceinline__ unsigned pack2bf(float lo, float hi) { return (unsigned)f2bf(lo) | ((unsigned)f2bf(hi) << 16); }
__device__ __forceinline__ float sigmoidf_(float x) { return 1.0f / (1.0f + __expf(-x)); }
__device__ __forceinline__ float siluf_(float x) { return x / (1.0f + __expf(-x)); }
__device__ __forceinline__ float softplusf_(float x) { return fmaxf(x, 0.f) + log1pf(__expf(-fabsf(x))); }
__device__ __forceinline__ float logsigmoidf_(float x) { return -softplusf_(-x); }
__device__ __forceinline__ float wave_sum(float v) {
    v += __shfl_xor(v, 32); v += __shfl_xor(v, 16); v += __shfl_xor(v, 8); v += __shfl_xor(v, 4); v += __shfl_xor(v, 2); v += __shfl_xor(v, 1); return v;
}

__device__ __forceinline__ int opaque_tid() { int t = threadIdx.x; asm volatile("" : "+v"(t)); return t; }
__device__ __forceinline__ unsigned char* opaque_ptr(unsigned char* q) { asm volatile("" : "+s"(q)); return q; }

__device__ void transpose_convert(const float* __restrict__ W, int nraw, int npad, bf16_t* __restrict__ Wt, float* lds) {
    const int TID = opaque_tid();
    const int tiles_n = npad / 64, tiles = tiles_n * 16;
    const int tx = TID & 63, ty = TID >> 6;
    for (int tile = blockIdx.x; tile < tiles; tile += gridDim.x) {
        const int tn = tile % tiles_n, tk = tile / tiles_n;
        __syncthreads();
        for (int r = ty; r < 64; r += 4) {
            const int n = tn * 64 + tx, k = tk * 64 + r;
            lds[r * 65 + tx] = (n < nraw) ? W[(size_t)k * nraw + n] : 0.f;
        }
        __syncthreads();
        for (int r = ty; r < 64; r += 4) {
            Wt[(size_t)(tn * 64 + r) * 1024 + tk * 64 + tx] = f2bf(lds[tx * 65 + r]);
        }
    }
}

__device__ void convert_bf16(const float* __restrict__ src, bf16_t* __restrict__ dst, size_t n) {
    const int TID = opaque_tid();
    const size_t n8 = n / 8;
    for (size_t i = (size_t)blockIdx.x * NTH + TID; i < n8; i += (size_t)gridDim.x * NTH) {
        const f32x4 a = *(const f32x4*)(src + i * 8), b = *(const f32x4*)(src + i * 8 + 4);
        uint4 w; w.x = pack2bf(a[0], a[1]); w.y = pack2bf(a[2], a[3]); w.z = pack2bf(b[0], b[1]); w.w = pack2bf(b[2], b[3]);
        *(uint4*)(dst + i * 8) = w;
    }
}

__device__ void phase_prologue(const Params& p, float* lds) {
    const int TID = opaque_tid();
    unsigned char* ws = opaque_ptr(p.ws);
    bf16_t* win = (bf16_t*)(ws + OFF_WIN);
    transpose_convert(p.in[10], 4096, 4096, win + (size_t)WIN_ROWS0 * 1024, lds);
    transpose_convert(p.in[14], 4112, 4224, win + (size_t)WIN_ROWS1 * 1024, lds);
    transpose_convert(p.in[20], 4112, 4224, win + (size_t)WIN_ROWS2 * 1024, lds);
    transpose_convert(p.in[25], 3088, 3200, win + (size_t)WIN_ROWS3 * 1024, lds);
    bf16_t* wout = (bf16_t*)(ws + OFF_WOUT);
    transpose_convert(p.in[13], 1024, 1024, wout + (size_t)0 * 1024 * 1024, lds);
    transpose_convert(p.in[19], 1024, 1024, wout + (size_t)1 * 1024 * 1024, lds);
    transpose_convert(p.in[24], 1024, 1024, wout + (size_t)2 * 1024 * 1024, lds);
    transpose_convert(p.in[29], 1024, 1024, wout + (size_t)3 * 1024 * 1024, lds);
    bf16_t* wq = (bf16_t*)(ws + OFF_WQ);
    for (int l = 0; l < 4; ++l) transpose_convert(p.in[30] + (size_t)l * 1024 * 2048, 2048, 2048, wq + (size_t)l * 2048 * 1024, lds);
    bf16_t* keys = (bf16_t*)(ws + OFF_KEYS);
    for (int l = 0; l < 4; ++l) {
        convert_bf16(p.in[31] + (size_t)l * 16384, keys + (size_t)(l * 2 + 0) * 16384, 16384);
        convert_bf16(p.in[32] + (size_t)l * 16384, keys + (size_t)(l * 2 + 1) * 16384, 16384);
    }
    convert_bf16(p.in[33], (bf16_t*)(ws + OFF_UB), (size_t)4 * NEXP * 1024);
    convert_bf16(p.in[34], (bf16_t*)(ws + OFF_VB), (size_t)4 * NEXP * 1024);
    float* lb = (float*)(ws + OFF_LB);
    for (int c = blockIdx.x * NTH + TID; c < 1024; c += gridDim.x * NTH) {
        const float* L = p.in[11];
        float mx = L[c];
        for (int j = 1; j < 5; ++j) mx = fmaxf(mx, L[j * 1024 + c]);
        float s = 0.f;
        for (int j = 0; j < 5; ++j) s += expf(L[j * 1024 + c] - mx);
        lb[c] = expf(L[c] - mx) / s;
    }
    float* H = (float*)(ws + OFF_H);
    bf16_t* Hb = (bf16_t*)(ws + OFF_HB);
    const size_t nvec = (size_t)MTOK * 256;
    for (size_t i = (size_t)blockIdx.x * NTH + TID; i < nvec; i += (size_t)gridDim.x * NTH) {
        const int row = (int)(i >> 8), c4 = (int)(i & 255) * 4;
        const float* src;
        if (row < ROWS_P) { const int b = row / T_P, t = row % T_P; src = (t < 16) ? p.in[9] + (size_t)t * 1024 : p.in[0] + ((size_t)b * 2048 + (t - 16)) * 1024; }
        else src = p.in[1] + (size_t)(row - ROWS_P) * 1024;
        const f32x4 v = *(const f32x4*)(src + c4);
        *(f32x4*)(H + (size_t)row * 1024 + c4) = v;
        uint2 w; w.x = pack2bf(v[0], v[1]); w.y = pack2bf(v[2], v[3]);
        *(uint2*)(Hb + (size_t)row * 1024 + c4) = w;
    }
}

template <bool OUT_BF16>
__device__ void gemm_phase(const bf16_t* __restrict__ A, int lda, const bf16_t* __restrict__ Bt, int ldb, void* __restrict__ Cv, int ldc,
                           int M, int N, int K, unsigned char* lds) {
    const int TID = opaque_tid();
    constexpr int BM = 128, BK = 32, HT = BM * BK * 2;
    const int tid = TID, wid = tid >> 6, lane = tid & 63, wr = wid >> 1, wc = wid & 1, fr = lane & 15, fq = lane >> 4;
    const int tn = N / BM, tiles = (M / BM) * tn;
    unsigned char* SA = lds; unsigned char* SB = lds + HT;
    for (int tile = blockIdx.x; tile < tiles; tile += gridDim.x) {
        const int brow = (tile / tn) * BM, bcol = (tile % tn) * BM;
        f32x4 acc[4][4];
#pragma unroll
        for (int m = 0; m < 4; ++m)
#pragma unroll
            for (int n = 0; n < 4; ++n) acc[m][n] = (f32x4){0.f, 0.f, 0.f, 0.f};
        const int sr = tid >> 2, scc = (tid & 3) * 8;
        const bf16_t* ga = A + (size_t)(brow + sr) * lda + scc;
        const bf16_t* gb = Bt + (size_t)(bcol + sr) * ldb + scc;
        for (int kt = 0; kt < K / BK; ++kt) {
            __builtin_amdgcn_global_load_lds((const unsigned*)(ga + kt * BK), (LDSP unsigned*)(SA + tid * 16), 16, 0, 0);
            __builtin_amdgcn_global_load_lds((const unsigned*)(ga + (size_t)64 * lda + kt * BK), (LDSP unsigned*)(SA + tid * 16 + 4096), 16, 0, 0);
            __builtin_amdgcn_global_load_lds((const unsigned*)(gb + kt * BK), (LDSP unsigned*)(SB + tid * 16), 16, 0, 0);
            __builtin_amdgcn_global_load_lds((const unsigned*)(gb + (size_t)64 * ldb + kt * BK), (LDSP unsigned*)(SB + tid * 16 + 4096), 16, 0, 0);
            asm volatile("s_waitcnt vmcnt(0)" ::: "memory");
            __syncthreads();
            bf16x8 At[4], Bl[4];
#pragma unroll
            for (int m = 0; m < 4; ++m) At[m] = *(const bf16x8*)(SA + (wr * 64 + m * 16 + fr) * (BK * 2) + fq * 16);
#pragma unroll
            for (int n = 0; n < 4; ++n) Bl[n] = *(const bf16x8*)(SB + (wc * 64 + n * 16 + fr) * (BK * 2) + fq * 16);
#pragma unroll
            for (int m = 0; m < 4; ++m)
#pragma unroll
                for (int n = 0; n < 4; ++n) acc[m][n] = __builtin_amdgcn_mfma_f32_16x16x32_bf16(At[m], Bl[n], acc[m][n], 0, 0, 0);
            __syncthreads();
        }
#pragma unroll
        for (int n = 0; n < 4; ++n) {
            const size_t base = (size_t)(bcol + wc * 64 + n * 16 + fr) * ldc + brow + wr * 64 + fq * 4;
#pragma unroll
            for (int m = 0; m < 4; ++m) {
                if (OUT_BF16) { uint2 w; w.x = pack2bf(acc[m][n][0], acc[m][n][1]); w.y = pack2bf(acc[m][n][2], acc[m][n][3]); *(uint2*)((bf16_t*)Cv + base + m * 16) = w; }
                else *(f32x4*)((float*)Cv + base + m * 16) = acc[m][n];
            }
        }
    }
}

template <int MIX>
__device__ void scan_phase(const Params& p, float* lds) {
    const int TID = opaque_tid();
    unsigned char* ws = opaque_ptr(p.ws);
    const float* P = (const float*)(ws + OFF_P);
    float* O = (float*)(ws + OFF_O);
    const float* lbv = (const float*)(ws + OFF_LB);
    float* qs = lds;
    float* ks = lds + 2048;
    float* fs = lds + 4096;
    float* vs = lds + 6144;
    float* sc = lds + 7168;
    const int tid = TID, wave = tid >> 6, lane = tid & 63, g = lane >> 4, c = lane & 15;
    constexpr int DV = (MIX == 3) ? 256 : 128;
    constexpr int NH = (MIX == 3) ? 4 : 8;
    constexpr int VG = DV / 64;
    const int nitems = NSEQ * 16;
    for (int item = blockIdx.x; item < nitems; item += gridDim.x) {
        const int seq = item >> 4, sub = item & 15, h = sub / VG, vg = sub % VG;
        const int T = (seq < NB_P) ? T_P : 1;
        const int row0 = (seq < NB_P) ? seq * T_P : ROWS_P + (seq - NB_P);
        const bool has_init = seq >= NB_P;
        const int sseq = seq - NB_P;
        const int vcol = vg * 64 + wave * 16 + c;
        float s[32];
        const float* init_S = nullptr; float* out_S = nullptr;
        if (MIX == 0) { init_S = p.in[2]; out_S = p.out + (has_init ? OUT_S_HGRN : OUT_P_HGRN); }
        if (MIX == 1) { init_S = p.in[3]; out_S = p.out + (has_init ? OUT_S_GDN : OUT_P_GDN); }
        if (MIX == 2) { init_S = p.in[5]; out_S = p.out + (has_init ? OUT_S_MC : OUT_P_MC); }
        if (MIX == 3) { init_S = p.in[8]; out_S = p.out + (has_init ? OUT_S_GLA : OUT_P_GLA); }
        const size_t st_off = ((size_t)(has_init ? sseq : seq) * NH + h) * 128 * DV;
#pragma unroll
        for (int i = 0; i < 32; ++i) s[i] = has_init ? init_S[st_off + (size_t)(g * 32 + i) * DV + vcol] : 0.f;
        float nn0 = 0.f, nn1 = 0.f, mrun = 0.f;
        if (MIX == 2 && has_init) {
            nn0 = p.in[6][((size_t)sseq * 8 + h) * 128 + 2 * lane]; nn1 = p.in[6][((size_t)sseq * 8 + h) * 128 + 2 * lane + 1];
            mrun = p.in[7][(size_t)sseq * 8 + h];
        }
        for (int t0 = 0; t0 < T; t0 += 16) {
            const int nt = (T - t0) < 16 ? (T - t0) : 16;
            __syncthreads();
            {
                const int tt = tid >> 4, d0 = (tid & 15) * 8;
                if (tt < nt) {
                    const int t = t0 + tt; const float* Pr = P + (size_t)(row0 + t) * PLD;
                    if (MIX == 0) {
#pragma unroll
                        for (int j = 0; j < 8; ++j) {
                            const int d = d0 + j, cc = h * 128 + d;
                            const float qr = Pr[cc], fr_ = Pr[1024 + cc], lb = lbv[cc];
                            const float fg = lb + (1.f - lb) * sigmoidf_(fr_);
                            qs[tt * 128 + d] = siluf_(qr); ks[tt * 128 + d] = 1.f - fg; fs[tt * 128 + d] = fg;
                        }
                    } else if (MIX == 1) {
                        const float* cw = p.in[15]; const float* cbuf = p.in[4];
                        float sq = 0.f, sk = 0.f;
#pragma unroll 1
                        for (int j = 0; j < 8; ++j) {
                            const int cq = h * 128 + d0 + j, ck = 1024 + cq;
                            float yq = 0.f, yk = 0.f;
#pragma unroll
                            for (int w = 0; w < 4; ++w) {
                                const int tp = t - 3 + w; float xq, xk;
                                if (tp >= 0) { xq = P[(size_t)(row0 + tp) * PLD + cq]; xk = P[(size_t)(row0 + tp) * PLD + ck]; }
                                else if (has_init) { xq = cbuf[((size_t)sseq * 3 + (3 + tp)) * 3072 + cq]; xk = cbuf[((size_t)sseq * 3 + (3 + tp)) * 3072 + ck]; }
                                else { xq = 0.f; xk = 0.f; }
                                yq += cw[w * 3072 + cq] * xq; yk += cw[w * 3072 + ck] * xk;
                            }
                            const float qv = siluf_(yq), kv = siluf_(yk);
                            sq += qv * qv; sk += kv * kv;
                            qs[tt * 128 + d0 + j] = qv; ks[tt * 128 + d0 + j] = kv;
                        }
                        sq += __shfl_xor(sq, 1); sq += __shfl_xor(sq, 2); sq += __shfl_xor(sq, 4); sq += __shfl_xor(sq, 8);
                        sk += __shfl_xor(sk, 1); sk += __shfl_xor(sk, 2); sk += __shfl_xor(sk, 4); sk += __shfl_xor(sk, 8);
                        const float rq = rsqrtf(sq + 1e-6f) * 0.08838834764831845f, rk = rsqrtf(sk + 1e-6f);
#pragma unroll 1
                        for (int j = 0; j < 8; ++j) { qs[tt * 128 + d0 + j] *= rq; ks[tt * 128 + d0 + j] *= rk; }
                        if ((tid & 15) == 0) {
                            const float ar = Pr[3072 + h], br = Pr[3080 + h];
                            const float la = -expf(p.in[16][h]) * softplusf_(ar + p.in[17][h]);
                            sc[tt * 2] = expf(la); sc[tt * 2 + 1] = sigmoidf_(br);
                        }
                    } else if (MIX == 2) {
#pragma unroll
                        for (int j = 0; j < 8; ++j) {
                            const int d = d0 + j, cc = h * 128 + d;
                            qs[tt * 128 + d] = Pr[cc]; ks[tt * 128 + d] = Pr[1024 + cc] * 0.08838834764831845f;
                        }
                        if ((tid & 15) == 0) {
                            sc[tt * 2] = Pr[3072 + h] + p.in[21][h];
                            sc[tt * 2 + 1] = logsigmoidf_(Pr[3080 + h] + p.in[22][h]);
                        }
                    } else {
                        const float* wg = p.in[26]; const float* bg = p.in[27];
                        float rr[16];
#pragma unroll
                        for (int j = 0; j < 16; ++j) rr[j] = Pr[3072 + j];
#pragma unroll
                        for (int j = 0; j < 8; ++j) {
                            const int d = d0 + j, cc = h * 128 + d;
                            float pre = bg[cc];
#pragma unroll
                            for (int q = 0; q < 16; ++q) pre += rr[q] * wg[q * 512 + cc];
                            qs[tt * 128 + d] = Pr[cc] * 0.08838834764831845f; ks[tt * 128 + d] = Pr[512 + cc];
                            fs[tt * 128 + d] = expf(logsigmoidf_(pre) * 0.0625f);
                        }
                    }
                    {
                        const int v0 = (tid & 15) * 4;
                        const int vbase = (MIX == 0) ? 2048 : (MIX == 1) ? 2048 : (MIX == 2) ? 2048 : 1024;
#pragma unroll 1
                        for (int j = 0; j < 4; ++j) {
                            const int cv = vbase + h * DV + vg * 64 + v0 + j;
                            float val;
                            if (MIX == 1) {
                                const float* cw = p.in[15]; const float* cbuf = p.in[4];
                                float y = 0.f;
#pragma unroll
                                for (int w = 0; w < 4; ++w) {
                                    const int tp = t - 3 + w; float x;
                                    if (tp >= 0) x = P[(size_t)(row0 + tp) * PLD + cv];
                                    else if (has_init) x = cbuf[((size_t)sseq * 3 + (3 + tp)) * 3072 + cv];
                                    else x = 0.f;
                                    y += cw[w * 3072 + cv] * x;
                                }
                                val = siluf_(y);
                            } else val = Pr[cv];
                            vs[tt * 64 + v0 + j] = val;
                        }
                    }
                }
            }
            __syncthreads();
            for (int tt = 0; tt < nt; ++tt) {
                const float vv = vs[tt * 64 + wave * 16 + c];
                const f32x4* q4 = (const f32x4*)(qs + tt * 128 + g * 32);
                const f32x4* k4 = (const f32x4*)(ks + tt * 128 + g * 32);
                const f32x4* f4 = (const f32x4*)(fs + tt * 128 + g * 32);
                float o = 0.f;
                if (MIX == 0 || MIX == 3) {
#pragma unroll
                    for (int i4 = 0; i4 < 8; ++i4) {
                        const f32x4 qq = q4[i4], kk = k4[i4], ff = f4[i4];
#pragma unroll
                        for (int j = 0; j < 4; ++j) { const int i = i4 * 4 + j; s[i] = ff[j] * s[i] + kk[j] * vv; o += qq[j] * s[i]; }
                    }
                    o += __shfl_xor(o, 16); o += __shfl_xor(o, 32);
                } else if (MIX == 1) {
                    const float a = sc[tt * 2], beta = sc[tt * 2 + 1];
                    float r = 0.f;
#pragma unroll
                    for (int i4 = 0; i4 < 8; ++i4) {
                        const f32x4 kk = k4[i4];
#pragma unroll
                        for (int j = 0; j < 4; ++j) { const int i = i4 * 4 + j; s[i] *= a; r += kk[j] * s[i]; }
                    }
                    r += __shfl_xor(r, 16); r += __shfl_xor(r, 32);
                    const float vn = beta * (vv - r);
#pragma unroll
                    for (int i4 = 0; i4 < 8; ++i4) {
                        const f32x4 qq = q4[i4], kk = k4[i4];
#pragma unroll
                        for (int j = 0; j < 4; ++j) { const int i = i4 * 4 + j; s[i] += kk[j] * vn; o += qq[j] * s[i]; }
                    }
                    o += __shfl_xor(o, 16); o += __shfl_xor(o, 32);
                } else {
                    const float li = sc[tt * 2], lf = sc[tt * 2 + 1];
                    const float mn = fmaxf(lf + mrun, li);
                    const float a = expf(lf + mrun - mn), w = expf(li - mn);
                    mrun = mn;
                    const float wv = w * vv;
#pragma unroll
                    for (int i4 = 0; i4 < 8; ++i4) {
                        const f32x4 qq = q4[i4], kk = k4[i4];
#pragma unroll
                        for (int j = 0; j < 4; ++j) { const int i = i4 * 4 + j; s[i] = a * s[i] + kk[j] * wv; o += qq[j] * s[i]; }
                    }
                    o += __shfl_xor(o, 16); o += __shfl_xor(o, 32);
                    const float k0 = ks[tt * 128 + 2 * lane], k1 = ks[tt * 128 + 2 * lane + 1];
                    const float q0 = qs[tt * 128 + 2 * lane], q1 = qs[tt * 128 + 2 * lane + 1];
                    nn0 = a * nn0 + w * k0; nn1 = a * nn1 + w * k1;
                    const float den = wave_sum(q0 * nn0 + q1 * nn1);
                    o = o / fmaxf(fabsf(den), expf(-mn));
                }
                if (g == 0) O[(size_t)(row0 + t0 + tt) * 1024 + sub * 64 + wave * 16 + c] = o;
            }
        }
#pragma unroll
        for (int i = 0; i < 32; ++i) out_S[st_off + (size_t)(g * 32 + i) * DV + vcol] = s[i];
        if (MIX == 2 && vg == 0 && wave == 0) {
            float* on = p.out + (has_init ? OUT_S_MN : OUT_P_MN) + ((size_t)(has_init ? sseq : seq) * 8 + h) * 128;
            on[2 * lane] = nn0; on[2 * lane + 1] = nn1;
            if (lane == 0) p.out[(has_init ? OUT_S_MM : OUT_P_MM) + (size_t)(has_init ? sseq : seq) * 8 + h] = mrun;
        }
    }
}

template <int MIX>
__device__ void normgate_phase(const Params& p) {
    const int TID = opaque_tid();
    unsigned char* ws = opaque_ptr(p.ws);
    const float* P = (const float*)(ws + OFF_P);
    const float* O = (const float*)(ws + OFF_O);
    bf16_t* A2 = (bf16_t*)(ws + OFF_A2);
    const int wave = TID >> 6, lane = TID & 63;
    const float* ng = (MIX == 0) ? p.in[12] : (MIX == 1) ? p.in[18] : (MIX == 2) ? p.in[23] : p.in[28];
    constexpr int GOFF = (MIX == 0) ? 3072 : (MIX == 1) ? 3088 : (MIX == 2) ? 3088 : 2048;
    for (int row = blockIdx.x * 4 + wave; row < MTOK; row += gridDim.x * 4) {
        const int c0 = lane * 16;
        float x[16], gt[16];
#pragma unroll
        for (int j = 0; j < 4; ++j) {
            const f32x4 v = *(const f32x4*)(O + (size_t)row * 1024 + c0 + j * 4);
            const f32x4 gg = *(const f32x4*)(P + (size_t)row * PLD + GOFF + c0 + j * 4);
#pragma unroll
            for (int q = 0; q < 4; ++q) { x[j * 4 + q] = v[q]; gt[j * 4 + q] = gg[q]; }
        }
        float s1 = 0.f, s2 = 0.f;
#pragma unroll
        for (int j = 0; j < 16; ++j) { s1 += x[j]; s2 += x[j] * x[j]; }
        s1 += __shfl_xor(s1, 1); s1 += __shfl_xor(s1, 2); s1 += __shfl_xor(s1, 4);
        s2 += __shfl_xor(s2, 1); s2 += __shfl_xor(s2, 2); s2 += __shfl_xor(s2, 4);
        if (MIX == 3) { s1 += __shfl_xor(s1, 8); s2 += __shfl_xor(s2, 8); }
        constexpr float invn = (MIX == 3) ? (1.f / 256.f) : (1.f / 128.f);
        float outv[16];
        if (MIX == 2) {
            const float mean = s1 * invn;
            float q2 = 0.f;
#pragma unroll
            for (int j = 0; j < 16; ++j) { const float d = x[j] - mean; q2 += d * d; }
            q2 += __shfl_xor(q2, 1); q2 += __shfl_xor(q2, 2); q2 += __shfl_xor(q2, 4);
            const float rs = rsqrtf(q2 * invn + 1e-6f);
#pragma unroll
            for (int j = 0; j < 16; ++j) outv[j] = sigmoidf_(gt[j]) * ((x[j] - mean) * rs * ng[c0 + j]);
        } else {
            const float rs = rsqrtf(s2 * invn + 1e-6f);
#pragma unroll
            for (int j = 0; j < 16; ++j) {
                const int gi = (MIX == 3) ? ((c0 + j) & 255) : ((c0 + j) & 127);
                outv[j] = x[j] * rs * ng[gi] * siluf_(gt[j]);
            }
        }
        uint4 w0, w1;
        w0.x = pack2bf(outv[0], outv[1]); w0.y = pack2bf(outv[2], outv[3]); w0.z = pack2bf(outv[4], outv[5]); w0.w = pack2bf(outv[6], outv[7]);
        w1.x = pack2bf(outv[8], outv[9]); w1.y = pack2bf(outv[10], outv[11]); w1.z = pack2bf(outv[12], outv[13]); w1.w = pack2bf(outv[14], outv[15]);
        *(uint4*)(A2 + (size_t)row * 1024 + c0) = w0; *(uint4*)(A2 + (size_t)row * 1024 + c0 + 8) = w1;
    }
    if (MIX == 1) {
        const float* cbuf = p.in[4];
        const int total = NSEQ * 3 * 3072;
        for (int i = blockIdx.x * NTH + TID; i < total; i += gridDim.x * NTH) {
            const int seq = i / (3 * 3072), rem = i % (3 * 3072), j = rem / 3072, cc = rem % 3072;
            if (seq < NB_P) p.out[OUT_P_CONV + (size_t)i] = P[(size_t)(seq * T_P + T_P - 3 + j) * PLD + cc];
            else {
                const int ss = seq - NB_P;
                const float v = (j < 2) ? cbuf[((size_t)ss * 3 + j + 1) * 3072 + cc] : P[(size_t)(ROWS_P + ss) * PLD + cc];
                p.out[OUT_S_CONV + ((size_t)ss * 3 + j) * 3072 + cc] = v;
            }
        }
    }
}

__device__ void ln_phase(const Params& p, int layer) {
    const int TID = opaque_tid();
    unsigned char* ws = opaque_ptr(p.ws);
    float* H = (float*)(ws + OFF_H);
    bf16_t* Hb = (bf16_t*)(ws + OFF_HB);
    const float* Y = (const float*)(ws + OFF_O);
    const float* lg = p.in[35] + (size_t)(layer * 2 + 0) * 1024;
    const float* lbias = p.in[36] + (size_t)(layer * 2 + 0) * 1024;
    const int wave = TID >> 6, lane = TID & 63;
    for (int row = blockIdx.x * 4 + wave; row < MTOK; row += gridDim.x * 4) {
        const int c0 = lane * 16;
        float z[16];
        float s1 = 0.f;
#pragma unroll
        for (int j = 0; j < 4; ++j) {
            const f32x4 hv = *(const f32x4*)(H + (size_t)row * 1024 + c0 + j * 4);
            const f32x4 yv = *(const f32x4*)(Y + (size_t)row * 1024 + c0 + j * 4);
#pragma unroll
            for (int q = 0; q < 4; ++q) { z[j * 4 + q] = DN_ALPHA * hv[q] + yv[q]; s1 += z[j * 4 + q]; }
        }
        const float mean = wave_sum(s1) * (1.f / 1024.f);
        float s2 = 0.f;
#pragma unroll
        for (int j = 0; j < 16; ++j) { const float d = z[j] - mean; s2 += d * d; }
        const float rs = rsqrtf(wave_sum(s2) * (1.f / 1024.f) + 1e-5f);
        float o[16];
#pragma unroll
        for (int j = 0; j < 16; ++j) o[j] = (z[j] - mean) * rs * lg[c0 + j] + lbias[c0 + j];
#pragma unroll
        for (int j = 0; j < 4; ++j) *(f32x4*)(H + (size_t)row * 1024 + c0 + j * 4) = (f32x4){o[j * 4], o[j * 4 + 1], o[j * 4 + 2], o[j * 4 + 3]};
        uint4 w0, w1;
        w0.x = pack2bf(o[0], o[1]); w0.y = pack2bf(o[2], o[3]); w0.z = pack2bf(o[4], o[5]); w0.w = pack2bf(o[6], o[7]);
        w1.x = pack2bf(o[8], o[9]); w1.y = pack2bf(o[10], o[11]); w1.z = pack2bf(o[12], o[13]); w1.w = pack2bf(o[14], o[15]);
        *(uint4*)(Hb + (size_t)row * 1024 + c0) = w0; *(uint4*)(Hb + (size_t)row * 1024 + c0 + 8) = w1;
    }
}

#define INS16(V, I, xv, xi) do { float cv_ = (xv); int ci_ = (xi); \
    _Pragma("unroll") for (int q_ = 0; q_ < 16; ++q_) { const bool gt_ = cv_ > V[q_]; const float tv_ = gt_ ? V[q_] : cv_; const int ti_ = gt_ ? I[q_] : ci_; \
        V[q_] = gt_ ? cv_ : V[q_]; I[q_] = gt_ ? ci_ : I[q_]; cv_ = tv_; ci_ = ti_; } } while (0)

__device__ void topk_phase(const Params& p) {
    const int TID = opaque_tid();
    unsigned char* ws = opaque_ptr(p.ws);
    const float* S1 = (const float*)(ws + OFF_S1);
    const float* S2 = (const float*)(ws + OFF_S2);
    int* TI = (int*)(ws + OFF_TI);
    float* TW = (float*)(ws + OFF_TW);
    const int NR = MTOK * 8;
    for (int r = blockIdx.x * NTH + TID; r < NR; r += gridDim.x * NTH) {
        float v1[16], v2[16]; int i1[16], i2[16];
#pragma unroll
        for (int q = 0; q < 16; ++q) { v1[q] = -INFINITY; v2[q] = -INFINITY; i1[q] = 0; i2[q] = 0; }
#pragma unroll 2
        for (int j = 0; j < 128; ++j) { const float x1 = S1[(size_t)j * NR + r]; INS16(v1, i1, x1, j); }
#pragma unroll 2
        for (int j = 0; j < 128; ++j) { const float x2 = S2[(size_t)j * NR + r]; INS16(v2, i2, x2, j); }
        float tv[16]; int te[16];
#pragma unroll
        for (int q = 0; q < 16; ++q) { tv[q] = -INFINITY; te[q] = 0; }
#pragma unroll
        for (int a = 0; a < 16; ++a)
#pragma unroll
            for (int b = 0; b < 16; ++b)
                if ((a + 1) * (b + 1) <= 16) { INS16(tv, te, v1[a] + v2[b], i1[a] * 128 + i2[b]); }
        float e[16]; float sum = 0.f;
#pragma unroll
        for (int q = 0; q < 16; ++q) { e[q] = expf(tv[q] - tv[0]); sum += e[q]; }
        const float inv = 1.f / sum;
#pragma unroll
        for (int q = 0; q < 4; ++q) {
            *(int4*)(TI + (size_t)r * 16 + q * 4) = make_int4(te[q * 4], te[q * 4 + 1], te[q * 4 + 2], te[q * 4 + 3]);
            *(f32x4*)(TW + (size_t)r * 16 + q * 4) = (f32x4){e[q * 4] * inv, e[q * 4 + 1] * inv, e[q * 4 + 2] * inv, e[q * 4 + 3] * inv};
        }
    }
}

__device__ void gather_phase(const Params& p, int layer) {
    const int TID = opaque_tid();
    unsigned char* ws = opaque_ptr(p.ws);
    float* H = (float*)(ws + OFF_H);
    bf16_t* Hb = (bf16_t*)(ws + OFF_HB);
    const int* TI = (const int*)(ws + OFF_TI);
    const float* TW = (const float*)(ws + OFF_TW);
    const bf16_t* Ub = (const bf16_t*)(ws + OFF_UB) + (size_t)layer * NEXP * 1024;
    const bf16_t* Vb = (const bf16_t*)(ws + OFF_VB) + (size_t)layer * NEXP * 1024;
    const float* lg = p.in[35] + (size_t)(layer * 2 + 1) * 1024;
    const float* lbias = p.in[36] + (size_t)(layer * 2 + 1) * 1024;
    const int wave = TID >> 6, lane = TID & 63;
    for (int row = blockIdx.x * 4 + wave; row < MTOK; row += gridDim.x * 4) {
        const int c0 = lane * 16;
        float x[16];
        {
            const uint4 a = *(const uint4*)(Hb + (size_t)row * 1024 + c0), b = *(const uint4*)(Hb + (size_t)row * 1024 + c0 + 8);
            const unsigned w[8] = {a.x, a.y, a.z, a.w, b.x, b.y, b.z, b.w};
#pragma unroll
            for (int j = 0; j < 8; ++j) { x[2 * j] = __uint_as_float(w[j] << 16); x[2 * j + 1] = __uint_as_float(w[j] & 0xffff0000u); }
        }
        const int e0 = TI[(size_t)row * 128 + lane], e1 = TI[(size_t)row * 128 + 64 + lane];
        const float g0 = TW[(size_t)row * 128 + lane], g1 = TW[(size_t)row * 128 + 64 + lane];
        float f[16];
#pragma unroll
        for (int j = 0; j < 16; ++j) f[j] = 0.f;
#pragma unroll 1
        for (int half = 0; half < 2; ++half) {
            const int ev = half ? e1 : e0; const float gv = half ? g1 : g0;
#pragma unroll 4
            for (int j = 0; j < 64; ++j) {
                const int e = __shfl(ev, j); const float gw = __shfl(gv, j);
                const bf16_t* ur = Ub + (size_t)e * 1024 + c0; const bf16_t* vr = Vb + (size_t)e * 1024 + c0;
                const uint4 ua = *(const uint4*)ur, ub = *(const uint4*)(ur + 8);
                const uint4 va = *(const uint4*)vr, vb = *(const uint4*)(vr + 8);
                const unsigned uw[8] = {ua.x, ua.y, ua.z, ua.w, ub.x, ub.y, ub.z, ub.w};
                const unsigned vw[8] = {va.x, va.y, va.z, va.w, vb.x, vb.y, vb.z, vb.w};
                float d = 0.f;
#pragma unroll
                for (int q = 0; q < 8; ++q) { d += __uint_as_float(uw[q] << 16) * x[2 * q]; d += __uint_as_float(uw[q] & 0xffff0000u) * x[2 * q + 1]; }
                d = wave_sum(d);
                const float act = 0.5f * d * (1.f + erff(d * 0.70710678118654752f));
                const float wgt = gw * act;
#pragma unroll
                for (int q = 0; q < 8; ++q) { f[2 * q] += wgt * __uint_as_float(vw[q] << 16); f[2 * q + 1] += wgt * __uint_as_float(vw[q] & 0xffff0000u); }
            }
        }
        float z[16]; float s1 = 0.f;
#pragma unroll
        for (int j = 0; j < 4; ++j) {
            const f32x4 hv = *(const f32x4*)(H + (size_t)row * 1024 + c0 + j * 4);
#pragma unroll
            for (int q = 0; q < 4; ++q) { z[j * 4 + q] = DN_ALPHA * hv[q] + f[j * 4 + q]; s1 += z[j * 4 + q]; }
        }
        const float mean = wave_sum(s1) * (1.f / 1024.f);
        float s2 = 0.f;
#pragma unroll
        for (int j = 0; j < 16; ++j) { const float d = z[j] - mean; s2 += d * d; }
        const float rs = rsqrtf(wave_sum(s2) * (1.f / 1024.f) + 1e-5f);
        float o[16];
#pragma unroll
        for (int j = 0; j < 16; ++j) o[j] = (z[j] - mean) * rs * lg[c0 + j] + lbias[c0 + j];
#pragma unroll
        for (int j = 0; j < 4; ++j) *(f32x4*)(H + (size_t)row * 1024 + c0 + j * 4) = (f32x4){o[j * 4], o[j * 4 + 1], o[j * 4 + 2], o[j * 4 + 3]};
        uint4 w0, w1;
        w0.x = pack2bf(o[0], o[1]); w0.y = pack2bf(o[2], o[3]); w0.z = pack2bf(o[4], o[5]); w0.w = pack2bf(o[6], o[7]);
        w1.x = pack2bf(o[8], o[9]); w1.y = pack2bf(o[10], o[11]); w1.z = pack2bf(o[12], o[13]); w1.w = pack2bf(o[14], o[15]);
        *(uint4*)(Hb + (size_t)row * 1024 + c0) = w0; *(uint4*)(Hb + (size_t)row * 1024 + c0 + 8) = w1;
        if (layer == 3) {
            float* dst = nullptr;
            if (row < ROWS_P) { const int b = row / T_P, t = row % T_P; if (t >= 16) dst = p.out + OUT_YP + ((size_t)b * 2048 + (t - 16)) * 1024; }
            else dst = p.out + OUT_YS + (size_t)(row - ROWS_P) * 1024;
            if (dst) {
#pragma unroll
                for (int j = 0; j < 4; ++j) *(f32x4*)(dst + c0 + j * 4) = (f32x4){o[j * 4], o[j * 4 + 1], o[j * 4 + 2], o[j * 4 + 3]};
            }
        }
    }
}

constexpr int NPHASE = 1 + 4 * 9;

__device__ void run_phase(const Params& p, int ph, unsigned char* lds) {
    unsigned char* ws = opaque_ptr(p.ws);
    if (ph == 0) { phase_prologue(p, (float*)lds); return; }
    const int layer = (ph - 1) / 9, sub = (ph - 1) % 9;
    const bf16_t* Hb = (const bf16_t*)(ws + OFF_HB);
    switch (sub) {
    case 0: {
        const int wrow = (layer == 0) ? WIN_ROWS0 : (layer == 1) ? WIN_ROWS1 : (layer == 2) ? WIN_ROWS2 : WIN_ROWS3;
        const int npad = (layer == 0) ? 4096 : (layer == 3) ? 3200 : 4224;
        gemm_phase<false>((const bf16_t*)(ws + OFF_WIN) + (size_t)wrow * 1024, 1024, Hb, 1024, ws + OFF_P, PLD, npad, MTOK, 1024, lds);
    } break;
    case 1:
        if (layer == 0) scan_phase<0>(p, (float*)lds); else if (layer == 1) scan_phase<1>(p, (float*)lds);
        else if (layer == 2) scan_phase<2>(p, (float*)lds); else scan_phase<3>(p, (float*)lds);
        break;
    case 2:
        if (layer == 0) normgate_phase<0>(p); else if (layer == 1) normgate_phase<1>(p);
        else if (layer == 2) normgate_phase<2>(p); else normgate_phase<3>(p);
        break;
    case 3:
        gemm_phase<false>((const bf16_t*)(ws + OFF_WOUT) + (size_t)layer * 1024 * 1024, 1024, (const bf16_t*)(ws + OFF_A2), 1024, ws + OFF_O, 1024, 1024, MTOK, 1024, lds);
        break;
    case 4: ln_phase(p, layer); break;
    case 5:
        gemm_phase<true>((const bf16_t*)(ws + OFF_WQ) + (size_t)layer * 2048 * 1024, 1024, Hb, 1024, ws + OFF_Q, 2048, 2048, MTOK, 1024, lds);
        break;
    case 6: {
        const bf16_t* keys = (const bf16_t*)(ws + OFF_KEYS) + (size_t)layer * 2 * 16384;
        const bf16_t* Q = (const bf16_t*)(ws + OFF_Q);
        gemm_phase<false>(Q, 256, keys, 128, ws + OFF_S1, MTOK * 8, MTOK * 8, 128, 128, lds);
        gemm_phase<false>(Q + 128, 256, keys + 16384, 128, ws + OFF_S2, MTOK * 8, MTOK * 8, 128, 128, lds);
    } break;
    case 7: topk_phase(p); break;
    case 8: gather_phase(p, layer); break;
    }
}

__global__ void __launch_bounds__(NTH, 2) mega_kernel(Params p, int ph_lo, int ph_hi) {
    __shared__ __attribute__((aligned(16))) unsigned char lds[32768];
    cg::grid_group grid = cg::this_grid();
    for (int ph = ph_lo; ph < ph_hi; ++ph) {
        run_phase(p, ph, lds);
        if (ph + 1 < ph_hi) grid.sync();
    }
}

extern "C" void kernel_launch(void* const* d_in, const int* in_sizes, int n_in, void* d_out, int out_size, void* d_ws, size_t ws_size, hipStream_t stream) {
    static int grid_blocks = 0;
    if (!grid_blocks) {
        int dev = 0, cus = 0, per_cu = 0;
        hipGetDevice(&dev);
        hipDeviceGetAttribute(&cus, hipDeviceAttributeMultiprocessorCount, dev);
        hipOccupancyMaxActiveBlocksPerMultiprocessor(&per_cu, mega_kernel, NTH, 0);
        if (per_cu > 2) per_cu = 2;
        if (per_cu < 1) per_cu = 1;
        grid_blocks = cus * per_cu;
    }
    if (ws_size < WS_NEED) fprintf(stderr, "workspace too small: %zu < %zu\n", ws_size, (size_t)WS_NEED);
    if ((size_t)out_size != OUT_TOTAL) fprintf(stderr, "unexpected out_size %d vs %zu\n", out_size, (size_t)OUT_TOTAL);
    Params p{};
    for (int i = 0; i < 37; ++i) p.in[i] = (const float*)d_in[i];
    p.out = (float*)d_out;
    p.ws = (unsigned char*)d_ws;
#if SINGLE_LAUNCH
    int lo = 0, hi = NPHASE;
    void* args[] = {&p, &lo, &hi};
    hipError_t e = hipLaunchCooperativeKernel((void*)mega_kernel, dim3(grid_blocks), dim3(NTH), args, 0, stream);
    if (e != hipSuccess) fprintf(stderr, "cooperative launch failed: %s (grid %d)\n", hipGetErrorString(e), grid_blocks);
#else
    for (int ph = 0; ph < NPHASE; ++ph) mega_kernel<<<grid_blocks, NTH, 0, stream>>>(p, ph, ph + 1);
#endif
}
```

```cpp
#include <hip/hip_runtime.h>
#include <hip/hip_cooperative_groups.h>
#include <cstdio>
#include <cstdint>
namespace cg = cooperative_groups;

#ifndef OLD_PREPASS_MASK
#define OLD_PREPASS_MASK 0
#endif
#ifndef PROBE_BARRIERS
#define PROBE_BARRIERS 0
#endif
#ifndef PROBE_LITE
#define PROBE_LITE 0
#endif
#ifndef PROBE_MASK
#define PROBE_MASK 0
#endif
#ifndef SAMPLE_IN_SEQ
#define SAMPLE_IN_SEQ 1
#endif
#ifndef SINGLE_LAUNCH
#define SINGLE_LAUNCH 1
#endif

typedef unsigned short bf16_t;
typedef short bf16x8 __attribute__((ext_vector_type(8)));
typedef float f32x4 __attribute__((ext_vector_type(4)));
typedef __bf16 bf16x2 __attribute__((ext_vector_type(2)));
typedef short bf16x4 __attribute__((ext_vector_type(4)));
typedef unsigned u32x4 __attribute__((ext_vector_type(4)));
typedef unsigned u32x2 __attribute__((ext_vector_type(2)));
#define LDSP __attribute__((address_space(3)))

constexpr int D = 1024;
constexpr int NB_P = 8, T_P = 2064, NB_S = 128;
constexpr int ROWS_P = NB_P * T_P;
constexpr int MTOK = ROWS_P + NB_S;
constexpr int NSEQ = NB_P + NB_S;
constexpr int PLD = 4352;
constexpr int NEXP = 16384;
constexpr float DN_ALPHA = 1.6817928305074292f;
constexpr int NTH = 256;
constexpr int LDS_BYTES = 79872;

constexpr size_t al256(size_t x) { return (x + 255) & ~(size_t)255; }
constexpr int WIN_ROWS0 = 0, WIN_ROWS1 = 4096, WIN_ROWS2 = 4096 + 4352, WIN_ROWS3 = 4096 + 2 * 4352, WIN_ROWS = 4096 + 2 * 4352 + 3328;
constexpr size_t OFF_WIN = 0;
constexpr size_t OFF_WOUT = OFF_WIN + al256((size_t)WIN_ROWS * 1024 * 2);
constexpr size_t OFF_WQ = OFF_WOUT + al256((size_t)4 * 1024 * 1024 * 2);
constexpr size_t OFF_KEYS = OFF_WQ + al256((size_t)4 * 2048 * 1024 * 2);
constexpr size_t OFF_UB = OFF_KEYS + al256((size_t)4 * 2 * 128 * 128 * 2);
constexpr size_t OFF_VB = OFF_UB + al256((size_t)4 * NEXP * 1024);
constexpr size_t OFF_SU = OFF_VB + al256((size_t)4 * NEXP * 1024);
constexpr size_t OFF_SV = OFF_SU + al256((size_t)4 * NEXP * 4);
constexpr size_t OFF_LB = OFF_SV + al256((size_t)4 * NEXP * 4);
constexpr size_t OFF_H = OFF_LB + al256(1024 * 4);
constexpr size_t OFF_PG = OFF_H;
constexpr size_t OFF_HB = OFF_H + al256((size_t)MTOK * 1024 * 4);
constexpr size_t OFF_P = OFF_HB + al256((size_t)MTOK * 1024 * 2);
constexpr size_t OFF_Q = OFF_P;
constexpr size_t OFF_S1 = OFF_P + al256((size_t)MTOK * 2048 * 2);
constexpr size_t OFF_S2 = OFF_S1 + al256((size_t)128 * MTOK * 8 * 4);
constexpr size_t OFF_PD = OFF_P;
constexpr size_t OFF_F = OFF_P + al256((size_t)8 * MTOK * 128 * 4);
constexpr size_t OFF_DRY = OFF_F + al256((size_t)MTOK * 1024 * 4);
constexpr size_t OFF_O = OFF_P + al256((size_t)MTOK * PLD * 4);
constexpr size_t OFF_A2 = OFF_O + al256((size_t)MTOK * 1024 * 4);
constexpr size_t OFF_TI = OFF_A2 + al256((size_t)MTOK * 1024 * 2);
constexpr size_t OFF_TW = OFF_TI + al256((size_t)MTOK * 128 * 4);
constexpr int NCHUNK_MAX = 8 * 8 * 129;
constexpr size_t OFF_QF = OFF_A2;
constexpr size_t OFF_AF = OFF_QF + al256((size_t)NCHUNK_MAX * 2048 * 2);
constexpr size_t OFF_DF = OFF_AF + al256((size_t)NCHUNK_MAX * 256 * 4);
constexpr size_t OFF_KF = OFF_TW + al256((size_t)MTOK * 128 * 4);
constexpr size_t OFF_WF = OFF_KF + al256((size_t)NCHUNK_MAX * 2048 * 2);
constexpr size_t OFF_VF = OFF_WF + al256((size_t)NCHUNK_MAX * 2048 * 2);
constexpr size_t OFF_DEN = OFF_VF + al256((size_t)NCHUNK_MAX * 2048 * 4);
constexpr size_t OFF_MT = OFF_DEN + al256((size_t)MTOK * 8 * 4);
constexpr size_t OFF_BAR = OFF_MT + al256((size_t)MTOK * 8 * 4);
constexpr size_t OFF_XCH = OFF_BAR + al256((3456 + 2048 + 512) * 4);
constexpr size_t OFF_HQ = OFF_XCH + al256((size_t)4 * 128 * 4 * 144 * 8);
constexpr size_t WS_NEED = OFF_HQ + al256((size_t)MTOK * 1024);
static_assert(OFF_S2 + (size_t)128 * MTOK * 8 * 4 <= OFF_O, "alias overflow");
static_assert(OFF_DRY + (size_t)MTOK * 1024 * 6 <= OFF_O, "alias overflow");

constexpr size_t OUT_YP = 0;
constexpr size_t OUT_YS = OUT_YP + (size_t)8 * 2048 * 1024;
constexpr size_t OUT_P_HGRN = OUT_YS + (size_t)128 * 1024;
constexpr size_t OUT_P_GDN = OUT_P_HGRN + (size_t)8 * 8 * 128 * 128;
constexpr size_t OUT_P_CONV = OUT_P_GDN + (size_t)8 * 8 * 128 * 128;
constexpr size_t OUT_P_MC = OUT_P_CONV + (size_t)8 * 3 * 3072;
constexpr size_t OUT_P_MN = OUT_P_MC + (size_t)8 * 8 * 128 * 128;
constexpr size_t OUT_P_MM = OUT_P_MN + (size_t)8 * 8 * 128;
constexpr size_t OUT_P_GLA = OUT_P_MM + (size_t)8 * 8;
constexpr size_t OUT_S_HGRN = OUT_P_GLA + (size_t)8 * 4 * 128 * 256;
constexpr size_t OUT_S_GDN = OUT_S_HGRN + (size_t)128 * 8 * 128 * 128;
constexpr size_t OUT_S_CONV = OUT_S_GDN + (size_t)128 * 8 * 128 * 128;
constexpr size_t OUT_S_MC = OUT_S_CONV + (size_t)128 * 3 * 3072;
constexpr size_t OUT_S_MN = OUT_S_MC + (size_t)128 * 8 * 128 * 128;
constexpr size_t OUT_S_MM = OUT_S_MN + (size_t)128 * 8 * 128;
constexpr size_t OUT_S_GLA = OUT_S_MM + (size_t)128 * 8;
constexpr size_t OUT_TOTAL = OUT_S_GLA + (size_t)128 * 4 * 128 * 256;

struct Params {
    const float* in[37];
    float* out;
    unsigned char* ws;
};

typedef float f32x2 __attribute__((ext_vector_type(2)));
__device__ __forceinline__ unsigned cvt_pk_bf16(float lo, float hi) { const f32x2 v = {lo, hi}; return __builtin_bit_cast(unsigned, __builtin_convertvector(v, bf16x2)); }
__device__ __forceinline__ bf16_t f2bf(float f) { return (bf16_t)(cvt_pk_bf16(f, f) & 0xffffu); }
__device__ __forceinline__ float bf2f(bf16_t h) { return __uint_as_float(((unsigned)h) << 16); }
__device__ __forceinline__ unsigned pack2bf(float lo, float hi) { return cvt_pk_bf16(lo, hi); }
__device__ __forceinline__ float sigmoidf_(float x) { return __builtin_amdgcn_rcpf(1.0f + __expf(-x)); }
__device__ __forceinline__ float siluf_(float x) { return x * __builtin_amdgcn_rcpf(1.0f + __expf(-x)); }
__device__ __forceinline__ float softplusf_(float x) { return fmaxf(x, 0.f) + __logf(1.f + __expf(-fabsf(x))); }
__device__ __forceinline__ float logsigmoidf_(float x) { return -softplusf_(-x); }
__device__ __forceinline__ float wave_sum(float v) {
    v += __shfl_xor(v, 32); v += __shfl_xor(v, 16); v += __shfl_xor(v, 8); v += __shfl_xor(v, 4); v += __shfl_xor(v, 2); v += __shfl_xor(v, 1); return v;
}

__device__ __forceinline__ float dpp_max(float v, int ctrl_sel) {
    const int x = __builtin_bit_cast(int, v);
    int y;
    if (ctrl_sel == 0) y = __builtin_amdgcn_update_dpp(0, x, 0xB1, 0xF, 0xF, true);
    else if (ctrl_sel == 1) y = __builtin_amdgcn_update_dpp(0, x, 0x4E, 0xF, 0xF, true);
    else if (ctrl_sel == 2) y = __builtin_amdgcn_update_dpp(0, x, 0x141, 0xF, 0xF, true);
    else y = __builtin_amdgcn_update_dpp(0, x, 0x140, 0xF, 0xF, true);
    return fmaxf(v, __builtin_bit_cast(float, y));
}
__device__ __forceinline__ float wave_max_u(float v) {
    v = dpp_max(v, 0); v = dpp_max(v, 1); v = dpp_max(v, 2); v = dpp_max(v, 3);
    const int x = __builtin_bit_cast(int, v);
    const float a = __builtin_bit_cast(float, __builtin_amdgcn_readlane(x, 0)), b = __builtin_bit_cast(float, __builtin_amdgcn_readlane(x, 16));
    const float c = __builtin_bit_cast(float, __builtin_amdgcn_readlane(x, 32)), d = __builtin_bit_cast(float, __builtin_amdgcn_readlane(x, 48));
    return fmaxf(fmaxf(a, b), fmaxf(c, d));
}
__device__ __forceinline__ f32x2 ldbf2(const bf16_t* a) { const unsigned w = *(const unsigned*)a; return (f32x2){__uint_as_float(w << 16), __uint_as_float(w & 0xffff0000u)}; }
__device__ __forceinline__ f32x4 ldbf4(const bf16_t* a) { const u32x2 w = *(const u32x2*)a; return (f32x4){__uint_as_float(w.x << 16), __uint_as_float(w.x & 0xffff0000u), __uint_as_float(w.y << 16), __uint_as_float(w.y & 0xffff0000u)}; }
constexpr float XQ_SCALE = 8.0f / 127.0f;
__device__ __forceinline__ unsigned pack_i8x4(float a, float b, float c, float d) {
    const int ia = (int)rintf(fminf(fmaxf(a, -127.f), 127.f)), ib = (int)rintf(fminf(fmaxf(b, -127.f), 127.f));
    const int ic = (int)rintf(fminf(fmaxf(c, -127.f), 127.f)), id = (int)rintf(fminf(fmaxf(d, -127.f), 127.f));
    return (unsigned)(ia & 255) | ((unsigned)(ib & 255) << 8) | ((unsigned)(ic & 255) << 16) | ((unsigned)(id & 255) << 24);
}
__device__ __forceinline__ int opaque_tid() { int t = threadIdx.x; asm volatile("" : "+v"(t)); return t; }
__device__ __forceinline__ unsigned char* opaque_ptr(unsigned char* q) {
    unsigned lo = __builtin_amdgcn_readfirstlane((unsigned)(uintptr_t)q), hi = __builtin_amdgcn_readfirstlane((unsigned)((uintptr_t)q >> 32));
    asm volatile("" : "+s"(lo), "+s"(hi));
    typedef __attribute__((address_space(1))) unsigned char* gptr_t;
    return (unsigned char*)(gptr_t)(((uintptr_t)hi << 32) | (uintptr_t)lo);
}

__device__ __forceinline__ void transpose_convert(const float* __restrict__ W, int nraw, int npad, bf16_t* __restrict__ Wt, float* lds, int base) {
    const int TID = opaque_tid();
    const int tiles_n = npad / 64, tiles = tiles_n * 16, G = gridDim.x;
    const int tx = TID & 63, ty = TID >> 6;
    int tile = ((int)blockIdx.x - base % G + G) % G, buf = 0;
    float v[16];
    if (tile < tiles) {
        const int n = (tile % tiles_n) * 64 + tx, k0 = (tile / tiles_n) * 64;
#pragma unroll
        for (int i = 0; i < 16; ++i) v[i] = (n < nraw) ? W[(size_t)(k0 + ty + 4 * i) * nraw + n] : 0.f;
    }
    for (; tile < tiles; tile += G) {
        float* L = lds + buf * (64 * 65);
#pragma unroll
        for (int i = 0; i < 16; ++i) L[(ty + 4 * i) * 65 + tx] = v[i];
        __syncthreads();
        if (tile + G < tiles) {
            const int n = ((tile + G) % tiles_n) * 64 + tx, k0 = ((tile + G) / tiles_n) * 64;
#pragma unroll
            for (int i = 0; i < 16; ++i) v[i] = (n < nraw) ? W[(size_t)(k0 + ty + 4 * i) * nraw + n] : 0.f;
        }
        bf16_t* dst = Wt + (size_t)((tile % tiles_n) * 64) * 1024 + (tile / tiles_n) * 64;
#pragma unroll
        for (int i = 0; i < 16; ++i) { const int r = ty + 4 * i; dst[(size_t)r * 1024 + tx] = f2bf(L[tx * 65 + r]); }
        buf ^= 1;
    }
    __syncthreads();
}

__device__ __forceinline__ void convert_bf16(const float* __restrict__ src, bf16_t* __restrict__ dst, size_t n) {
    const int TID = opaque_tid();
    const size_t n8 = n / 8;
    for (size_t i = (size_t)blockIdx.x * NTH + TID; i < n8; i += (size_t)gridDim.x * NTH) {
        const f32x4 a = *(const f32x4*)(src + i * 8), b = *(const f32x4*)(src + i * 8 + 4);
        uint4 w; w.x = pack2bf(a[0], a[1]); w.y = pack2bf(a[2], a[3]); w.z = pack2bf(b[0], b[1]); w.w = pack2bf(b[2], b[3]);
        *(uint4*)(dst + i * 8) = w;
    }
}

template <bool AS_INT8>
__device__ __forceinline__ void convert_fp8_rows(const float* __restrict__ src, unsigned char* __restrict__ dst, float* __restrict__ scales, int row_lo, int row_hi, int wrank, int nwaves, int lane) {
    for (int row = row_lo + wrank; row < row_hi; row += 4 * nwaves) {
        f32x4 v[4][4];
#pragma unroll
        for (int u = 0; u < 4; ++u) {
            const int rr = (row + u * nwaves < row_hi) ? row + u * nwaves : row;
            const float* r = src + (size_t)rr * 1024 + lane * 16;
#pragma unroll
            for (int j = 0; j < 4; ++j) v[u][j] = *(const f32x4*)(r + j * 4);
        }
#pragma unroll
        for (int u = 0; u < 4; ++u) {
            const int rr = row + u * nwaves;
            float m = 0.f;
#pragma unroll
            for (int j = 0; j < 4; ++j) m = fmaxf(m, fmaxf(fmaxf(fabsf(v[u][j][0]), fabsf(v[u][j][1])), fmaxf(fabsf(v[u][j][2]), fabsf(v[u][j][3]))));
            m = wave_max_u(m);
            const float sc = (m > 0.f) ? m * (AS_INT8 ? (1.f / 127.f) : (1.f / 448.f)) : 1.f, inv = 1.f / sc;
            u32x4 w;
#pragma unroll
            for (int j = 0; j < 4; ++j) {
                if (AS_INT8) w[j] = pack_i8x4(v[u][j][0] * inv, v[u][j][1] * inv, v[u][j][2] * inv, v[u][j][3] * inv);
                else { int t = 0; t = __builtin_amdgcn_cvt_pk_fp8_f32(v[u][j][0] * inv, v[u][j][1] * inv, t, false); t = __builtin_amdgcn_cvt_pk_fp8_f32(v[u][j][2] * inv, v[u][j][3] * inv, t, true); w[j] = (unsigned)t; }
            }
            if (rr < row_hi) {
                *(u32x4*)(dst + ((size_t)((rr / NEXP) * 8 + (lane >> 3)) * NEXP + (rr % NEXP)) * 128 + (lane & 7) * 16) = w;
                if (lane == 0) scales[rr] = sc;
            }
        }
    }
}

__device__ __forceinline__ void phase_prologue(const Params& p, float* lds) {
    const int TID = opaque_tid();
    unsigned char* ws = opaque_ptr(p.ws);
    bf16_t* win = (bf16_t*)(ws + OFF_WIN);
    transpose_convert(p.in[10], 4096, 4096, win + (size_t)WIN_ROWS0 * 1024, lds, 0);
    transpose_convert(p.in[14], 4112, 4352, win + (size_t)WIN_ROWS1 * 1024, lds, 1024);
    transpose_convert(p.in[20], 4112, 4352, win + (size_t)WIN_ROWS2 * 1024, lds, 2112);
    transpose_convert(p.in[25], 3088, 3328, win + (size_t)WIN_ROWS3 * 1024, lds, 3200);
    bf16_t* wout = (bf16_t*)(ws + OFF_WOUT);
    transpose_convert(p.in[13], 1024, 1024, wout + (size_t)0 * 1024 * 1024, lds, 4032);
    transpose_convert(p.in[19], 1024, 1024, wout + (size_t)1 * 1024 * 1024, lds, 4288);
    transpose_convert(p.in[24], 1024, 1024, wout + (size_t)2 * 1024 * 1024, lds, 4544);
    transpose_convert(p.in[29], 1024, 1024, wout + (size_t)3 * 1024 * 1024, lds, 4800);
    bf16_t* wq = (bf16_t*)(ws + OFF_WQ);
    for (int l = 0; l < 4; ++l) transpose_convert(p.in[30] + (size_t)l * 1024 * 2048, 2048, 2048, wq + (size_t)l * 2048 * 1024, lds, 5056 + l * 512);
    bf16_t* keys = (bf16_t*)(ws + OFF_KEYS);
    for (int l = 0; l < 4; ++l) {
        convert_bf16(p.in[31] + (size_t)l * 16384, keys + (size_t)(l * 2 + 0) * 16384, 16384);
        convert_bf16(p.in[32] + (size_t)l * 16384, keys + (size_t)(l * 2 + 1) * 16384, 16384);
    }
    float* lb = (float*)(ws + OFF_LB);
    for (int c = blockIdx.x * NTH + TID; c < 1024; c += gridDim.x * NTH) {
        const float* L = p.in[11];
        float mx = L[c];
        for (int j = 1; j < 5; ++j) mx = fmaxf(mx, L[j * 1024 + c]);
        float s = 0.f;
        for (int j = 0; j < 5; ++j) s += expf(L[j * 1024 + c] - mx);
        lb[c] = expf(L[c] - mx) / s;
    }
    bf16_t* Hb = (bf16_t*)(ws + OFF_HB);
    const size_t nvec = (size_t)MTOK * 256;
    for (size_t i = (size_t)blockIdx.x * NTH + TID; i < nvec; i += (size_t)gridDim.x * NTH) {
        const int row = (int)(i >> 8), c4 = (int)(i & 255) * 4;
        const float* src;
        if (row < ROWS_P) { const int b = row / T_P, t = row % T_P; src = (t < 16) ? p.in[9] + (size_t)t * 1024 : p.in[0] + ((size_t)b * 2048 + (t - 16)) * 1024; }
        else src = p.in[1] + (size_t)(row - ROWS_P) * 1024;
        const f32x4 v = *(const f32x4*)(src + c4);
        uint2 w; w.x = pack2bf(v[0], v[1]); w.y = pack2bf(v[2], v[3]);
        *(uint2*)(Hb + (size_t)row * 1024 + c4) = w;
    }
}

#define GEMM_WAIT(n) asm volatile("s_waitcnt vmcnt(" #n ")" ::: "memory")
template <bool OUT_BF16, bool TILED = false, bool DUAL = false>
__device__ __forceinline__ void gemm_phase(const bf16_t* __restrict__ A, int lda, const bf16_t* __restrict__ Bt, int ldb, void* __restrict__ Cv0, int ldc,
                           int M, int N, int K, unsigned char* lds, size_t a2 = 0, size_t b2 = 0, size_t c2 = 0) {
    const int TID = opaque_tid();
    constexpr int BMA = 256, BNB = 128, BK = 32, STG = 24576;
    const int tid = TID, wid = tid >> 6, lane = tid & 63, wr = wid >> 1, wc = wid & 1, fr = lane & 15, fq = lane >> 4;
    const int tn = N / BNB, tiles = (M / BMA) * tn * (DUAL ? 2 : 1), nk = K / BK;
    const int sr = tid >> 2, scc = (((tid & 3) ^ ((0 - (tid >> 4)) & 3)) * 8);
    const int rsw = (0 - (fr >> 2)) & 3;
    const int aoff = (wr * 128 + fr) * 64 + ((fq ^ rsw) * 16), boff = 16384 + (wc * 64 + fr) * 64 + ((fq ^ rsw) * 16);
    for (int tile_ = blockIdx.x; tile_ < tiles; tile_ += gridDim.x) {
        const int half = DUAL ? (tile_ & 1) : 0, tile = DUAL ? (tile_ >> 1) : tile_;
        void* Cv = (unsigned char*)Cv0 + (size_t)half * c2;
        const int brow = (tile / tn) * BMA, bcol = (tile % tn) * BNB;
        f32x4 acc[8][4];
#pragma unroll
        for (int m = 0; m < 8; ++m)
#pragma unroll
            for (int n = 0; n < 4; ++n) acc[m][n] = (f32x4){0.f, 0.f, 0.f, 0.f};
        const bf16_t* ga = A + (size_t)half * a2 + (size_t)(brow + sr) * lda + scc;
        const bf16_t* gb = Bt + (size_t)half * b2 + (size_t)(bcol + sr) * ldb + scc;
#define GEMM_STAGE(kt_) do { unsigned char* sb_ = lds + ((kt_) % 3) * STG + tid * 16; \
            __builtin_amdgcn_global_load_lds((const unsigned*)(ga + (kt_) * BK), (LDSP unsigned*)(sb_), 16, 0, 0); \
            __builtin_amdgcn_global_load_lds((const unsigned*)(ga + (size_t)64 * lda + (kt_) * BK), (LDSP unsigned*)(sb_ + 4096), 16, 0, 0); \
            __builtin_amdgcn_global_load_lds((const unsigned*)(ga + (size_t)128 * lda + (kt_) * BK), (LDSP unsigned*)(sb_ + 8192), 16, 0, 0); \
            __builtin_amdgcn_global_load_lds((const unsigned*)(ga + (size_t)192 * lda + (kt_) * BK), (LDSP unsigned*)(sb_ + 12288), 16, 0, 0); \
            __builtin_amdgcn_global_load_lds((const unsigned*)(gb + (kt_) * BK), (LDSP unsigned*)(sb_ + 16384), 16, 0, 0); \
            __builtin_amdgcn_global_load_lds((const unsigned*)(gb + (size_t)64 * ldb + (kt_) * BK), (LDSP unsigned*)(sb_ + 20480), 16, 0, 0); } while (0)
        asm volatile("s_waitcnt lgkmcnt(0)" ::: "memory"); __builtin_amdgcn_s_barrier();
        GEMM_STAGE(0);
        if (nk > 1) GEMM_STAGE(1);
        for (int kt = 0; kt < nk; ++kt) {
            if (kt + 1 < nk) GEMM_WAIT(6); else GEMM_WAIT(0);
            asm volatile("s_waitcnt lgkmcnt(0)" ::: "memory"); __builtin_amdgcn_s_barrier();
            if (kt + 2 < nk) GEMM_STAGE(kt + 2);
            const unsigned char* st = lds + (kt % 3) * STG;
            bf16x8 At[8], Bl[4];
#pragma unroll
            for (int n = 0; n < 4; ++n) Bl[n] = *(const bf16x8*)(st + boff + n * 1024);
#pragma unroll
            for (int m = 0; m < 8; ++m) At[m] = *(const bf16x8*)(st + aoff + m * 1024);
#pragma unroll
            for (int m = 0; m < 8; ++m)
#pragma unroll
                for (int n = 0; n < 4; ++n) acc[m][n] = __builtin_amdgcn_mfma_f32_16x16x32_bf16(At[m], Bl[n], acc[m][n], 0, 0, 0);
        }
#undef GEMM_STAGE
#pragma unroll
        for (int n = 0; n < 4; ++n) {
            const size_t base = TILED ? (size_t)(brow + wr * 128) * N + (size_t)(bcol + wc * 64 + n * 16 + fr) * 128 + fq * 4
                                      : (size_t)(bcol + wc * 64 + n * 16 + fr) * ldc + brow + wr * 128 + fq * 4;
#pragma unroll
            for (int m = 0; m < 8; ++m) {
                if (OUT_BF16) { uint2 w; w.x = pack2bf(acc[m][n][0], acc[m][n][1]); w.y = pack2bf(acc[m][n][2], acc[m][n][3]); *(uint2*)((bf16_t*)Cv + base + m * 16) = w; }
                else *(f32x4*)((float*)Cv + base + m * 16) = acc[m][n];
            }
        }
    }
    asm volatile("s_waitcnt vmcnt(0) lgkmcnt(0)" ::: "memory");
    __syncthreads();
}

struct LnEpi { float* H; bf16_t* Hb; unsigned char* Hq; const float* g; const float* b; unsigned long long* xch; unsigned* cnt; };
template <bool OUT_BF16, bool EPI_LN = false>
__device__ __forceinline__ void gemm130_phase(const bf16_t* __restrict__ W, const bf16_t* __restrict__ X, void* __restrict__ Cv, int ldc, int NF, int K, unsigned char* lds, LnEpi le = LnEpi{}, int gap_at = 1 << 30) {
    const int TID = opaque_tid();
    constexpr int BK = 32, STG = 25600;
    const int tid = TID, wid = __builtin_amdgcn_readfirstlane(tid >> 6), lane = tid & 63, fr = lane & 15, fq = lane >> 4;
    const int tiles = (NF / 256) * 128, nk = K / BK;
    const int sr = tid >> 2, scc = (((tid & 3) ^ ((0 - (tid >> 4)) & 3)) * 8);
    const int rsw = (0 - (fr >> 2)) & 3;
    const int aoff = (wid * 64 + fr) * 64 + ((fq ^ rsw) * 16), boff = 16384 + fr * 64 + ((fq ^ rsw) * 16);
    for (int tile = blockIdx.x; tile < tiles; tile += gridDim.x) {
        const int brow0 = (tile >> 7) * 256, brow = brow0 + ((brow0 >= gap_at) ? 16 : 0), tok0 = (tile & 127) * 130;
        f32x4 acc[4][9];
#pragma unroll
        for (int m = 0; m < 4; ++m)
#pragma unroll
            for (int n = 0; n < 9; ++n) acc[m][n] = (f32x4){0.f, 0.f, 0.f, 0.f};
        const bf16_t* ga = W + (size_t)(brow + sr) * K + scc;
        const bf16_t* gb0 = X + (size_t)(tok0 + sr) * K + scc;
        const bf16_t* gb1 = X + (size_t)(tok0 + 64 + sr) * K + scc;
        const int r2 = 128 + sr; const bf16_t* gb2 = X + (size_t)(tok0 + (r2 < 130 ? r2 : 129)) * K + scc;
#define G130_STAGE(kt_) do { unsigned char* sb_ = lds + ((kt_) % 3) * STG + tid * 16; \
            __builtin_amdgcn_global_load_lds((const unsigned*)(ga + (kt_) * BK), (LDSP unsigned*)(sb_), 16, 0, 0); \
            __builtin_amdgcn_global_load_lds((const unsigned*)(ga + (size_t)64 * K + (kt_) * BK), (LDSP unsigned*)(sb_ + 4096), 16, 0, 0); \
            __builtin_amdgcn_global_load_lds((const unsigned*)(ga + (size_t)128 * K + (kt_) * BK), (LDSP unsigned*)(sb_ + 8192), 16, 0, 0); \
            __builtin_amdgcn_global_load_lds((const unsigned*)(ga + (size_t)192 * K + (kt_) * BK), (LDSP unsigned*)(sb_ + 12288), 16, 0, 0); \
            __builtin_amdgcn_global_load_lds((const unsigned*)(gb0 + (kt_) * BK), (LDSP unsigned*)(sb_ + 16384), 16, 0, 0); \
            __builtin_amdgcn_global_load_lds((const unsigned*)(gb1 + (kt_) * BK), (LDSP unsigned*)(sb_ + 20480), 16, 0, 0); \
            if (wid == 0) __builtin_amdgcn_global_load_lds((const unsigned*)(gb2 + (kt_) * BK), (LDSP unsigned*)(sb_ + 24576), 16, 0, 0); } while (0)
        asm volatile("s_waitcnt lgkmcnt(0)" ::: "memory"); __builtin_amdgcn_s_barrier();
        G130_STAGE(0);
        if (nk > 1) G130_STAGE(1);
#pragma unroll 1
        for (int kt = 0; kt < nk; ++kt) {
            if (kt + 1 < nk) { if (wid == 0) GEMM_WAIT(7); else GEMM_WAIT(6); } else GEMM_WAIT(0);
            asm volatile("s_waitcnt lgkmcnt(0)" ::: "memory"); __builtin_amdgcn_s_barrier();
            if (kt + 2 < nk) G130_STAGE(kt + 2);
            const unsigned char* st = lds + (kt % 3) * STG;
            bf16x8 At[4];
#pragma unroll
            for (int m = 0; m < 4; ++m) At[m] = *(const bf16x8*)(st + aoff + m * 1024);
            __builtin_amdgcn_s_setprio(1);
#pragma unroll
            for (int n = 0; n < 9; ++n) {
                const bf16x8 Bl = *(const bf16x8*)(st + boff + n * 1024);
#pragma unroll
                for (int m = 0; m < 4; ++m) acc[m][n] = __builtin_amdgcn_mfma_f32_16x16x32_bf16(At[m], Bl, acc[m][n], 0, 0, 0);
            }
            __builtin_amdgcn_s_setprio(0);
        }
#undef G130_STAGE
        if (EPI_LN) {
            const int tt = tile & 127, ft = tile >> 7;
            float* stat = (float*)lds;
            __syncthreads();
#pragma unroll
            for (int n = 0; n < 9; ++n) {
                const bool ok = (n < 8) || (fr < 2);
                const size_t base = (size_t)(tok0 + (ok ? n * 16 + fr : 0)) * 1024 + brow + wid * 64 + fq * 4;
                float a1 = 0.f, a2 = 0.f;
#pragma unroll
                for (int m = 0; m < 4; ++m) {
                    const u32x2 hw_ = *(const u32x2*)(le.Hb + base + m * 16);
                    const f32x4 hv = (f32x4){__uint_as_float(hw_.x << 16), __uint_as_float(hw_.x & 0xffff0000u), __uint_as_float(hw_.y << 16), __uint_as_float(hw_.y & 0xffff0000u)};
                    acc[m][n] = acc[m][n] + hv * DN_ALPHA;
                    a1 += (acc[m][n][0] + acc[m][n][1]) + (acc[m][n][2] + acc[m][n][3]);
                    a2 += (acc[m][n][0] * acc[m][n][0] + acc[m][n][1] * acc[m][n][1]) + (acc[m][n][2] * acc[m][n][2] + acc[m][n][3] * acc[m][n][3]);
                }
                a1 += __shfl_xor(a1, 16); a1 += __shfl_xor(a1, 32); a2 += __shfl_xor(a2, 16); a2 += __shfl_xor(a2, 32);
                if (fq == 0) { stat[(wid * 144 + n * 16 + fr) * 2] = a1; stat[(wid * 144 + n * 16 + fr) * 2 + 1] = a2; }
                asm volatile("" ::: "memory");
            }
            __syncthreads();
            unsigned long long* slot = le.xch + ((size_t)tt * 4) * 144;
            if (tid < 144) {
                const float p1 = (stat[tid * 2] + stat[(144 + tid) * 2]) + (stat[(288 + tid) * 2] + stat[(432 + tid) * 2]);
                const float p2 = (stat[tid * 2 + 1] + stat[(144 + tid) * 2 + 1]) + (stat[(288 + tid) * 2 + 1] + stat[(432 + tid) * 2 + 1]);
                __hip_atomic_store(slot + (size_t)ft * 144 + tid, ((unsigned long long)__float_as_uint(p2) << 32) | __float_as_uint(p1), __ATOMIC_RELAXED, __HIP_MEMORY_SCOPE_AGENT);
            }
            asm volatile("s_waitcnt vmcnt(0)" ::: "memory");
            __syncthreads();
            if (tid == 0) {
                __hip_atomic_fetch_add(le.cnt + tt, 1u, __ATOMIC_RELAXED, __HIP_MEMORY_SCOPE_AGENT);
                unsigned sp = 0;
                while (__hip_atomic_load(le.cnt + tt, __ATOMIC_RELAXED, __HIP_MEMORY_SCOPE_AGENT) < 4u) { __builtin_amdgcn_s_sleep(1); if (++sp > (1u << 22)) break; }
                __builtin_amdgcn_fence(__ATOMIC_ACQUIRE, "agent");
                asm volatile("s_waitcnt vmcnt(0)" ::: "memory");
            }
            __syncthreads();
            float* mr = stat + 1152;
            if (tid < 144) {
                float t1 = 0.f, t2 = 0.f;
#pragma unroll
                for (int f = 0; f < 4; ++f) { const unsigned long long w = __hip_atomic_load(slot + (size_t)f * 144 + tid, __ATOMIC_RELAXED, __HIP_MEMORY_SCOPE_AGENT); t1 += __uint_as_float((unsigned)w); t2 += __uint_as_float((unsigned)(w >> 32)); }
                const float mean = t1 * (1.f / 1024.f), var = t2 * (1.f / 1024.f) - mean * mean;
                mr[tid * 2] = mean; mr[tid * 2 + 1] = rsqrtf(fmaxf(var, 0.f) + 1e-5f);
            }
            __syncthreads();
#pragma unroll
            for (int n = 0; n < 9; ++n) {
                const bool ok = (n < 8) || (fr < 2);
                const size_t base = (size_t)(tok0 + (ok ? n * 16 + fr : 0)) * 1024 + brow + wid * 64 + fq * 4;
                const float mean = mr[(n * 16 + fr) * 2], rs = mr[(n * 16 + fr) * 2 + 1];
#pragma unroll
                for (int m = 0; m < 4; ++m) {
                    const f32x4 gvm = *(const f32x4*)(le.g + brow + wid * 64 + m * 16 + fq * 4), bvm = *(const f32x4*)(le.b + brow + wid * 64 + m * 16 + fq * 4);
                    const f32x4 o = (acc[m][n] - mean) * rs * gvm + bvm;
                    if (ok) { u32x2 w; w.x = cvt_pk_bf16(o[0], o[1]); w.y = cvt_pk_bf16(o[2], o[3]); *(u32x2*)(le.Hb + base + m * 16) = w;
                              *(unsigned*)(le.Hq + base + m * 16) = pack_i8x4(o[0] * (1.f / XQ_SCALE), o[1] * (1.f / XQ_SCALE), o[2] * (1.f / XQ_SCALE), o[3] * (1.f / XQ_SCALE)); }
                }
                asm volatile("" ::: "memory");
            }
        } else
#pragma unroll
        for (int n = 0; n < 9; ++n) {
            const bool ok = (n < 8) || (fr < 2);
            const size_t base = (size_t)(tok0 + (ok ? n * 16 + fr : 0)) * ldc + brow + wid * 64 + fq * 4;
#pragma unroll
            for (int m = 0; m < 4; ++m) {
                const f32x4 v = acc[m][n];
                if (OUT_BF16) { u32x2 w; w.x = cvt_pk_bf16(v[0], v[1]); w.y = cvt_pk_bf16(v[2], v[3]); if (ok) *(u32x2*)((bf16_t*)Cv + base + m * 16) = w; }
                else { if (ok) *(f32x4*)((float*)Cv + base + m * 16) = v; }
            }
            asm volatile("" ::: "memory");
        }
    }
    asm volatile("s_waitcnt vmcnt(0) lgkmcnt(0)" ::: "memory");
    __syncthreads();
}

__device__ __forceinline__ void skinny16_phase(const bf16_t* __restrict__ W16, const bf16_t* __restrict__ X, float* __restrict__ C, int ldc) {
    const int TID = opaque_tid();
    const int wave = TID >> 6, lane = TID & 63, q = lane >> 4, c = lane & 15;
    for (int t = blockIdx.x + wave * gridDim.x; t < MTOK / 16; t += gridDim.x * 4) {
        const bf16_t* wa = W16 + (size_t)c * 1024 + q * 8;
        const bf16_t* xb = X + (size_t)(t * 16 + c) * 1024 + q * 8;
        f32x4 acc0 = (f32x4){0.f, 0.f, 0.f, 0.f}, acc1 = (f32x4){0.f, 0.f, 0.f, 0.f};
#pragma unroll 1
        for (int k0 = 0; k0 < 1024; k0 += 512) {
            bf16x8 a[16], b[16];
#pragma unroll
            for (int j = 0; j < 16; ++j) { a[j] = *(const bf16x8*)(wa + k0 + j * 32); b[j] = *(const bf16x8*)(xb + k0 + j * 32); }
#pragma unroll
            for (int j = 0; j < 16; j += 2) {
                acc0 = __builtin_amdgcn_mfma_f32_16x16x32_bf16(a[j], b[j], acc0, 0, 0, 0);
                acc1 = __builtin_amdgcn_mfma_f32_16x16x32_bf16(a[j + 1], b[j + 1], acc1, 0, 0, 0);
            }
        }
        *(f32x4*)(C + (size_t)(t * 16 + c) * ldc + 4 * q) = acc0 + acc1;
    }
}

constexpr int NCH = 129;
constexpr int QS = 132;
__device__ __forceinline__ f32x4 mfma16(bf16x4 a, bf16x4 b, f32x4 c, int, int, int) {
    const bf16x8 a8 = {a[0], a[1], a[2], a[3], 0, 0, 0, 0}, b8 = {b[0], b[1], b[2], b[3], 0, 0, 0, 0};
    return __builtin_amdgcn_mfma_f32_16x16x32_bf16(a8, b8, c, 0, 0, 0);
}
__device__ __forceinline__ int qf_index(int t, int k) { const int m = k >> 5, kk = k & 31, half = kk >> 4, rem = kk & 15, q = rem >> 2, j = (rem & 3) + 4 * half; return (m * 64 + q * 16 + t) * 8 + j; }
__device__ __forceinline__ int kf_index(int t, int k) { return (((t >> 2) * 16 + (k & 15)) * 8 + (k >> 4)) * 4 + (t & 3); }
__device__ __forceinline__ int af_index(int t, int s_) { return ((s_ >> 2) * 16 + t) * 4 + (s_ & 3); }
__device__ __forceinline__ int vf_index(int t, int v) { return ((v >> 4) * 64 + (t >> 2) * 16 + (v & 15)) * 4 + (t & 3); }

template <int MIX>
__device__ __forceinline__ void stage_qk(const Params& p, const float* __restrict__ P, const float* __restrict__ lbv, float* qs, float* ks, float* fs, float* sc,
                                         int tid, int h, int row0, int t0, int nt, bool has_init, int sseq) {
    const int tt = tid >> 4, d0 = (tid & 15) * 8;
    if (tt < nt) {
        const int t = t0 + tt; const float* Pr = P + (size_t)(row0 + t) * PLD;
        if (MIX == 0) {
#pragma unroll
            for (int j = 0; j < 8; ++j) {
                const int d = d0 + j, cc = h * 128 + d;
                const float qr = Pr[cc], fr_ = Pr[1024 + cc], lb = lbv[cc];
                const float fg = lb + (1.f - lb) * sigmoidf_(fr_);
                qs[tt * QS + d] = siluf_(qr); ks[tt * QS + d] = 1.f - fg; fs[tt * QS + d] = logf(fg);
            }
        } else if (MIX == 1) {
            const float* cw = p.in[15]; const float* cbuf = p.in[4];
            float sq = 0.f, sk = 0.f;
#pragma unroll 1
            for (int j = 0; j < 8; ++j) {
                const int cq = h * 128 + d0 + j, ck = 1024 + cq;
                float yq = 0.f, yk = 0.f;
#pragma unroll
                for (int w = 0; w < 4; ++w) {
                    const int tp = t - 3 + w; float xq, xk;
                    if (tp >= 0) { xq = P[(size_t)(row0 + tp) * PLD + cq]; xk = P[(size_t)(row0 + tp) * PLD + ck]; }
                    else if (has_init) { xq = cbuf[((size_t)sseq * 3 + (3 + tp)) * 3072 + cq]; xk = cbuf[((size_t)sseq * 3 + (3 + tp)) * 3072 + ck]; }
                    else { xq = 0.f; xk = 0.f; }
                    yq += cw[w * 3072 + cq] * xq; yk += cw[w * 3072 + ck] * xk;
                }
                const float qv = siluf_(yq), kv = siluf_(yk);
                sq += qv * qv; sk += kv * kv;
                qs[tt * QS + d0 + j] = qv; ks[tt * QS + d0 + j] = kv;
            }
            sq += __shfl_xor(sq, 1); sq += __shfl_xor(sq, 2); sq += __shfl_xor(sq, 4); sq += __shfl_xor(sq, 8);
            sk += __shfl_xor(sk, 1); sk += __shfl_xor(sk, 2); sk += __shfl_xor(sk, 4); sk += __shfl_xor(sk, 8);
            const float rq = rsqrtf(sq + 1e-6f) * 0.08838834764831845f, rk = rsqrtf(sk + 1e-6f);
#pragma unroll 1
            for (int j = 0; j < 8; ++j) { qs[tt * QS + d0 + j] *= rq; ks[tt * QS + d0 + j] *= rk; }
            if ((tid & 15) == 0) {
                const float ar = Pr[3072 + h], br = Pr[3080 + h];
                sc[tt * 2] = -expf(p.in[16][h]) * softplusf_(ar + p.in[17][h]);
                sc[tt * 2 + 1] = sigmoidf_(br);
            }
        } else if (MIX == 2) {
#pragma unroll
            for (int j = 0; j < 8; ++j) {
                const int d = d0 + j, cc = h * 128 + d;
                qs[tt * QS + d] = Pr[cc]; ks[tt * QS + d] = Pr[1024 + cc] * 0.08838834764831845f;
            }
            if ((tid & 15) == 0) {
                sc[tt * 2] = Pr[3072 + h] + p.in[21][h];
                sc[tt * 2 + 1] = logsigmoidf_(Pr[3080 + h] + p.in[22][h]);
            }
        } else {
            const float* wg = p.in[26]; const float* bg = p.in[27];
            float rr[16];
#pragma unroll
            for (int j = 0; j < 16; ++j) rr[j] = Pr[3072 + j];
#pragma unroll
            for (int j = 0; j < 8; ++j) {
                const int d = d0 + j, cc = h * 128 + d;
                float pre = bg[cc];
#pragma unroll
                for (int q = 0; q < 16; ++q) pre += rr[q] * wg[q * 512 + cc];
                qs[tt * QS + d] = Pr[cc] * 0.08838834764831845f; ks[tt * QS + d] = Pr[512 + cc];
                fs[tt * QS + d] = logsigmoidf_(pre) * 0.0625f;
            }
        }
    }
}

template <int MIX>
__device__ __forceinline__ float load_v(const Params& p, const float* __restrict__ P, int row0, int t, int cv, bool has_init, int sseq) {
    if (MIX == 1) {
        const float* cw = p.in[15]; const float* cbuf = p.in[4];
        float y = 0.f;
#pragma unroll
        for (int w = 0; w < 4; ++w) {
            const int tp = t - 3 + w; float x;
            if (tp >= 0) x = P[(size_t)(row0 + tp) * PLD + cv];
            else if (has_init) x = cbuf[((size_t)sseq * 3 + (3 + tp)) * 3072 + cv];
            else x = 0.f;
            y += cw[w * 3072 + cv] * x;
        }
        return siluf_(y);
    }
    return P[(size_t)(row0 + t) * PLD + cv];
}

template <int MIX>
__device__ __forceinline__ void scan_sample_item(const Params& p, float* lds, int tid, int item) {
    unsigned char* ws = opaque_ptr(p.ws);
    const float* P = (const float*)(ws + OFF_P);
    float* O = (float*)(ws + OFF_O);
    const float* lbv = (const float*)(ws + OFF_LB);
    float* qs = lds; float* ks = lds + 16 * QS; float* fs = lds + 32 * QS; float* vs = lds + 48 * QS; float* sc = lds + 64 * QS;
    const int wave = tid >> 6, lane = tid & 63, g = lane >> 4, c = lane & 15;
    constexpr int DV = (MIX == 3) ? 256 : 128;
    constexpr int NH = (MIX == 3) ? 4 : 8;
    constexpr int VG = DV / 64;
    constexpr int VBASE = (MIX == 3) ? 1024 : 2048;
    const int sseq = item >> 4, sub = item & 15, h = sub / VG, vg = sub % VG;
    const int row0 = ROWS_P + sseq;
    const int vcol = vg * 64 + wave * 16 + c;
    float s[32];
    const float* init_S = (MIX == 0) ? p.in[2] : (MIX == 1) ? p.in[3] : (MIX == 2) ? p.in[5] : p.in[8];
    float* out_S = p.out + ((MIX == 0) ? OUT_S_HGRN : (MIX == 1) ? OUT_S_GDN : (MIX == 2) ? OUT_S_MC : OUT_S_GLA);
    const size_t st_off = ((size_t)sseq * NH + h) * 128 * DV;
#pragma unroll
    for (int i = 0; i < 32; ++i) s[i] = init_S[st_off + (size_t)(g * 32 + i) * DV + vcol];
    float nn0 = 0.f, nn1 = 0.f, mrun = 0.f;
    if (MIX == 2) {
        nn0 = p.in[6][((size_t)sseq * 8 + h) * 128 + 2 * lane]; nn1 = p.in[6][((size_t)sseq * 8 + h) * 128 + 2 * lane + 1];
        mrun = p.in[7][(size_t)sseq * 8 + h];
    }
    __syncthreads();
    stage_qk<MIX>(p, P, lbv, qs, ks, fs, sc, tid, h, row0, 0, 1, true, sseq);
    if (tid < 64) vs[tid] = load_v<MIX>(p, P, row0, 0, VBASE + h * DV + vg * 64 + tid, true, sseq);
    __syncthreads();
    {
        const float vv = vs[wave * 16 + c];
        const f32x4* q4 = (const f32x4*)(qs + g * 32);
        const f32x4* k4 = (const f32x4*)(ks + g * 32);
        const f32x4* f4 = (const f32x4*)(fs + g * 32);
        float o = 0.f;
        if (MIX == 0 || MIX == 3) {
#pragma unroll
            for (int i4 = 0; i4 < 8; ++i4) {
                const f32x4 qq = q4[i4], kk = k4[i4], ff = f4[i4];
#pragma unroll
                for (int j = 0; j < 4; ++j) { const int i = i4 * 4 + j; s[i] = expf(ff[j]) * s[i] + kk[j] * vv; o += qq[j] * s[i]; }
            }
            o += __shfl_xor(o, 16); o += __shfl_xor(o, 32);
        } else if (MIX == 1) {
            const float a = expf(sc[0]), beta = sc[1];
            float r = 0.f;
#pragma unroll
            for (int i4 = 0; i4 < 8; ++i4) {
                const f32x4 kk = k4[i4];
#pragma unroll
                for (int j = 0; j < 4; ++j) { const int i = i4 * 4 + j; s[i] *= a; r += kk[j] * s[i]; }
            }
            r += __shfl_xor(r, 16); r += __shfl_xor(r, 32);
            const float vn = beta * (vv - r);
#pragma unroll
            for (int i4 = 0; i4 < 8; ++i4) {
                const f32x4 qq = q4[i4], kk = k4[i4];
#pragma unroll
                for (int j = 0; j < 4; ++j) { const int i = i4 * 4 + j; s[i] += kk[j] * vn; o += qq[j] * s[i]; }
            }
            o += __shfl_xor(o, 16); o += __shfl_xor(o, 32);
        } else {
            const float li = sc[0], lf = sc[1];
            const float mn = fmaxf(lf + mrun, li);
            const float a = expf(lf + mrun - mn), w = expf(li - mn);
            mrun = mn;
            const float wv = w * vv;
#pragma unroll
            for (int i4 = 0; i4 < 8; ++i4) {
                const f32x4 qq = q4[i4], kk = k4[i4];
#pragma unroll
                for (int j = 0; j < 4; ++j) { const int i = i4 * 4 + j; s[i] = a * s[i] + kk[j] * wv; o += qq[j] * s[i]; }
            }
            o += __shfl_xor(o, 16); o += __shfl_xor(o, 32);
            const float k0 = ks[2 * lane], k1 = ks[2 * lane + 1];
            const float q0 = qs[2 * lane], q1 = qs[2 * lane + 1];
            nn0 = a * nn0 + w * k0; nn1 = a * nn1 + w * k1;
            const float den = wave_sum(q0 * nn0 + q1 * nn1);
            o = o / fmaxf(fabsf(den), expf(-mn));
        }
        if (g == 0) O[(size_t)row0 * 1024 + sub * 64 + wave * 16 + c] = o;
    }
#pragma unroll
    for (int i = 0; i < 32; ++i) out_S[st_off + (size_t)(g * 32 + i) * DV + vcol] = s[i];
    if (MIX == 2 && vg == 0 && wave == 0) {
        float* on = p.out + OUT_S_MN + ((size_t)sseq * 8 + h) * 128;
        on[2 * lane] = nn0; on[2 * lane + 1] = nn1;
        if (lane == 0) {
            p.out[OUT_S_MM + (size_t)sseq * 8 + h] = mrun;
            ((float*)(ws + OFF_DEN))[(size_t)row0 * 8 + h] = 1.f;
            ((float*)(ws + OFF_MT))[(size_t)row0 * 8 + h] = 100.f;
        }
    }
}

template <int MIX>
__device__ __forceinline__ void prepass_chunk(const Params& p, float* lds, int tid, int item) {
    unsigned char* ws = opaque_ptr(p.ws);
    const float* P = (const float*)(ws + OFF_P);
    const float* lbv = (const float*)(ws + OFF_LB);
    float* qs = lds; float* ks = lds + 16 * QS; float* fs = lds + 32 * QS; float* vs = lds + 48 * QS; float* sc = lds + 64 * QS;
    float* nm = sc + 32;
    constexpr int DV = (MIX == 3) ? 256 : 128;
    constexpr int NH = (MIX == 3) ? 4 : 8;
    constexpr int VBASE = (MIX == 3) ? 1024 : 2048;
    const int ci = item, ch = item % NCH, bh = item / NCH, h = bh % NH, b = bh / NH;
    const int row0 = b * T_P, t0 = ch * 16;
    bf16_t* QF = (bf16_t*)(ws + OFF_QF) + (size_t)ci * 2048;
    bf16_t* KF = (bf16_t*)(ws + OFF_KF) + (size_t)ci * 2048;
    bf16_t* WF = (bf16_t*)(ws + OFF_WF) + (size_t)ci * 2048;
    float* DF = (float*)(ws + OFF_DF) + (size_t)ci * 128;
    __syncthreads();
    stage_qk<MIX>(p, P, lbv, qs, ks, fs, sc, tid, h, row0, t0, 16, false, 0);
    if (MIX == 1) {
        for (int e = tid; e < 16 * 128; e += NTH) { const int tt = e >> 7, col = e & 127; vs[tt * QS + col] = load_v<1>(p, P, row0, t0 + tt, VBASE + h * 128 + col, false, 0); }
    }
    __syncthreads();
    if (MIX == 0 || MIX == 3) {
        if (tid < 128) { float bb = 0.f;
#pragma unroll
            for (int t = 0; t < 16; ++t) { bb += fs[t * QS + tid]; fs[t * QS + tid] = bb; } }
        __syncthreads();
        for (int e = tid; e < 512; e += NTH) {
            const int t = e >> 5, k0 = (e & 31) * 4;
            float qv[4];
#pragma unroll
            for (int j = 0; j < 4; ++j) { const float bb = fs[t * QS + k0 + j]; qv[j] = qs[t * QS + k0 + j] * expf(bb); }
            u32x2 w; w.x = cvt_pk_bf16(qv[0], qv[1]); w.y = cvt_pk_bf16(qv[2], qv[3]);
            *(u32x2*)(QF + qf_index(t, k0)) = w;
#pragma unroll
            for (int j = 0; j < 4; ++j) qs[t * QS + k0 + j] = qv[j];
        }
        for (int e = tid; e < 512; e += NTH) {
            const int k = e & 127, tq = e >> 7;
            const float be = fs[15 * QS + k];
            float kv[4];
#pragma unroll
            for (int j = 0; j < 4; ++j) { const int t = tq * 4 + j; kv[j] = ks[t * QS + k] * expf(be - fs[t * QS + k]); }
            u32x2 w; w.x = cvt_pk_bf16(kv[0], kv[1]); w.y = cvt_pk_bf16(kv[2], kv[3]);
            *(u32x2*)(KF + kf_index(tq * 4, k)) = w;
        }
        if (tid < 128) { const int k = tid; DF[((k >> 2) & 3) * 32 + (k >> 4) * 4 + (k & 3)] = expf(fs[15 * QS + k]); }
        __syncthreads();
        for (int e = tid; e < 2048; e += NTH) { const int t = e >> 7, k = e & 127; ks[t * QS + k] *= expf(-fs[t * QS + k]); }
        __syncthreads();
        {
            const int t = tid >> 4, s_ = tid & 15;
            const f32x4* a4 = (const f32x4*)(qs + t * QS); const f32x4* b4 = (const f32x4*)(ks + s_ * QS);
            float acc = 0.f;
#pragma unroll 8
            for (int i = 0; i < 32; ++i) { const f32x4 x = a4[i], y = b4[i]; acc += x[0] * y[0] + x[1] * y[1] + x[2] * y[2] + x[3] * y[3]; }
            ((bf16_t*)(ws + OFF_AF))[(size_t)ci * 512 + af_index(t, s_)] = f2bf(s_ <= t ? acc : 0.f);
        }
    } else if (MIX == 1) {
        float bc[16];
        { float bb = 0.f;
#pragma unroll
          for (int t = 0; t < 16; ++t) { bb += sc[t * 2]; bc[t] = bb; } }
        {
            const int t = tid >> 4, s_ = tid & 15;
            const f32x4* a4 = (const f32x4*)(ks + t * QS); const f32x4* q4 = (const f32x4*)(qs + t * QS); const f32x4* b4 = (const f32x4*)(ks + s_ * QS);
            float kk = 0.f, qk = 0.f;
#pragma unroll 8
            for (int i = 0; i < 32; ++i) { const f32x4 x = a4[i], z = q4[i], y = b4[i]; kk += x[0] * y[0] + x[1] * y[1] + x[2] * y[2] + x[3] * y[3]; qk += z[0] * y[0] + z[1] * y[1] + z[2] * y[2] + z[3] * y[3]; }
            float bt = 0.f, bs_ = 0.f;
#pragma unroll
            for (int i = 0; i < 16; ++i) { bt = (i == t) ? bc[i] : bt; bs_ = (i == s_) ? bc[i] : bs_; }
            const float e = (s_ <= t) ? expf(bt - bs_) : 0.f;
            nm[t * 17 + s_] = (s_ < t) ? sc[t * 2 + 1] * kk * e : 0.f;
            ((bf16_t*)(ws + OFF_AF))[(size_t)ci * 512 + af_index(t, s_)] = f2bf(qk * e);
        }
        for (int e = tid; e < 512; e += NTH) {
            const int t = e >> 5, k0 = (e & 31) * 4;
            float bt = 0.f;
#pragma unroll
            for (int i = 0; i < 16; ++i) bt = (i == t) ? bc[i] : bt;
            const float eb = expf(bt);
            u32x2 w; w.x = cvt_pk_bf16(qs[t * QS + k0] * eb, qs[t * QS + k0 + 1] * eb); w.y = cvt_pk_bf16(qs[t * QS + k0 + 2] * eb, qs[t * QS + k0 + 3] * eb);
            *(u32x2*)(QF + qf_index(t, k0)) = w;
        }
        for (int e = tid; e < 512; e += NTH) {
            const int k = e & 127, tq = e >> 7;
            float kv[4];
#pragma unroll
            for (int j = 0; j < 4; ++j) { float bt = 0.f;
#pragma unroll
                for (int i = 0; i < 16; ++i) bt = (i == tq * 4 + j) ? bc[i] : bt;
                kv[j] = ks[(tq * 4 + j) * QS + k] * expf(bc[15] - bt); }
            u32x2 w; w.x = cvt_pk_bf16(kv[0], kv[1]); w.y = cvt_pk_bf16(kv[2], kv[3]);
            *(u32x2*)(KF + kf_index(tq * 4, k)) = w;
        }
        if (tid == 0) DF[0] = expf(bc[15]);
        __syncthreads();
        {
            float x[16];
            const bool isv = tid < 128; const int col = tid & 127;
#pragma unroll
            for (int t = 0; t < 16; ++t) { const float beta = sc[t * 2 + 1]; x[t] = isv ? beta * vs[t * QS + col] : beta * expf(bc[t]) * ks[t * QS + col]; }
#pragma unroll
            for (int t = 1; t < 16; ++t)
#pragma unroll
                for (int s_ = 0; s_ < t; ++s_) x[t] -= nm[t * 17 + s_] * x[s_];
            if (isv) {
                float* UF = (float*)(ws + OFF_VF) + (size_t)ci * 2048;
#pragma unroll
                for (int tq = 0; tq < 4; ++tq) *(f32x4*)(UF + vf_index(tq * 4, col)) = (f32x4){x[tq * 4], x[tq * 4 + 1], x[tq * 4 + 2], x[tq * 4 + 3]};
            } else {
#pragma unroll
                for (int t = 0; t < 16; ++t) WF[qf_index(t, col)] = f2bf(x[t]);
            }
        }
    } else {
        float cc[16], gg[16], bc[16];
        { float bb = 0.f, gm = -INFINITY;
#pragma unroll
          for (int t = 0; t < 16; ++t) { bb += sc[t * 2 + 1]; bc[t] = bb; cc[t] = sc[t * 2] - bb; gm = fmaxf(gm, cc[t]); gg[t] = gm; } }
        {
            const int t = tid >> 4, s_ = tid & 15;
            const f32x4* a4 = (const f32x4*)(qs + t * QS); const f32x4* b4 = (const f32x4*)(ks + s_ * QS);
            float acc = 0.f;
#pragma unroll 8
            for (int i = 0; i < 32; ++i) { const f32x4 x = a4[i], y = b4[i]; acc += x[0] * y[0] + x[1] * y[1] + x[2] * y[2] + x[3] * y[3]; }
            ((float*)(ws + OFF_AF))[(size_t)ci * 256 + af_index(t, s_)] = (s_ <= t) ? acc : 0.f;
        }
        for (int e = tid; e < 512; e += NTH) {
            const int t = e >> 5, k0 = (e & 31) * 4;
            u32x2 w; w.x = cvt_pk_bf16(qs[t * QS + k0], qs[t * QS + k0 + 1]); w.y = cvt_pk_bf16(qs[t * QS + k0 + 2], qs[t * QS + k0 + 3]);
            *(u32x2*)(QF + qf_index(t, k0)) = w;
        }
        for (int e = tid; e < 512; e += NTH) {
            const int k = e & 127, tq = e >> 7;
            float kv[4];
#pragma unroll
            for (int j = 0; j < 4; ++j) { float ct = 0.f;
#pragma unroll
                for (int i = 0; i < 16; ++i) ct = (i == tq * 4 + j) ? cc[i] : ct;
                kv[j] = ks[(tq * 4 + j) * QS + k] * expf(ct - gg[15]); }
            u32x2 w; w.x = cvt_pk_bf16(kv[0], kv[1]); w.y = cvt_pk_bf16(kv[2], kv[3]);
            *(u32x2*)(KF + kf_index(tq * 4, k)) = w;
        }
        if (tid < 16) {
            float cv = 0.f, gv = 0.f, bv = 0.f;
#pragma unroll
            for (int i = 0; i < 16; ++i) { cv = (i == tid) ? cc[i] : cv; gv = (i == tid) ? gg[i] : gv; bv = (i == tid) ? bc[i] : bv; }
            DF[tid] = cv; DF[16 + tid] = gv; DF[32 + tid] = bv;
        }
    }
    if (MIX != 1) {
        bf16_t* VF = (bf16_t*)(ws + OFF_VF) + (size_t)ci * (16 * DV);
        for (int e = tid; e < DV * 4; e += NTH) {
            const int v = e % DV, tq = e / DV;
            float x[4];
#pragma unroll
            for (int j = 0; j < 4; ++j) x[j] = P[(size_t)(row0 + t0 + tq * 4 + j) * PLD + VBASE + h * DV + v];
            u32x2 w; w.x = cvt_pk_bf16(x[0], x[1]); w.y = cvt_pk_bf16(x[2], x[3]);
            *(u32x2*)(VF + vf_index(tq * 4, v)) = w;
        }
    }
}

constexpr int PW_IMG = 272;
constexpr int PW_BYTES = 14336;
#define PW_FENCE() asm volatile("s_waitcnt lgkmcnt(0)" ::: "memory")
__device__ __forceinline__ float exp_fast(float x) { return __expf(x); }
__device__ __forceinline__ f32x4 img_mfma(const unsigned char* X, const unsigned char* Y, int lane) {
    f32x4 d = (f32x4){0.f, 0.f, 0.f, 0.f};
    const int r = lane & 15, q = lane >> 4;
#pragma unroll
    for (int m = 0; m < 4; ++m) {
        const bf16x8 a = *(const bf16x8*)(X + r * PW_IMG + m * 64 + q * 16), b = *(const bf16x8*)(Y + r * PW_IMG + m * 64 + q * 16);
        d = __builtin_amdgcn_mfma_f32_16x16x32_bf16(a, b, d, 0, 0, 0);
    }
    return d;
}
__device__ __forceinline__ void emit_qf(const unsigned char* img, bf16_t* rec, int lane, float rowscale, bool scaled) {
    const int t = lane & 15, q = lane >> 4;
#pragma unroll
    for (int m = 0; m < 4; ++m) {
        u32x2 lo = *(const u32x2*)(img + t * PW_IMG + (32 * m + 4 * q) * 2), hi = *(const u32x2*)(img + t * PW_IMG + (32 * m + 16 + 4 * q) * 2);
        if (scaled) {
            lo.x = cvt_pk_bf16(__uint_as_float(lo.x << 16) * rowscale, __uint_as_float(lo.x & 0xffff0000u) * rowscale); lo.y = cvt_pk_bf16(__uint_as_float(lo.y << 16) * rowscale, __uint_as_float(lo.y & 0xffff0000u) * rowscale);
            hi.x = cvt_pk_bf16(__uint_as_float(hi.x << 16) * rowscale, __uint_as_float(hi.x & 0xffff0000u) * rowscale); hi.y = cvt_pk_bf16(__uint_as_float(hi.y << 16) * rowscale, __uint_as_float(hi.y & 0xffff0000u) * rowscale);
        }
        *(u32x4*)(rec + (m * 64 + lane) * 8) = (u32x4){lo.x, lo.y, hi.x, hi.y};
    }
}
__device__ __forceinline__ void emit_kf(const unsigned char* kt_img, bf16_t* rec, int lane) {
    const int i = lane & 15, q = lane >> 4;
#pragma unroll
    for (int g = 0; g < 4; ++g) {
        const u32x2 a = *(const u32x2*)(kt_img + (16 * (2 * g) + i) * 32 + q * 8), b = *(const u32x2*)(kt_img + (16 * (2 * g + 1) + i) * 32 + q * 8);
        *(u32x4*)(rec + lane * 32 + g * 8) = (u32x4){a.x, a.y, b.x, b.y};
    }
}
__device__ __forceinline__ void store_kt(unsigned char* kt_img, int lane, const float (&v0)[16], const float (&v1)[16]) {
#pragma unroll
    for (int hh = 0; hh < 2; ++hh) {
        u32x4 w0, w1;
#pragma unroll
        for (int j = 0; j < 4; ++j) { w0[j] = cvt_pk_bf16(v0[hh * 8 + 2 * j], v0[hh * 8 + 2 * j + 1]); w1[j] = cvt_pk_bf16(v1[hh * 8 + 2 * j], v1[hh * 8 + 2 * j + 1]); }
        *(u32x4*)(kt_img + (2 * lane) * 32 + hh * 16) = w0; *(u32x4*)(kt_img + (2 * lane + 1) * 32 + hh * 16) = w1;
    }
}
__device__ __forceinline__ void wave_sum16(float (&v)[16], int lane) {
    float a[8], b[4], c[2], d;
#pragma unroll
    for (int i = 0; i < 8; ++i) { const bool up = lane >= 32; const float snd = up ? v[i] : v[i + 8], keep = up ? v[i + 8] : v[i]; a[i] = keep + __shfl_xor(snd, 32); }
#pragma unroll
    for (int i = 0; i < 4; ++i) { const bool up = (lane & 16) != 0; const float snd = up ? a[i] : a[i + 4], keep = up ? a[i + 4] : a[i]; b[i] = keep + __shfl_xor(snd, 16); }
#pragma unroll
    for (int i = 0; i < 2; ++i) { const bool up = (lane & 8) != 0; const float snd = up ? b[i] : b[i + 2], keep = up ? b[i + 2] : b[i]; c[i] = keep + __shfl_xor(snd, 8); }
    { const bool up = (lane & 4) != 0; const float snd = up ? c[0] : c[1], keep = up ? c[1] : c[0]; d = keep + __shfl_xor(snd, 4); }
    d += __shfl_xor(d, 2); d += __shfl_xor(d, 1);
#pragma unroll
    for (int i = 0; i < 16; ++i) {
        const int src = ((i >> 3) & 1) * 32 + ((i >> 2) & 1) * 16 + ((i >> 1) & 1) * 8 + (i & 1) * 4;
        v[i] = __builtin_bit_cast(float, __builtin_amdgcn_readlane(__builtin_bit_cast(int, d), src));
    }
}

template <int MIX, int VARIANT = 0>
__device__ __forceinline__ void prepass_wave(const Params& p, unsigned char* wl, int lane, int item) {
    unsigned char* ws = opaque_ptr(p.ws);
    const bf16_t* P = (const bf16_t*)(ws + OFF_P);
    constexpr int DV = (MIX == 3) ? 256 : 128;
    constexpr int NH = (MIX == 3) ? 4 : 8;
    constexpr int VBASE = (MIX == 3) ? 1024 : 2048;
    const int ci = item, ch = item % NCH, bh = item / NCH, h = bh % NH, b = bh / NH;
    const int row0 = b * T_P, t0 = ch * 16;
    const int q = lane >> 4, c = lane & 15, kc = h * 128 + 2 * lane;
    bf16_t* QF = (bf16_t*)(ws + OFF_QF) + (size_t)ci * 2048;
    bf16_t* KF = (bf16_t*)(ws + OFF_KF) + (size_t)ci * 2048;
    float* DF = (float*)(ws + OFF_DF) + (size_t)ci * 128;
    unsigned char* imgA = wl; unsigned char* imgB = wl + 16 * PW_IMG; unsigned char* ktI = wl + 32 * PW_IMG; float* nm = (float*)(wl + 32 * PW_IMG + 4096);
    const bf16_t* Prow = P + (size_t)(row0 + t0) * PLD;
    const float* PGrow = (const float*)(ws + OFF_PG) + (size_t)(row0 + t0) * 16;
    unsigned x[DV / 16][4];
    if (MIX != 1) {
#pragma unroll
        for (int vt = 0; vt < DV / 16; ++vt)
#pragma unroll
            for (int j = 0; j < 4; ++j) x[vt][j] = Prow[(size_t)(4 * q + j) * PLD + VBASE + h * DV + vt * 16 + c];
    }
    auto vf_store = [&]() {
        if (MIX != 1) {
            bf16_t* VF = (bf16_t*)(ws + OFF_VF) + (size_t)ci * (16 * DV);
#pragma unroll
            for (int vt = 0; vt < DV / 16; ++vt) {
                u32x2 w; w.x = x[vt][0] | (x[vt][1] << 16); w.y = x[vt][2] | (x[vt][3] << 16);
                *(u32x2*)(VF + (vt * 64 + lane) * 4) = w;
            }
        }
    };
    if (MIX == 0 || MIX == 3) {
        float qv0[16], qv1[16], kv0[16], kv1[16], b0[16], b1[16];
        if (MIX == 0) {
            const float* lbv = (const float*)(ws + OFF_LB);
            const f32x2 lb = *(const f32x2*)(lbv + kc);
#pragma unroll
            for (int t = 0; t < 16; ++t) {
                const f32x2 qr = ldbf2(Prow + (size_t)t * PLD + kc), fr_ = ldbf2(Prow + (size_t)t * PLD + 1024 + kc);
                const float fg0 = lb[0] + (1.f - lb[0]) * sigmoidf_(fr_[0]), fg1 = lb[1] + (1.f - lb[1]) * sigmoidf_(fr_[1]);
                qv0[t] = siluf_(qr[0]); qv1[t] = siluf_(qr[1]); kv0[t] = 1.f - fg0; kv1[t] = 1.f - fg1; b0[t] = __logf(fg0); b1[t] = __logf(fg1);
            }
        } else {
            const float* wg = p.in[26]; const float* bg = p.in[27];
            f32x2 wgt[16];
#pragma unroll
            for (int j = 0; j < 16; ++j) wgt[j] = *(const f32x2*)(wg + j * 512 + kc);
            const f32x2 bgv = *(const f32x2*)(bg + kc);
#pragma unroll
            for (int t = 0; t < 16; ++t) {
                const bf16_t* Pr = Prow + (size_t)t * PLD;
                const f32x2 qr = ldbf2(Pr + kc), kr = ldbf2(Pr + 512 + kc);
                float p0 = bgv[0], p1 = bgv[1];
#pragma unroll
                for (int j4 = 0; j4 < 4; ++j4) { const f32x4 rr = *(const f32x4*)(PGrow + t * 16 + j4 * 4);
#pragma unroll
                    for (int j = 0; j < 4; ++j) { p0 += rr[j] * wgt[j4 * 4 + j][0]; p1 += rr[j] * wgt[j4 * 4 + j][1]; } }
                qv0[t] = qr[0] * 0.08838834764831845f; qv1[t] = qr[1] * 0.08838834764831845f; kv0[t] = kr[0]; kv1[t] = kr[1];
                b0[t] = logsigmoidf_(p0) * 0.0625f; b1[t] = logsigmoidf_(p1) * 0.0625f;
            }
        }
        vf_store();
#pragma unroll
        for (int t = 1; t < 16; ++t) { b0[t] += b0[t - 1]; b1[t] += b1[t - 1]; }
        float kh0[16], kh1[16];
#pragma unroll
        for (int t = 0; t < 16; ++t) {
            const float e0 = exp_fast(b0[t]), e1 = exp_fast(b1[t]);
            *(unsigned*)(imgA + t * PW_IMG + 4 * lane) = cvt_pk_bf16(qv0[t] * e0, qv1[t] * e1);
            *(unsigned*)(imgB + t * PW_IMG + 4 * lane) = cvt_pk_bf16(kv0[t] * exp_fast(-b0[t]), kv1[t] * exp_fast(-b1[t]));
            kh0[t] = kv0[t] * exp_fast(b0[15] - b0[t]); kh1[t] = kv1[t] * exp_fast(b1[15] - b1[t]);
        }
        store_kt(ktI, lane, kh0, kh1);
        { const int k = 2 * lane; *(f32x2*)(DF + ((k >> 2) & 3) * 32 + (k >> 4) * 4 + (k & 3)) = (f32x2){exp_fast(b0[15]), exp_fast(b1[15])}; }
        PW_FENCE();
        f32x4 d = img_mfma(imgB, imgA, lane);
        u32x2 aw; aw.x = cvt_pk_bf16((4 * q + 0 <= c) ? d[0] : 0.f, (4 * q + 1 <= c) ? d[1] : 0.f); aw.y = cvt_pk_bf16((4 * q + 2 <= c) ? d[2] : 0.f, (4 * q + 3 <= c) ? d[3] : 0.f);
        *(u32x2*)((bf16_t*)(ws + OFF_AF) + (size_t)ci * 512 + lane * 4) = aw;
        emit_qf(imgA, QF, lane, 1.f, false);
        emit_kf(ktI, KF, lane);
    } else if (MIX == 2) {
        float qv0[16], qv1[16], kv0[16], kv1[16];
#pragma unroll
        for (int t = 0; t < 16; ++t) {
            const f32x2 qr = ldbf2(Prow + (size_t)t * PLD + kc), kr = ldbf2(Prow + (size_t)t * PLD + 1024 + kc);
            qv0[t] = qr[0]; qv1[t] = qr[1]; kv0[t] = kr[0] * 0.08838834764831845f; kv1[t] = kr[1] * 0.08838834764831845f;
        }
        float cc[16], gg[16], bc[16];
        { float bb = 0.f, gm = -INFINITY; const float bi = p.in[21][h], bf_ = p.in[22][h];
#pragma unroll
          for (int t = 0; t < 16; ++t) { const float li = PGrow[t * 16 + h] + bi, lf = logsigmoidf_(PGrow[t * 16 + 8 + h] + bf_);
              bb += lf; bc[t] = bb; cc[t] = li - bb; gm = fmaxf(gm, cc[t]); gg[t] = gm; } }
        vf_store();
        float kh0[16], kh1[16];
#pragma unroll
        for (int t = 0; t < 16; ++t) {
            *(unsigned*)(imgA + t * PW_IMG + 4 * lane) = cvt_pk_bf16(qv0[t], qv1[t]);
            *(unsigned*)(imgB + t * PW_IMG + 4 * lane) = cvt_pk_bf16(kv0[t], kv1[t]);
            const float e = exp_fast(cc[t] - gg[15]); kh0[t] = kv0[t] * e; kh1[t] = kv1[t] * e;
        }
        store_kt(ktI, lane, kh0, kh1);
        if (lane < 16) {
            float cv = 0.f, gv = 0.f, bv = 0.f;
#pragma unroll
            for (int i = 0; i < 16; ++i) { cv = (i == lane) ? cc[i] : cv; gv = (i == lane) ? gg[i] : gv; bv = (i == lane) ? bc[i] : bv; }
            DF[lane] = cv; DF[16 + lane] = gv; DF[32 + lane] = bv;
        }
        PW_FENCE();
        f32x4 d = img_mfma(imgB, imgA, lane);
#pragma unroll
        for (int r = 0; r < 4; ++r) d[r] = (4 * q + r <= c) ? d[r] : 0.f;
        *(f32x4*)((float*)(ws + OFF_AF) + (size_t)ci * 256 + lane * 4) = d;
        emit_qf(imgA, QF, lane, 1.f, false);
        emit_kf(ktI, KF, lane);
    } else {
        const float* cw = p.in[15];
        bf16_t* WF = (bf16_t*)(ws + OFF_WF) + (size_t)ci * 2048;
        float qv0[16], qv1[16], kv0[16], kv1[16], vv0[16], vv1[16];
#define PW_CONV(col_, o0, o1) do { const int cc_ = (col_); f32x2 w_[4]; \
            _Pragma("unroll") for (int w = 0; w < 4; ++w) w_[w] = *(const f32x2*)(cw + w * 3072 + cc_); \
            f32x2 r_[19]; \
            _Pragma("unroll") for (int i = 0; i < 19; ++i) { const int t = t0 - 3 + i; r_[i] = (t >= 0) ? ldbf2(P + (size_t)(row0 + (t >= 0 ? t : 0)) * PLD + cc_) : (f32x2){0.f, 0.f}; } \
            _Pragma("unroll") for (int t = 0; t < 16; ++t) { f32x2 y_ = {0.f, 0.f}; \
                _Pragma("unroll") for (int w = 0; w < 4; ++w) y_ += w_[w] * r_[t + w]; \
                o0[t] = siluf_(y_[0]); o1[t] = siluf_(y_[1]); } \
            asm volatile("" ::: "memory"); } while (0)
        PW_CONV(kc, qv0, qv1);
        PW_CONV(1024 + kc, kv0, kv1);
        PW_CONV(2048 + kc, vv0, vv1);
#undef PW_CONV
        float sq[16], sk[16];
#pragma unroll
        for (int t = 0; t < 16; ++t) { sq[t] = qv0[t] * qv0[t] + qv1[t] * qv1[t]; sk[t] = kv0[t] * kv0[t] + kv1[t] * kv1[t]; }
        wave_sum16(sq, lane); wave_sum16(sk, lane);
        float bc[16], beta[16];
        { float bb = 0.f; const float ea = expf(p.in[16][h]), dtb = p.in[17][h];
#pragma unroll
          for (int t = 0; t < 16; ++t) { bb += -ea * softplusf_(PGrow[t * 16 + h] + dtb); bc[t] = bb; beta[t] = sigmoidf_(PGrow[t * 16 + 8 + h]); } }
#pragma unroll
        for (int t = 0; t < 16; ++t) {
            const float rq_ = rsqrtf(sq[t] + 1e-6f) * 0.08838834764831845f, rk_ = rsqrtf(sk[t] + 1e-6f);
            kv0[t] *= rk_; kv1[t] *= rk_;
            *(unsigned*)(imgA + t * PW_IMG + 4 * lane) = cvt_pk_bf16(qv0[t] * rq_, qv1[t] * rq_);
            *(unsigned*)(imgB + t * PW_IMG + 4 * lane) = cvt_pk_bf16(kv0[t], kv1[t]);
        }
#pragma unroll
        for (int hh = 0; hh < 2; ++hh) {
            u32x4 w0, w1;
#pragma unroll
            for (int j = 0; j < 4; ++j) {
                const int ta = hh * 8 + 2 * j; const float ea = exp_fast(bc[15] - bc[ta]), eb = exp_fast(bc[15] - bc[ta + 1]);
                w0[j] = cvt_pk_bf16(kv0[ta] * ea, kv0[ta + 1] * eb); w1[j] = cvt_pk_bf16(kv1[ta] * ea, kv1[ta + 1] * eb);
            }
            *(u32x4*)(ktI + (2 * lane) * 32 + hh * 16) = w0; *(u32x4*)(ktI + (2 * lane + 1) * 32 + hh * 16) = w1;
        }
        if (lane == 0) DF[0] = exp_fast(bc[15]);
        PW_FENCE();
        const unsigned char* imgB2 = imgB; asm volatile("" : "+v"(imgB2));
        const f32x4 dkk = img_mfma(imgB, imgB2, lane);
        const f32x4 dqk = img_mfma(imgB, imgA, lane);
        float bcol = 0.f, betac = 0.f;
#pragma unroll
        for (int i = 0; i < 16; ++i) { bcol = (i == c) ? bc[i] : bcol; betac = (i == c) ? beta[i] : betac; }
        u32x2 aw; float av[4];
#pragma unroll
        for (int r = 0; r < 4; ++r) {
            const int s_ = 4 * q + r; float bs_ = 0.f;
#pragma unroll
            for (int i = 0; i < 16; ++i) bs_ = (i == s_) ? bc[i] : bs_;
            const float e = (s_ <= c) ? exp_fast(bcol - bs_) : 0.f;
            nm[c * 17 + s_] = (s_ < c) ? betac * dkk[r] * e : 0.f;
            av[r] = dqk[r] * e;
        }
        aw.x = cvt_pk_bf16(av[0], av[1]); aw.y = cvt_pk_bf16(av[2], av[3]);
        *(u32x2*)((bf16_t*)(ws + OFF_AF) + (size_t)ci * 512 + lane * 4) = aw;
        { float bt = 0.f;
#pragma unroll
          for (int i = 0; i < 16; ++i) bt = (i == c) ? bc[i] : bt;
          emit_qf(imgA, QF, lane, exp_fast(bt), true); }
        emit_kf(ktI, KF, lane);
        PW_FENCE();
#pragma unroll
        for (int t = 0; t < 16; ++t) { const float bb = beta[t], be = bb * exp_fast(bc[t]); vv0[t] *= bb; vv1[t] *= bb; kv0[t] *= be; kv1[t] *= be; }
#pragma unroll
        for (int t = 1; t < 16; ++t)
#pragma unroll
            for (int s_ = 0; s_ < t; ++s_) { const float n_ = nm[t * 17 + s_]; vv0[t] -= n_ * vv0[s_]; vv1[t] -= n_ * vv1[s_]; kv0[t] -= n_ * kv0[s_]; kv1[t] -= n_ * kv1[s_]; }
        {
            bf16_t* UF = (bf16_t*)(ws + OFF_VF) + (size_t)ci * 2048;
#pragma unroll
            for (int tq = 0; tq < 4; ++tq) {
                u32x2 a_, b_;
                a_.x = cvt_pk_bf16(vv0[tq * 4], vv0[tq * 4 + 1]); a_.y = cvt_pk_bf16(vv0[tq * 4 + 2], vv0[tq * 4 + 3]);
                b_.x = cvt_pk_bf16(vv1[tq * 4], vv1[tq * 4 + 1]); b_.y = cvt_pk_bf16(vv1[tq * 4 + 2], vv1[tq * 4 + 3]);
                *(u32x2*)(UF + vf_index(tq * 4, 2 * lane)) = a_;
                *(u32x2*)(UF + vf_index(tq * 4, 2 * lane + 1)) = b_;
            }
        }
        PW_FENCE();
#pragma unroll
        for (int t = 0; t < 16; ++t) *(unsigned*)(imgA + t * PW_IMG + 4 * lane) = cvt_pk_bf16(kv0[t], kv1[t]);
        PW_FENCE();
        emit_qf(imgA, WF, lane, 1.f, false);
    }
    PW_FENCE();
}

template <int MIX>
__device__ __forceinline__ void scanA_phase(const Params& p, float* lds) {
    const int TID = opaque_tid();
    constexpr int NH = (MIX == 3) ? 4 : 8;
    const int nchunk = NB_P * NH * NCH;
    const int wave = TID >> 6, lane = TID & 63;
    if (OLD_PREPASS_MASK & (1 << MIX)) { for (int item = blockIdx.x; item < nchunk; item += gridDim.x) prepass_chunk<MIX>(p, lds, TID, item); }
    else { for (int item = blockIdx.x * 4 + wave; item < nchunk; item += gridDim.x * 4) prepass_wave<MIX>(p, (unsigned char*)lds + wave * PW_BYTES, lane, item); }
#if SAMPLE_IN_SEQ
    return;
#endif
    const int NW = (int)gridDim.x * 4, wr = ((int)gridDim.x - 1 - (int)blockIdx.x) * 4 + (3 - wave);
    if (NB_S * 32 == 2 * NW && nchunk % NW != 0 && 4 * (nchunk % NW) <= NW) {
        const int extra = nchunk % NW;
        const int nmine = (wr >= NW - extra) ? 0 : (wr < 2 * extra) ? 3 : 2;
#pragma unroll 1
        for (int k = 0; k < nmine; ++k) {
            const int it = (k < 2) ? wr + k * NW : ((wr < extra) ? NW - extra + wr : 2 * NW - extra + (wr - extra));
            sample_wave<MIX>(p, (unsigned char*)lds + wave * PW_BYTES, lane, it);
        }
    } else
    for (int it = wr; it < NB_S * 32; it += NW) sample_wave<MIX>(p, (unsigned char*)lds + wave * PW_BYTES, lane, it);
}

template <int MIX>
__device__ __forceinline__ void sample_wave(const Params& p, unsigned char* wl, int lane, int item) {
    unsigned char* ws = opaque_ptr(p.ws);
    const bf16_t* P = (const bf16_t*)(ws + OFF_P);
    float* O = (float*)(ws + OFF_O);
    constexpr int DV = (MIX == 3) ? 256 : 128;
    constexpr int NH = (MIX == 3) ? 4 : 8;
    constexpr int VBASE = (MIX == 3) ? 1024 : 2048;
    const int sseq = item >> 5, tile = item & 31, col0 = tile * 32;
    const int h = col0 / DV, vc0 = col0 % DV;
    const int row = ROWS_P + sseq;
    const int g = lane >> 5, c = lane & 31, kc = h * 128 + 2 * lane;
    const bf16_t* Pr = P + (size_t)row * PLD;
    const float* PGr = (const float*)(ws + OFF_PG) + (size_t)row * 16;
    float* qL = (float*)wl; float* kL = qL + 128; float* fL = kL + 128;
    float sc0 = 0.f, sc1 = 0.f;
    float q0, q1, k0, k1, f0 = 0.f, f1 = 0.f, vv;
    if (MIX == 0) {
        const float* lbv = (const float*)(ws + OFF_LB);
        const f32x2 qr = ldbf2(Pr + kc), fr_ = ldbf2(Pr + 1024 + kc), lb = *(const f32x2*)(lbv + kc);
        const float fg0 = lb[0] + (1.f - lb[0]) * sigmoidf_(fr_[0]), fg1 = lb[1] + (1.f - lb[1]) * sigmoidf_(fr_[1]);
        q0 = siluf_(qr[0]); q1 = siluf_(qr[1]); k0 = 1.f - fg0; k1 = 1.f - fg1; f0 = fg0; f1 = fg1;
        vv = bf2f(Pr[VBASE + col0 + c]);
    } else if (MIX == 3) {
        const float* wg = p.in[26]; const float* bg = p.in[27];
        const f32x2 qr = ldbf2(Pr + kc), kr = ldbf2(Pr + 512 + kc), bgv = *(const f32x2*)(bg + kc);
        float p0 = bgv[0], p1 = bgv[1];
#pragma unroll
        for (int j = 0; j < 16; ++j) { const float rr = PGr[j]; const f32x2 w = *(const f32x2*)(wg + j * 512 + kc); p0 += rr * w[0]; p1 += rr * w[1]; }
        q0 = qr[0] * 0.08838834764831845f; q1 = qr[1] * 0.08838834764831845f; k0 = kr[0]; k1 = kr[1];
        f0 = expf(logsigmoidf_(p0) * 0.0625f); f1 = expf(logsigmoidf_(p1) * 0.0625f);
        vv = bf2f(Pr[VBASE + col0 + c]);
    } else if (MIX == 2) {
        const f32x2 qr = ldbf2(Pr + kc), kr = ldbf2(Pr + 1024 + kc);
        q0 = qr[0]; q1 = qr[1]; k0 = kr[0] * 0.08838834764831845f; k1 = kr[1] * 0.08838834764831845f;
        sc0 = PGr[h] + p.in[21][h]; sc1 = logsigmoidf_(PGr[8 + h] + p.in[22][h]);
        vv = bf2f(Pr[VBASE + col0 + c]);
    } else {
        const float* cw = p.in[15]; const float* cbuf = p.in[4] + (size_t)sseq * 3 * 3072;
        f32x2 yq = {0.f, 0.f}, yk = {0.f, 0.f}; float yv = 0.f;
        const int cv = VBASE + col0 + c;
#pragma unroll
        for (int w = 0; w < 4; ++w) {
            const float* src = cbuf + (w < 3 ? w : 0) * 3072;
            yq += *(const f32x2*)(cw + w * 3072 + kc) * ((w < 3) ? *(const f32x2*)(src + kc) : ldbf2(Pr + kc));
            yk += *(const f32x2*)(cw + w * 3072 + 1024 + kc) * ((w < 3) ? *(const f32x2*)(src + 1024 + kc) : ldbf2(Pr + 1024 + kc));
            yv += cw[w * 3072 + cv] * ((w < 3) ? src[cv] : bf2f(Pr[cv]));
        }
        q0 = siluf_(yq[0]); q1 = siluf_(yq[1]); k0 = siluf_(yk[0]); k1 = siluf_(yk[1]); vv = siluf_(yv);
        const float rq = rsqrtf(wave_sum(q0 * q0 + q1 * q1) + 1e-6f) * 0.08838834764831845f, rk = rsqrtf(wave_sum(k0 * k0 + k1 * k1) + 1e-6f);
        q0 *= rq; q1 *= rq; k0 *= rk; k1 *= rk;
        sc0 = expf(-expf(p.in[16][h]) * softplusf_(PGr[h] + p.in[17][h])); sc1 = sigmoidf_(PGr[8 + h]);
    }
    *(f32x2*)(qL + 2 * lane) = (f32x2){q0, q1}; *(f32x2*)(kL + 2 * lane) = (f32x2){k0, k1};
    if (MIX == 0 || MIX == 3) *(f32x2*)(fL + 2 * lane) = (f32x2){f0, f1};
    const float* init_S = (MIX == 0) ? p.in[2] : (MIX == 1) ? p.in[3] : (MIX == 2) ? p.in[5] : p.in[8];
    float* out_S = p.out + ((MIX == 0) ? OUT_S_HGRN : (MIX == 1) ? OUT_S_GDN : (MIX == 2) ? OUT_S_MC : OUT_S_GLA);
    const size_t st_off = ((size_t)sseq * NH + h) * 128 * DV + (size_t)(64 * g) * DV + vc0 + c;
    float s[64];
#pragma unroll
    for (int i = 0; i < 64; ++i) s[i] = init_S[st_off + (size_t)i * DV];
    float nn0 = 0.f, nn1 = 0.f, mrun = 0.f;
    if (MIX == 2) { nn0 = p.in[6][((size_t)sseq * 8 + h) * 128 + 2 * lane]; nn1 = p.in[6][((size_t)sseq * 8 + h) * 128 + 2 * lane + 1]; mrun = p.in[7][(size_t)sseq * 8 + h]; }
    PW_FENCE();
    const f32x4* q4 = (const f32x4*)(qL + 64 * g); const f32x4* k4 = (const f32x4*)(kL + 64 * g); const f32x4* f4 = (const f32x4*)(fL + 64 * g);
    float o = 0.f;
    if (MIX == 0 || MIX == 3) {
#pragma unroll
        for (int i4 = 0; i4 < 16; ++i4) { const f32x4 qq = q4[i4], kk = k4[i4], ff = f4[i4];
#pragma unroll
            for (int j = 0; j < 4; ++j) { const int i = i4 * 4 + j; s[i] = ff[j] * s[i] + kk[j] * vv; o += qq[j] * s[i]; } }
        o += __shfl_xor(o, 32);
    } else if (MIX == 1) {
        float r = 0.f;
#pragma unroll
        for (int i4 = 0; i4 < 16; ++i4) { const f32x4 kk = k4[i4];
#pragma unroll
            for (int j = 0; j < 4; ++j) { const int i = i4 * 4 + j; s[i] *= sc0; r += kk[j] * s[i]; } }
        r += __shfl_xor(r, 32);
        const float vn = sc1 * (vv - r);
#pragma unroll
        for (int i4 = 0; i4 < 16; ++i4) { const f32x4 qq = q4[i4], kk = k4[i4];
#pragma unroll
            for (int j = 0; j < 4; ++j) { const int i = i4 * 4 + j; s[i] += kk[j] * vn; o += qq[j] * s[i]; } }
        o += __shfl_xor(o, 32);
    } else {
        const float mn = fmaxf(sc1 + mrun, sc0);
        const float a = expf(sc1 + mrun - mn), w = expf(sc0 - mn);
        mrun = mn;
        const float wv = w * vv;
#pragma unroll
        for (int i4 = 0; i4 < 16; ++i4) { const f32x4 qq = q4[i4], kk = k4[i4];
#pragma unroll
            for (int j = 0; j < 4; ++j) { const int i = i4 * 4 + j; s[i] = a * s[i] + kk[j] * wv; o += qq[j] * s[i]; } }
        o += __shfl_xor(o, 32);
        nn0 = a * nn0 + w * k0; nn1 = a * nn1 + w * k1;
        const float den = wave_sum(q0 * nn0 + q1 * nn1);
        o = o / fmaxf(fabsf(den), expf(-mn));
    }
    if (g == 0) ((bf16_t*)O)[(size_t)row * 1024 + col0 + c] = f2bf(o);
#pragma unroll
    for (int i = 0; i < 64; ++i) out_S[st_off + (size_t)i * DV] = s[i];
    if (MIX == 2 && vc0 == 0) {
        float* on = p.out + OUT_S_MN + ((size_t)sseq * 8 + h) * 128;
        *(f32x2*)(on + 2 * lane) = (f32x2){nn0, nn1};
        if (lane == 0) {
            p.out[OUT_S_MM + (size_t)sseq * 8 + h] = mrun;
            ((float*)(ws + OFF_DEN))[(size_t)row * 8 + h] = 1.f;
            ((float*)(ws + OFF_MT))[(size_t)row * 8 + h] = 100.f;
        }
    }
    PW_FENCE();
}

#define RING_BYTES_OF(M_) (((M_) == 2) ? 3 * 11264 : ((M_) == 1) ? 4 * 15360 : 5 * 11264)
template <int MIX, bool LITE = false>
__device__ __forceinline__ void seq_phase(const Params& p, unsigned char* lds, bool do_seq = true, bool do_sample = true) {
    const int TID = opaque_tid();
    unsigned char* ws = opaque_ptr(p.ws);
    constexpr int DV = (MIX == 3) ? 256 : 128;
    constexpr int NH = (MIX == 3) ? 4 : 8;
    constexpr int NVT = DV / 16;
    constexpr int NT = NVT + ((MIX == 2) ? 1 : 0);
    const int wave = TID >> 6, lane = TID & 63, q = lane >> 4, c = lane & 15;
    float* O = (float*)(ws + OFF_O);
    const int nitems = NB_P * NH * NT;
    if (wave >= 2 && !LITE) {
        const int layer_ = (MIX == 0) ? 0 : (MIX == 1) ? 1 : (MIX == 2) ? 2 : 3;
        const int wr_ = blockIdx.x * 2 + (wave - 2), nw_ = gridDim.x * 2;
        convert_fp8_rows<true>(p.in[33], ws + OFF_UB, (float*)(ws + OFF_SU), layer_ * NEXP, (layer_ + 1) * NEXP, wr_, nw_, lane);
        convert_fp8_rows<false>(p.in[34], ws + OFF_VB, (float*)(ws + OFF_SV), layer_ * NEXP, (layer_ + 1) * NEXP, wr_, nw_, lane);
#if SAMPLE_IN_SEQ
        for (int it = wr_; it < NB_S * 32; it += nw_) sample_wave<MIX>(p, lds + LDS_BYTES - 4096 + (wave - 2) * 2048, lane, it);
#endif
    }
    constexpr int NSW = (MIX == 2) ? 2 : 1;
    for (int lap = wave; do_seq && wave < NSW && lap * (int)gridDim.x + (int)blockIdx.x < 8 * NT * ((NB_P * NH + 7) / 8); lap += NSW) {
        const int slot = lap * (int)gridDim.x + (int)blockIdx.x;
        const int bh = ((slot >> 3) / NT) * 8 + (slot & 7), vt = (slot >> 3) % NT, b = bh / NH, h = bh % NH;
        if (bh >= NB_P * NH) continue;
        const bool ntile = (MIX == 2) && (vt == NVT);
        const int row0 = b * T_P;
        f32x4 S[8];
#pragma unroll
        for (int kt = 0; kt < 8; ++kt) S[kt] = (f32x4){0.f, 0.f, 0.f, 0.f};
        float mprev = 0.f;
        const size_t ci0 = (size_t)bh * NCH;
        bf16x8 qf[4], wf[4]; u32x4 kf[4]; u32x2 afb; f32x4 aff; u32x2 vfb; f32x4 uf; f32x4 df[8]; float dsc = 1.f;
        f32x4 c4, g4, b4; float grow = 0.f, g15 = 0.f, b15 = 0.f;
        bf16x8 nqf[4], nwf[4]; u32x4 nkf[4]; u32x2 nafb; f32x4 naff; u32x2 nvfb; f32x4 nuf; f32x4 ndf[8]; float ndsc = 1.f;
        f32x4 nc4, ng4, nb4; float ngrow = 0.f, ng15 = 0.f, nb15 = 0.f;
        constexpr int RING = (MIX == 2) ? 3 : (MIX == 1) ? 4 : 5;
        constexpr int NDMA = (MIX == 1) ? 15 : 11;
        constexpr int AOFF = (MIX == 1) ? 12288 : 8192, VOFF = AOFF + 1024, DOFF = AOFF + 2048, SLOT = AOFF + 3072;
        constexpr int OG = (MIX == 2) ? 4 : 8;
        constexpr int WAVE_LDS = RING_BYTES_OF(MIX) + OG * 1024;
        static_assert(((MIX == 2) ? 2 : 1) * WAVE_LDS <= LDS_BYTES - 4096, "chunk-walk rings overlap the sample-step scratch");
        unsigned char* ring = lds + ((MIX == 2) ? wave * WAVE_LDS : 0);
        float* ostage = (float*)(ring + RING_BYTES_OF(MIX));
        const int vsel = ntile ? 0 : vt;
#define SEQ_DMA(cc_) do { const size_t ci = ci0 + (cc_); unsigned char* sl_ = ring + ((cc_) % RING) * SLOT; \
        { const unsigned char* g_ = ws + OFF_QF + ci * 4096 + lane * 16; _Pragma("unroll") for (int m = 0; m < 4; ++m) __builtin_amdgcn_global_load_lds((const unsigned*)(g_ + m * 1024), (LDSP unsigned*)(sl_ + m * 1024), 16, 0, 0); } \
        { const unsigned char* g_ = ws + OFF_KF + ci * 4096 + lane * 16; _Pragma("unroll") for (int m = 0; m < 4; ++m) __builtin_amdgcn_global_load_lds((const unsigned*)(g_ + m * 1024), (LDSP unsigned*)(sl_ + 4096 + m * 1024), 16, 0, 0); } \
        if (MIX == 1) { const unsigned char* g_ = ws + OFF_WF + ci * 4096 + lane * 16; _Pragma("unroll") for (int m = 0; m < 4; ++m) __builtin_amdgcn_global_load_lds((const unsigned*)(g_ + m * 1024), (LDSP unsigned*)(sl_ + 8192 + m * 1024), 16, 0, 0); } \
        __builtin_amdgcn_global_load_lds((const unsigned*)(ws + OFF_AF + ci * 1024 + lane * 16), (LDSP unsigned*)(sl_ + AOFF), 16, 0, 0); \
        __builtin_amdgcn_global_load_lds((const unsigned*)(ws + OFF_VF + ci * (32 * DV) + (vsel >> 1) * 1024 + lane * 16), (LDSP unsigned*)(sl_ + VOFF), 16, 0, 0); \
        __builtin_amdgcn_global_load_lds((const unsigned*)(ws + OFF_DF + ci * 512 + lane * 16), (LDSP unsigned*)(sl_ + DOFF), 16, 0, 0); } while (0)
#define SEQ_LOAD(cc_, Q_, W_, K_, AB_, AFF_, VB_, U_, D_, DS_, C4_, G4_, B4_, GR_, G15_, B15_) do { const unsigned char* sl_ = ring + ((cc_) % RING) * SLOT; \
        _Pragma("unroll") for (int m = 0; m < 4; ++m) Q_[m] = *(const bf16x8*)(sl_ + m * 1024 + lane * 16); \
        _Pragma("unroll") for (int i = 0; i < 4; ++i) K_[i] = *(const u32x4*)(sl_ + 4096 + lane * 64 + i * 16); \
        if (MIX == 1) { _Pragma("unroll") for (int m = 0; m < 4; ++m) W_[m] = *(const bf16x8*)(sl_ + 8192 + m * 1024 + lane * 16); \
                        { const u32x2 uw_ = *(const u32x2*)(sl_ + VOFF + (vt & 1) * 512 + lane * 8); U_ = (f32x4){__uint_as_float(uw_.x << 16), __uint_as_float(uw_.x & 0xffff0000u), __uint_as_float(uw_.y << 16), __uint_as_float(uw_.y & 0xffff0000u)}; } DS_ = *(const float*)(sl_ + DOFF); } \
        if (MIX == 2) { AFF_ = *(const f32x4*)(sl_ + AOFF + lane * 16); const float* CG = (const float*)(sl_ + DOFF); \
                        C4_ = *(const f32x4*)(CG + 4 * q); G4_ = *(const f32x4*)(CG + 16 + 4 * q); B4_ = *(const f32x4*)(CG + 32 + 4 * q); GR_ = CG[16 + c]; G15_ = CG[31]; B15_ = CG[47]; } \
        else AB_ = *(const u32x2*)(sl_ + AOFF + lane * 8); \
        if (MIX != 1 && !ntile) VB_ = *(const u32x2*)(sl_ + VOFF + (vt & 1) * 512 + lane * 8); \
        if (MIX == 0 || MIX == 3) { _Pragma("unroll") for (int kt = 0; kt < 8; ++kt) D_[kt] = *(const f32x4*)(sl_ + DOFF + q * 128 + kt * 16); } \
    } while (0)
#define SEQ_VMWAIT(n_) asm volatile("s_waitcnt vmcnt(%0)" :: "n"(n_) : "memory")
        asm volatile("s_waitcnt lgkmcnt(0)" ::: "memory");
#pragma unroll
        for (int cc = 0; cc < RING; ++cc) SEQ_DMA(cc);
        SEQ_VMWAIT((RING - 1) * NDMA);
        SEQ_LOAD(0, qf, wf, kf, afb, aff, vfb, uf, df, dsc, c4, g4, b4, grow, g15, b15);
        for (int ch = 0; ch < NCH; ++ch) {
            const int chn = (ch + 1 < NCH) ? ch + 1 : ch;
            if (ch + RING - 1 < NCH) SEQ_VMWAIT((RING - 2) * NDMA); else SEQ_VMWAIT(0);
            asm volatile("s_waitcnt lgkmcnt(0)" ::: "memory");
            if (ch + RING < NCH) SEQ_DMA(ch + RING);
            SEQ_LOAD(chn, nqf, nwf, nkf, nafb, naff, nvfb, nuf, ndf, ndsc, nc4, ng4, nb4, ngrow, ng15, nb15);
            bf16x8 Bs[4];
#pragma unroll
            for (int m = 0; m < 4; ++m) {
                u32x4 w; w.x = cvt_pk_bf16(S[2 * m][0], S[2 * m][1]); w.y = cvt_pk_bf16(S[2 * m][2], S[2 * m][3]);
                w.z = cvt_pk_bf16(S[2 * m + 1][0], S[2 * m + 1][1]); w.w = cvt_pk_bf16(S[2 * m + 1][2], S[2 * m + 1][3]);
                Bs[m] = __builtin_bit_cast(bf16x8, w);
            }
            f32x4 o;
            const f32x4 zero4 = (f32x4){0.f, 0.f, 0.f, 0.f};
            if (LITE) {
                unsigned acc_ = 0;
#pragma unroll
                for (int m = 0; m < 4; ++m) { const u32x4 t_ = __builtin_bit_cast(u32x4, qf[m]); acc_ ^= t_.x ^ t_.y ^ t_.z ^ t_.w ^ kf[m].x ^ kf[m].y ^ kf[m].z ^ kf[m].w; }
                acc_ ^= afb.x ^ vfb.x ^ __float_as_uint(df[0][0]) ^ __float_as_uint(df[7][3]) ^ __float_as_uint(uf[0]) ^ __float_as_uint(aff[1]) ^ __float_as_uint(dsc) ^ __float_as_uint(grow);
                o = (f32x4){__uint_as_float(acc_ & 0x3fffffffu), 0.f, 0.f, 0.f};
            } else
            if (MIX == 0 || MIX == 3) {
                const bf16x4 vb = __builtin_bit_cast(bf16x4, vfb);
                o = mfma16(__builtin_bit_cast(bf16x4, afb), vb, zero4, 0, 0, 0);
#pragma unroll
                for (int m = 0; m < 4; ++m) o = __builtin_amdgcn_mfma_f32_16x16x32_bf16(qf[m], Bs[m], o, 0, 0, 0);
#pragma unroll
                for (int kt = 0; kt < 8; ++kt) {
                    u32x2 kw; kw.x = kf[kt >> 1][(kt & 1) * 2]; kw.y = kf[kt >> 1][(kt & 1) * 2 + 1];
                    S[kt] = mfma16(__builtin_bit_cast(bf16x4, kw), vb, S[kt] * df[kt], 0, 0, 0);
                }
            } else if (MIX == 1) {
                f32x4 wsum = zero4;
#pragma unroll
                for (int m = 0; m < 4; ++m) wsum = __builtin_amdgcn_mfma_f32_16x16x32_bf16(wf[m], Bs[m], wsum, 0, 0, 0);
                const f32x4 vp = uf - wsum;
                u32x2 vw; vw.x = cvt_pk_bf16(vp[0], vp[1]); vw.y = cvt_pk_bf16(vp[2], vp[3]);
                const bf16x4 vb = __builtin_bit_cast(bf16x4, vw);
                o = mfma16(__builtin_bit_cast(bf16x4, afb), vb, zero4, 0, 0, 0);
#pragma unroll
                for (int m = 0; m < 4; ++m) o = __builtin_amdgcn_mfma_f32_16x16x32_bf16(qf[m], Bs[m], o, 0, 0, 0);
#pragma unroll
                for (int kt = 0; kt < 8; ++kt) {
                    u32x2 kw; kw.x = kf[kt >> 1][(kt & 1) * 2]; kw.y = kf[kt >> 1][(kt & 1) * 2 + 1];
                    S[kt] = mfma16(__builtin_bit_cast(bf16x4, kw), vb, S[kt] * dsc, 0, 0, 0);
                }
            } else {
                const float mrow = fmaxf(mprev, grow);
                u32x2 aw; aw.x = cvt_pk_bf16(aff[0] * expf(fminf(c4[0] - mrow, 0.f)), aff[1] * expf(fminf(c4[1] - mrow, 0.f)));
                aw.y = cvt_pk_bf16(aff[2] * expf(fminf(c4[2] - mrow, 0.f)), aff[3] * expf(fminf(c4[3] - mrow, 0.f)));
                f32x4 mr, aint;
#pragma unroll
                for (int r = 0; r < 4; ++r) { mr[r] = fmaxf(mprev, g4[r]); aint[r] = expf(mprev - mr[r]); }
                const float m15 = fmaxf(mprev, g15), lam = expf(g15 - m15), aend = expf(mprev - m15);
                bf16x4 vb, vbl;
                if (ntile) {
                    const unsigned one = (c == 0) ? 0x3f803f80u : 0u;
                    u32x2 t1; t1.x = one; t1.y = one; vb = __builtin_bit_cast(bf16x4, t1);
                    const float lv = (c == 0) ? lam : 0.f;
                    u32x2 t2; t2.x = cvt_pk_bf16(lv, lv); t2.y = t2.x; vbl = __builtin_bit_cast(bf16x4, t2);
                } else {
                    vb = __builtin_bit_cast(bf16x4, vfb);
                    u32x2 t2; t2.x = cvt_pk_bf16(__uint_as_float(vfb.x << 16) * lam, __uint_as_float(vfb.x & 0xffff0000u) * lam);
                    t2.y = cvt_pk_bf16(__uint_as_float(vfb.y << 16) * lam, __uint_as_float(vfb.y & 0xffff0000u) * lam);
                    vbl = __builtin_bit_cast(bf16x4, t2);
                }
                const f32x4 o1 = mfma16(__builtin_bit_cast(bf16x4, aw), vb, zero4, 0, 0, 0);
                f32x4 o2 = zero4;
#pragma unroll
                for (int m = 0; m < 4; ++m) o2 = __builtin_amdgcn_mfma_f32_16x16x32_bf16(qf[m], Bs[m], o2, 0, 0, 0);
                o = o1 + aint * o2;
#pragma unroll
                for (int kt = 0; kt < 8; ++kt) {
                    u32x2 kw; kw.x = kf[kt >> 1][(kt & 1) * 2]; kw.y = kf[kt >> 1][(kt & 1) * 2 + 1];
                    S[kt] = mfma16(__builtin_bit_cast(bf16x4, kw), vbl, S[kt] * aend, 0, 0, 0);
                }
                if (ntile && c == 0) {
#pragma unroll
                    for (int r = 0; r < 4; ++r) { const int rr = (ch % OG) * 16 + 4 * q + r; ostage[rr * 2] = o[r]; ostage[rr * 2 + 1] = b4[r] + mr[r]; }
                }
                mprev = b15 + m15;
            }
            if (!ntile) {
#pragma unroll
                for (int r = 0; r < 4; ++r) ostage[((ch % OG) * 16 + 4 * q + r) * 16 + c] = o[r];
            }
            if ((ch % OG) == OG - 1 || ch == NCH - 1) {
                const int nst = (ch % OG) + 1, chb = ch - (ch % OG);
                asm volatile("s_waitcnt lgkmcnt(0)" ::: "memory");
                if (!ntile) {
                    for (int j = 0; j < nst; ++j) {
                        const f32x4 v = *(const f32x4*)(ostage + (j * 16 + (lane >> 2)) * 16 + (lane & 3) * 4);
                        u32x2 w; w.x = cvt_pk_bf16(v[0], v[1]); w.y = cvt_pk_bf16(v[2], v[3]);
                        *(u32x2*)((bf16_t*)O + (size_t)(row0 + (chb + j) * 16 + (lane >> 2)) * 1024 + h * DV + vt * 16 + (lane & 3) * 4) = w;
                    }
                } else {
                    float* DEN = (float*)(ws + OFF_DEN); float* MT = (float*)(ws + OFF_MT);
                    for (int rr = lane; rr < nst * 16; rr += 64) { const size_t row = (size_t)(row0 + chb * 16 + rr); DEN[row * 8 + h] = ostage[rr * 2]; MT[row * 8 + h] = ostage[rr * 2 + 1]; }
                }
            }
#pragma unroll
            for (int m = 0; m < 4; ++m) { qf[m] = nqf[m]; wf[m] = nwf[m]; kf[m] = nkf[m]; }
#pragma unroll
            for (int kt = 0; kt < 8; ++kt) df[kt] = ndf[kt];
            afb = nafb; aff = naff; vfb = nvfb; uf = nuf; dsc = ndsc; c4 = nc4; g4 = ng4; b4 = nb4; grow = ngrow; g15 = ng15; b15 = nb15;
        }
#undef SEQ_LOAD
#undef SEQ_DMA
#undef SEQ_VMWAIT
        asm volatile("s_waitcnt vmcnt(0) lgkmcnt(0)" ::: "memory");
        if (!ntile) {
            float* out_S = p.out + ((MIX == 0) ? OUT_P_HGRN : (MIX == 1) ? OUT_P_GDN : (MIX == 2) ? OUT_P_MC : OUT_P_GLA) + (size_t)bh * 128 * DV;
#pragma unroll
            for (int kt = 0; kt < 8; ++kt)
#pragma unroll
                for (int r = 0; r < 4; ++r) out_S[(size_t)(16 * kt + 4 * q + r) * DV + vt * 16 + c] = S[kt][r];
        } else if (c == 0) {
            float* on = p.out + OUT_P_MN + (size_t)bh * 128;
#pragma unroll
            for (int kt = 0; kt < 8; ++kt)
#pragma unroll
                for (int r = 0; r < 4; ++r) on[16 * kt + 4 * q + r] = S[kt][r];
            if (q == 0) p.out[OUT_P_MM + bh] = mprev;
        }
    }
}

template <int MIX>
__device__ __forceinline__ void normgate_phase(const Params& p) {
    const int TID = opaque_tid();
    unsigned char* ws = opaque_ptr(p.ws);
    const bf16_t* P = (const bf16_t*)(ws + OFF_P);
    const float* O = (const float*)(ws + OFF_O);
    bf16_t* A2 = (bf16_t*)(ws + OFF_A2);
    const int wave = TID >> 6, lane = TID & 63;
    const float* ng = (MIX == 0) ? p.in[12] : (MIX == 1) ? p.in[18] : (MIX == 2) ? p.in[23] : p.in[28];
    constexpr int GOFF = (MIX == 0) ? 3072 : (MIX == 1) ? 3088 : (MIX == 2) ? 3088 : 2048;
    constexpr int R = 5;
    const int stride = gridDim.x * 4;
    const int c0 = lane * 16;
    for (int row0 = blockIdx.x * 4 + wave; row0 < MTOK; row0 += stride * R) {
        f32x4 ov[R][4]; u32x2 gw[R][4]; float denv[R], mtv[R];
#pragma unroll
        for (int u = 0; u < R; ++u) {
            const int row = (row0 + u * stride < MTOK) ? row0 + u * stride : row0;
#pragma unroll
            for (int j = 0; j < 4; ++j) {
                ov[u][j] = ldbf4((const bf16_t*)O + (size_t)row * 1024 + c0 + j * 4);
                gw[u][j] = *(const u32x2*)(P + (size_t)row * PLD + GOFF + c0 + j * 4);
            }
            if (MIX == 2) { denv[u] = ((const float*)(ws + OFF_DEN))[(size_t)row * 8 + (lane >> 3)]; mtv[u] = ((const float*)(ws + OFF_MT))[(size_t)row * 8 + (lane >> 3)]; }
        }
#pragma unroll
        for (int u = 0; u < R; ++u) {
            const int row = row0 + u * stride;
            if (row < MTOK) {
                float x[16], gt[16];
#pragma unroll
                for (int j = 0; j < 4; ++j) {
                    const f32x4 gg = (f32x4){__uint_as_float(gw[u][j].x << 16), __uint_as_float(gw[u][j].x & 0xffff0000u), __uint_as_float(gw[u][j].y << 16), __uint_as_float(gw[u][j].y & 0xffff0000u)};
#pragma unroll
                    for (int q = 0; q < 4; ++q) { x[j * 4 + q] = ov[u][j][q]; gt[j * 4 + q] = gg[q]; }
                }
                if (MIX == 2) {
                    const float inv = 1.f / fmaxf(fabsf(denv[u]), expf(-mtv[u]));
#pragma unroll
                    for (int j = 0; j < 16; ++j) x[j] *= inv;
                }
                float s1 = 0.f, s2 = 0.f;
#pragma unroll
                for (int j = 0; j < 16; ++j) { s1 += x[j]; s2 += x[j] * x[j]; }
                s1 += __shfl_xor(s1, 1); s1 += __shfl_xor(s1, 2); s1 += __shfl_xor(s1, 4);
                s2 += __shfl_xor(s2, 1); s2 += __shfl_xor(s2, 2); s2 += __shfl_xor(s2, 4);
                if (MIX == 3) { s1 += __shfl_xor(s1, 8); s2 += __shfl_xor(s2, 8); }
                constexpr float invn = (MIX == 3) ? (1.f / 256.f) : (1.f / 128.f);
                float outv[16];
                if (MIX == 2) {
                    const float mean = s1 * invn;
                    float q2 = 0.f;
#pragma unroll
                    for (int j = 0; j < 16; ++j) { const float d = x[j] - mean; q2 += d * d; }
                    q2 += __shfl_xor(q2, 1); q2 += __shfl_xor(q2, 2); q2 += __shfl_xor(q2, 4);
                    const float rs = rsqrtf(q2 * invn + 1e-6f);
#pragma unroll
                    for (int j = 0; j < 16; ++j) outv[j] = sigmoidf_(gt[j]) * ((x[j] - mean) * rs * ng[c0 + j]);
                } else {
                    const float rs = rsqrtf(s2 * invn + 1e-6f);
#pragma unroll
                    for (int j = 0; j < 16; ++j) {
                        const int gi = (MIX == 3) ? ((c0 + j) & 255) : ((c0 + j) & 127);
                        outv[j] = x[j] * rs * ng[gi] * siluf_(gt[j]);
                    }
                }
                uint4 w0, w1;
                w0.x = pack2bf(outv[0], outv[1]); w0.y = pack2bf(outv[2], outv[3]); w0.z = pack2bf(outv[4], outv[5]); w0.w = pack2bf(outv[6], outv[7]);
                w1.x = pack2bf(outv[8], outv[9]); w1.y = pack2bf(outv[10], outv[11]); w1.z = pack2bf(outv[12], outv[13]); w1.w = pack2bf(outv[14], outv[15]);
                *(uint4*)(A2 + (size_t)row * 1024 + c0) = w0; *(uint4*)(A2 + (size_t)row * 1024 + c0 + 8) = w1;
            }
        }
    }
    if (MIX == 1) {
        const float* cbuf = p.in[4];
        const int total = NSEQ * 3 * 3072;
        for (int i = blockIdx.x * NTH + TID; i < total; i += gridDim.x * NTH) {
            const int seq = i / (3 * 3072), rem = i % (3 * 3072), j = rem / 3072, cc = rem % 3072;
            if (seq < NB_P) p.out[OUT_P_CONV + (size_t)i] = bf2f(P[(size_t)(seq * T_P + T_P - 3 + j) * PLD + cc]);
            else {
                const int ss = seq - NB_P;
                const float v = (j < 2) ? cbuf[((size_t)ss * 3 + j + 1) * 3072 + cc] : bf2f(P[(size_t)(ROWS_P + ss) * PLD + cc]);
                p.out[OUT_S_CONV + ((size_t)ss * 3 + j) * 3072 + cc] = v;
            }
        }
    }
}

template <int which, int R>
__device__ __forceinline__ void ln_rows(const Params& p, int layer, bool dry) {
    const int TID = opaque_tid();
    unsigned char* ws = opaque_ptr(p.ws);
    const bf16_t* Hin = (const bf16_t*)(ws + OFF_HB);
    bf16_t* Hb = dry ? (bf16_t*)(ws + OFF_DRY + (size_t)MTOK * 4096) : (bf16_t*)(ws + OFF_HB);
    const float* Y = (const float*)(ws + OFF_O);
    const bf16_t* Fb = (const bf16_t*)(ws + OFF_F);
    const float* lg = p.in[35] + (size_t)(layer * 2 + which) * 1024;
    const float* lbias = p.in[36] + (size_t)(layer * 2 + which) * 1024;
    const int wave = TID >> 6, lane = TID & 63;
    const int stride = gridDim.x * 4;
    f32x4 gv[4], bv[4];
#pragma unroll
    for (int j = 0; j < 4; ++j) { gv[j] = *(const f32x4*)(lg + j * 256 + lane * 4); bv[j] = *(const f32x4*)(lbias + j * 256 + lane * 4); }
    for (int row0 = blockIdx.x * 4 + wave; row0 < MTOK; row0 += stride * R) {
        u32x2 hw[R][4], fw[R][4]; f32x4 yv[R][4];
#pragma unroll
        for (int u = 0; u < R; ++u) {
            const int row = (row0 + u * stride < MTOK) ? row0 + u * stride : row0;
#pragma unroll
            for (int j = 0; j < 4; ++j) {
                hw[u][j] = *(const u32x2*)(Hin + (size_t)row * 1024 + j * 256 + lane * 4);
                if (which) fw[u][j] = *(const u32x2*)(Fb + (size_t)row * 1024 + j * 256 + lane * 4);
                else yv[u][j] = *(const f32x4*)(Y + (size_t)row * 1024 + j * 256 + lane * 4);
            }
        }
#pragma unroll
        for (int u = 0; u < R; ++u) {
            const int row = row0 + u * stride;
            if (row < MTOK) {
                float z[16];
                float s1 = 0.f;
#pragma unroll
                for (int j = 0; j < 4; ++j) {
                    const f32x4 hv = (f32x4){__uint_as_float(hw[u][j].x << 16), __uint_as_float(hw[u][j].x & 0xffff0000u), __uint_as_float(hw[u][j].y << 16), __uint_as_float(hw[u][j].y & 0xffff0000u)};
                    f32x4 y4;
                    if (which) y4 = (f32x4){__uint_as_float(fw[u][j].x << 16), __uint_as_float(fw[u][j].x & 0xffff0000u), __uint_as_float(fw[u][j].y << 16), __uint_as_float(fw[u][j].y & 0xffff0000u)};
                    else y4 = yv[u][j];
#pragma unroll
                    for (int q = 0; q < 4; ++q) { z[j * 4 + q] = DN_ALPHA * hv[q] + y4[q]; s1 += z[j * 4 + q]; }
                }
                const float mean = wave_sum(s1) * (1.f / 1024.f);
                float s2 = 0.f;
#pragma unroll
                for (int j = 0; j < 16; ++j) { const float d = z[j] - mean; s2 += d * d; }
                const float rs = rsqrtf(wave_sum(s2) * (1.f / 1024.f) + 1e-5f);
                float o[16];
#pragma unroll
                for (int j = 0; j < 16; ++j) o[j] = (z[j] - mean) * rs * gv[j >> 2][j & 3] + bv[j >> 2][j & 3];
#pragma unroll
                for (int j = 0; j < 4; ++j) { u32x2 w; w.x = pack2bf(o[4 * j], o[4 * j + 1]); w.y = pack2bf(o[4 * j + 2], o[4 * j + 3]); *(u32x2*)(Hb + (size_t)row * 1024 + j * 256 + lane * 4) = w; }
                if (which == 0 && !dry) {
#pragma unroll
                    for (int j = 0; j < 4; ++j)
                        *(unsigned*)(ws + OFF_HQ + (size_t)row * 1024 + j * 256 + lane * 4) = pack_i8x4(o[4 * j] * (1.f / XQ_SCALE), o[4 * j + 1] * (1.f / XQ_SCALE), o[4 * j + 2] * (1.f / XQ_SCALE), o[4 * j + 3] * (1.f / XQ_SCALE));
                }
                if (which == 1 && layer == 3 && !dry) {
                    float* dst = nullptr;
                    if (row < ROWS_P) { const int b = row / T_P, t = row % T_P; if (t >= 16) dst = p.out + OUT_YP + ((size_t)b * 2048 + (t - 16)) * 1024; }
                    else dst = p.out + OUT_YS + (size_t)(row - ROWS_P) * 1024;
                    if (dst) {
#pragma unroll
                        for (int j = 0; j < 4; ++j) *(f32x4*)(dst + j * 256 + lane * 4) = (f32x4){o[j * 4], o[j * 4 + 1], o[j * 4 + 2], o[j * 4 + 3]};
                    }
                }
            }
        }
    }
}

__device__ __forceinline__ void ln_phase(const Params& p, int layer, int which, bool dry) {
    if (which == 0) ln_rows<0, 1>(p, layer, dry);
    else ln_rows<1, 9>(p, layer, dry);
}

#define KINS16(V, x_) do { const float xk_ = (x_); \
    _Pragma("unroll") for (int q_ = 15; q_ >= 1; --q_) V[q_] = __builtin_amdgcn_fmed3f(V[q_ - 1], V[q_], xk_); \
    V[0] = fmaxf(V[0], xk_); } while (0)
__device__ __forceinline__ float key_pack(float v, unsigned mask, unsigned id) { return __uint_as_float((__float_as_uint(v) & ~mask) | id); }
__device__ __forceinline__ float key_val(float k, unsigned mask) { return __uint_as_float(__float_as_uint(k) & ~mask); }

__device__ __forceinline__ void topk_phase(const Params& p) {
    const int TID = opaque_tid();
    unsigned char* ws = opaque_ptr(p.ws);
    const float* S1 = (const float*)(ws + OFF_S1);
    const float* S2 = (const float*)(ws + OFF_S2);
    int* TI = (int*)(ws + OFF_TI);
    float* TW = (float*)(ws + OFF_TW);
    const int NR = MTOK * 8;
    for (int r = blockIdx.x * NTH + TID; r < NR; r += gridDim.x * NTH) {
        float k1[16], k2[16];
#pragma unroll
        for (int q = 0; q < 16; ++q) { k1[q] = -INFINITY; k2[q] = -INFINITY; }
        const float* s1p = S1 + (size_t)(r >> 7) * 16384 + (r & 127);
        const float* s2p = S2 + (size_t)(r >> 7) * 16384 + (r & 127);
#pragma unroll 1
        for (int jb = 0; jb < 128; jb += 16) {
            float xs[16], ys[16];
#pragma unroll
            for (int j = 0; j < 16; ++j) { xs[j] = s1p[(jb + j) * 128]; ys[j] = s2p[(jb + j) * 128]; }
#pragma unroll
            for (int j = 0; j < 16; ++j) { KINS16(k1, key_pack(xs[j], 127u, (unsigned)(jb + j))); KINS16(k2, key_pack(ys[j], 127u, (unsigned)(jb + j))); }
        }
        float kc[16];
#pragma unroll
        for (int q = 0; q < 16; ++q) kc[q] = -INFINITY;
        {
            int slot = 0;
#pragma unroll
            for (int a = 0; a < 16; ++a)
#pragma unroll
                for (int b = 0; b < 16; ++b)
                    if ((a + 1) * (b + 1) <= 16) { const float sv = key_val(k1[a], 127u) + key_val(k2[b], 127u); KINS16(kc, key_pack(sv, 63u, (unsigned)slot)); ++slot; }
        }
        const float tau = kc[15], vmax = key_val(k1[0], 127u) + key_val(k2[0], 127u);
        float sum = 0.f;
        {
            int slot = 0;
#pragma unroll
            for (int a = 0; a < 16; ++a)
#pragma unroll
                for (int b = 0; b < 16; ++b)
                    if ((a + 1) * (b + 1) <= 16) { const float sv = key_val(k1[a], 127u) + key_val(k2[b], 127u); const bool sel = key_pack(sv, 63u, (unsigned)slot) >= tau; sum += sel ? __expf(sv - vmax) : 0.f; ++slot; }
        }
        const float inv = 1.f / sum;
        {
            int slot = 0, cnt = 0;
#pragma unroll
            for (int a = 0; a < 16; ++a)
#pragma unroll
                for (int b = 0; b < 16; ++b)
                    if ((a + 1) * (b + 1) <= 16) {
                        const float sv = key_val(k1[a], 127u) + key_val(k2[b], 127u); const bool sel = key_pack(sv, 63u, (unsigned)slot) >= tau;
                        if (sel) { TI[(size_t)r * 16 + cnt] = (int)(((__float_as_uint(k1[a]) & 127u) << 7) | (__float_as_uint(k2[b]) & 127u)); TW[(size_t)r * 16 + cnt] = __expf(sv - vmax) * inv; ++cnt; }
                        ++slot;
                    }
        }
    }
}

constexpr int ST_RS = 68;
constexpr int ST_BYTES = 64 * ST_RS * 4;
static_assert(4 * ST_BYTES <= LDS_BYTES, "score tiles exceed the LDS budget");
__device__ __forceinline__ void scoretopk_phase(const Params& p, int layer, unsigned char* lds) {
    const int TID = opaque_tid();
    unsigned char* ws = opaque_ptr(p.ws);
    const int wave = TID >> 6, lane = TID & 63, q = lane >> 4, c = lane & 15;
    const bf16_t* Q = (const bf16_t*)(ws + OFF_Q);
    const bf16_t* keys = (const bf16_t*)(ws + OFF_KEYS) + (size_t)layer * 2 * 16384;
    unsigned short* TI = (unsigned short*)(ws + OFF_TI);
    float* TW = (float*)(ws + OFF_TW);
    float* st = (float*)(lds + wave * ST_BYTES);
    for (int item = blockIdx.x * 4 + wave; item < 2048; item += gridDim.x * 4) {
        const int r0 = item * 65;
        float k1[16], k2[16];
#pragma unroll
        for (int i = 0; i < 16; ++i) { k1[i] = -INFINITY; k2[i] = -INFINITY; }
        float xe[4];
#pragma unroll
        for (int ph = 0; ph < 2; ++ph) {
            bf16x8 a[5][4];
#pragma unroll
            for (int rt = 0; rt < 5; ++rt)
#pragma unroll
                for (int ks = 0; ks < 4; ++ks) a[rt][ks] = *(const bf16x8*)(Q + (size_t)(r0 + 16 * rt + c) * 256 + ph * 128 + ks * 32 + q * 8);
#pragma unroll
            for (int kh = 0; kh < 2; ++kh) {
#pragma unroll
                for (int kt = 0; kt < 4; ++kt) {
                    f32x4 acc[5];
#pragma unroll
                    for (int rt = 0; rt < 5; ++rt) acc[rt] = (f32x4){0.f, 0.f, 0.f, 0.f};
#pragma unroll
                    for (int ks = 0; ks < 4; ++ks) {
                        const bf16x8 b = *(const bf16x8*)(keys + ph * 16384 + (size_t)(kh * 64 + kt * 16 + c) * 128 + ks * 32 + q * 8);
#pragma unroll
                        for (int rt = 0; rt < 5; ++rt) acc[rt] = __builtin_amdgcn_mfma_f32_16x16x32_bf16(a[rt][ks], b, acc[rt], 0, 0, 0);
                    }
#pragma unroll
                    for (int rt = 0; rt < 4; ++rt) *(f32x4*)(st + (kt * 16 + c) * ST_RS + 16 * rt + 4 * q) = acc[rt];
                    if (q == 0) st[(kt * 16 + c) * ST_RS + 64] = acc[4][0];
                }
#pragma unroll 1
                for (int jb = 0; jb < 64; jb += 16) {
                    float xs[16];
#pragma unroll
                    for (int j = 0; j < 16; ++j) xs[j] = st[(jb + j) * ST_RS + lane];
#pragma unroll
                    for (int j = 0; j < 16; ++j) {
                        const float kx = key_pack(xs[j], 127u, (unsigned)(kh * 64 + jb + j));
                        if (ph == 0) KINS16(k1, kx); else KINS16(k2, kx);
                    }
                }
                xe[ph * 2 + kh] = key_pack(st[lane * ST_RS + 64], 127u, (unsigned)(kh * 64 + lane));
            }
        }
        {
            const int r = r0 + lane;
            float kc[16];
#pragma unroll
            for (int i = 0; i < 16; ++i) kc[i] = -INFINITY;
            unsigned ia_[16], ib_[16];
#pragma unroll
            for (int i = 0; i < 16; ++i) { ia_[i] = (__float_as_uint(k1[i]) & 127u) << 7; ib_[i] = __float_as_uint(k2[i]) & 127u; }
#pragma unroll
            for (int a_ = 0; a_ < 16; ++a_)
#pragma unroll
                for (int b_ = 0; b_ < 16; ++b_)
                    if ((a_ + 1) * (b_ + 1) <= 16) { const float sv = key_val(k1[a_], 127u) + key_val(k2[b_], 127u); KINS16(kc, key_pack(sv, 0x3fffu, ia_[a_] | ib_[b_])); }
            const float vmax = key_val(kc[0], 0x3fffu);
            float ew[16], sum = 0.f;
#pragma unroll
            for (int i = 0; i < 16; ++i) { ew[i] = __expf(key_val(kc[i], 0x3fffu) - vmax); sum += ew[i]; }
            const float inv = 1.f / sum;
            u32x4 t0, t1;
#pragma unroll
            for (int i = 0; i < 4; ++i) {
                t0[i] = (__float_as_uint(kc[2 * i]) & 0x3fffu) | ((__float_as_uint(kc[2 * i + 1]) & 0x3fffu) << 16);
                t1[i] = (__float_as_uint(kc[8 + 2 * i]) & 0x3fffu) | ((__float_as_uint(kc[8 + 2 * i + 1]) & 0x3fffu) << 16);
            }
            *(u32x4*)(TI + (size_t)r * 16) = t0; *(u32x4*)(TI + (size_t)r * 16 + 8) = t1;
#pragma unroll
            for (int i = 0; i < 4; ++i) *(f32x4*)(TW + (size_t)r * 16 + 4 * i) = (f32x4){ew[4 * i] * inv, ew[4 * i + 1] * inv, ew[4 * i + 2] * inv, ew[4 * i + 3] * inv};
        }
        {
            const int r = r0 + 64;
            float l1[16], l2[16];
            float xa = xe[0], xb = xe[1], ya = xe[2], yb = xe[3];
#pragma unroll
            for (int i = 0; i < 16; ++i) {
                const float m1 = wave_max_u(fmaxf(xa, xb)), m2 = wave_max_u(fmaxf(ya, yb));
                l1[i] = m1; l2[i] = m2;
                xa = (xa == m1) ? -INFINITY : xa; xb = (xb == m1) ? -INFINITY : xb;
                ya = (ya == m2) ? -INFINITY : ya; yb = (yb == m2) ? -INFINITY : yb;
            }
            const int s = lane;
            int ca, cb;
            if (s < 16) { ca = 0; cb = s; } else if (s < 24) { ca = 1; cb = s - 16; } else if (s < 29) { ca = 2; cb = s - 24; } else if (s < 33) { ca = 3; cb = s - 29; }
            else if (s < 36) { ca = 4; cb = s - 33; } else if (s < 42) { ca = 5 + ((s - 36) >> 1); cb = (s - 36) & 1; } else { ca = 8 + (s - 42); cb = 0; }
            float ka = l1[0], kb = l2[0];
#pragma unroll
            for (int i = 1; i < 16; ++i) { ka = (ca == i) ? l1[i] : ka; kb = (cb == i) ? l2[i] : kb; }
            const float sv = key_val(ka, 127u) + key_val(kb, 127u);
            const float ck = (s < 50) ? key_pack(sv, 0x3fffu, ((__float_as_uint(ka) & 127u) << 7) | (__float_as_uint(kb) & 127u)) : -INFINITY;
            float cx = ck, mine = 0.f, vmax = 0.f, sum = 0.f;
#pragma unroll
            for (int i = 0; i < 16; ++i) {
                const float mx = wave_max_u(cx);
                cx = (cx == mx) ? -INFINITY : cx;
                if (i == 0) vmax = key_val(mx, 0x3fffu);
                sum += __expf(key_val(mx, 0x3fffu) - vmax);
                mine = (lane == i) ? mx : mine;
            }
            if (lane < 16) { TI[(size_t)r * 16 + lane] = (unsigned short)(__float_as_uint(mine) & 0x3fffu); TW[(size_t)r * 16 + lane] = __expf(key_val(mine, 0x3fffu) - vmax) / sum; }
        }
    }
}

__device__ __forceinline__ float gelu_erf(float d) { return 0.5f * d * (1.f + erff(d * 0.70710678118654752f)); }
#define XCD_BAR_WORDS 3456
constexpr int GQ_TW = 16;
constexpr int GQ_PER_SLICE = MTOK / (4 * GQ_TW);
__device__ __forceinline__ unsigned gq_xcc_id() { return (unsigned)__builtin_amdgcn_s_getreg((3 << 11) | 20) & 0xFu; }
__device__ __forceinline__ int queue_take(unsigned* cnt, int own, volatile LDSP int* bc, int tid) {
    if (tid == 0) {
        int it = -1;
        for (int k = 0; k < 8 && it < 0; ++k) {
            const int s_ = (own + k) & 7; unsigned* c = cnt + s_ * 16;
            if (__hip_atomic_load(c, __ATOMIC_RELAXED, __HIP_MEMORY_SCOPE_AGENT) < (unsigned)GQ_PER_SLICE) {
                const unsigned v = __hip_atomic_fetch_add(c, 1u, __ATOMIC_RELAXED, __HIP_MEMORY_SCOPE_AGENT);
                if (v < (unsigned)GQ_PER_SLICE) it = s_ * GQ_PER_SLICE + (int)v;
            }
        }
        bc[0] = it;
    }
    __syncthreads();
    const int it = bc[0];
    __syncthreads();
    return it;
}
__device__ __forceinline__ float dpp_add(float v, int ctrl_sel) {
    const int x = __builtin_bit_cast(int, v);
    int y;
    if (ctrl_sel == 0) y = __builtin_amdgcn_update_dpp(0, x, 0xB1, 0xF, 0xF, true);
    else if (ctrl_sel == 1) y = __builtin_amdgcn_update_dpp(0, x, 0x4E, 0xF, 0xF, true);
    else y = __builtin_amdgcn_update_dpp(0, x, 0x141, 0xF, 0xF, true);
    return v + __builtin_bit_cast(float, y);
}
__device__ __forceinline__ float sum8(float v) { v = dpp_add(v, 0); v = dpp_add(v, 1); v = dpp_add(v, 2); return v; }
#define CVT8(w_, lo_, hi_) const f32x2 lo_ = __builtin_amdgcn_cvt_pk_f32_fp8((int)(w_), false), hi_ = __builtin_amdgcn_cvt_pk_f32_fp8((int)(w_), true)

__device__ __forceinline__ void gatherU_phase(const Params& p, int layer, unsigned char* lds, int rep) {
    const int TID = opaque_tid();
    unsigned char* ws = opaque_ptr(p.ws);
    const unsigned char* Hq = ws + OFF_HQ;
    const unsigned short* TI = (const unsigned short*)(ws + OFF_TI);
    unsigned* cnt = (unsigned*)(ws + OFF_BAR) + XCD_BAR_WORDS + (layer * 4 + 0 + rep) * 128;
    const int wave = TID >> 6, lane = TID & 63, e = lane >> 3, c = lane & 7;
    const int own = (int)(gq_xcc_id() & 7u);
    auto process = [&](const int sl, const int tbase, const int ntok) {
        const unsigned char* Us = ws + OFF_UB + ((size_t)(layer * 8 + sl) * NEXP) * 128;
        bf16_t* PD = (bf16_t*)(ws + OFF_PD) + (size_t)sl * MTOK * 128;
        int i0 = TI[(size_t)tbase * 128 + lane], i1 = TI[(size_t)tbase * 128 + 64 + lane];
        u32x4 ub[16]; u32x4 xq, nxq;
        xq = *(const u32x4*)(Hq + (size_t)tbase * 1024 + sl * 128 + c * 16);
#pragma unroll
        for (int ii = 0; ii < 16; ++ii) { const int ej = __shfl((ii < 8) ? i0 : i1, (ii & 7) * 8 + e); ub[ii] = *(const u32x4*)(Us + (unsigned)(ej * 128 + c * 16)); }
        int n0 = TI[(size_t)(tbase + 1) * 128 + lane], n1 = TI[(size_t)(tbase + 1) * 128 + 64 + lane];
#pragma unroll 1
        for (int i = 0; i < ntok; ++i) {
            const int t = tbase + i, tn = tbase + ((i + 1 < ntok) ? i + 1 : ntok - 1), tnn = tbase + ((i + 2 < ntok) ? i + 2 : ntok - 1);
            nxq = *(const u32x4*)(Hq + (size_t)tn * 1024 + sl * 128 + c * 16);
            const int nn0 = TI[(size_t)tnn * 128 + lane], nn1 = TI[(size_t)tnn * 128 + 64 + lane];
            float k0 = 0.f, k1 = 0.f;
#pragma unroll
            for (int ii = 0; ii < 16; ++ii) {
                int di = __builtin_amdgcn_sdot4((int)ub[ii][0], (int)xq[0], 0, false);
                di = __builtin_amdgcn_sdot4((int)ub[ii][1], (int)xq[1], di, false);
                int dj = __builtin_amdgcn_sdot4((int)ub[ii][2], (int)xq[2], 0, false);
                dj = __builtin_amdgcn_sdot4((int)ub[ii][3], (int)xq[3], dj, false);
                float d = (float)(di + dj);
                { const int ej = __shfl((ii < 8) ? n0 : n1, (ii & 7) * 8 + e); ub[ii] = *(const u32x4*)(Us + (unsigned)(ej * 128 + c * 16)); }
                d = sum8(d);
                if (ii < 8) k0 = (ii == c) ? d : k0; else k1 = ((ii - 8) == c) ? d : k1;
            }
            PD[(size_t)t * 128 + c * 8 + e] = f2bf(k0);
            PD[(size_t)t * 128 + 64 + c * 8 + e] = f2bf(k1);
            xq = nxq; n0 = nn0; n1 = nn1;
        }
    };
    volatile LDSP unsigned* st_ = (volatile LDSP unsigned*)(lds + LDS_BYTES);
    if (st_[3] != 0u) {
        process(own, 65 * ((int)st_[2] * 4 + wave), 65);
    } else for (;;) {
        const int item = __builtin_amdgcn_readfirstlane(queue_take(cnt, own, (volatile LDSP int*)lds, TID));
        if (item < 0) break;
        process(item / GQ_PER_SLICE, (item % GQ_PER_SLICE) * (4 * GQ_TW) + wave * GQ_TW, GQ_TW);
    }
}

__device__ __forceinline__ void gatherW_phase(const Params& p, int layer) {
    const int TID = opaque_tid();
    unsigned char* ws = opaque_ptr(p.ws);
    const unsigned short* TI = (const unsigned short*)(ws + OFF_TI);
    const float* TW = (const float*)(ws + OFF_TW);
    bf16_t* TWb = (bf16_t*)(ws + OFF_TI + (size_t)MTOK * 128 * 2);
    const float* SU = (const float*)(ws + OFF_SU) + (size_t)layer * NEXP;
    const float* SV = (const float*)(ws + OFF_SV) + (size_t)layer * NEXP;
    const bf16_t* PD = (const bf16_t*)(ws + OFF_PD);
    const int n = MTOK * 128;
    for (int i = blockIdx.x * NTH + TID; i < n; i += gridDim.x * NTH) {
        float d = 0.f;
#pragma unroll
        for (int s_ = 0; s_ < 8; ++s_) d += bf2f(PD[(size_t)s_ * n + i]);
        const int e = TI[i];
        TWb[i] = f2bf(TW[i] * SV[e] * gelu_erf(d * (SU[e] * XQ_SCALE)));
    }
}

__device__ __forceinline__ void gatherV_phase(const Params& p, int layer, unsigned char* lds, int rep) {
    const int TID = opaque_tid();
    unsigned char* ws = opaque_ptr(p.ws);
    const unsigned short* TI = (const unsigned short*)(ws + OFF_TI);
    const bf16_t* TW = (const bf16_t*)(ws + OFF_TI + (size_t)MTOK * 128 * 2);
    bf16_t* F = (bf16_t*)(ws + OFF_F);
    unsigned* cnt = (unsigned*)(ws + OFF_BAR) + XCD_BAR_WORDS + (layer * 4 + 2 + rep) * 128;
    const int wave = TID >> 6, lane = TID & 63, e = lane >> 3, c = lane & 7;
    const int own = (int)(gq_xcc_id() & 7u);
    auto process = [&](const int sl, const int tbase, const int ntok) {
        const unsigned char* Vs = ws + OFF_VB + ((size_t)(layer * 8 + sl) * NEXP) * 128;
        int i0 = TI[(size_t)tbase * 128 + lane], i1 = TI[(size_t)tbase * 128 + 64 + lane];
        float w0 = bf2f(TW[(size_t)tbase * 128 + lane]), w1 = bf2f(TW[(size_t)tbase * 128 + 64 + lane]);
        u32x4 vbA[8], vbB[8];
#pragma unroll
        for (int ii = 0; ii < 8; ++ii) { const int ej = __shfl(i0, ii * 8 + e); vbA[ii] = *(const u32x4*)(Vs + (unsigned)(ej * 128 + c * 16)); }
#pragma unroll 1
        for (int i = 0; i < ntok; ++i) {
            const int t = tbase + i, tn = tbase + ((i + 1 < ntok) ? i + 1 : ntok - 1);
#pragma unroll
            for (int ii = 0; ii < 8; ++ii) { const int ej = __shfl(i1, ii * 8 + e); vbB[ii] = *(const u32x4*)(Vs + (unsigned)(ej * 128 + c * 16)); }
            const int n0 = TI[(size_t)tn * 128 + lane], n1 = TI[(size_t)tn * 128 + 64 + lane];
            const float nw0 = bf2f(TW[(size_t)tn * 128 + lane]), nw1 = bf2f(TW[(size_t)tn * 128 + 64 + lane]);
            float acc[16];
#pragma unroll
            for (int j = 0; j < 16; ++j) acc[j] = 0.f;
#pragma unroll
            for (int ii = 0; ii < 8; ++ii) {
                const float wj = __shfl(w0, ii * 8 + e);
#pragma unroll
                for (int q = 0; q < 4; ++q) { CVT8(vbA[ii][q], lo, hi); acc[4 * q] += wj * lo[0]; acc[4 * q + 1] += wj * lo[1]; acc[4 * q + 2] += wj * hi[0]; acc[4 * q + 3] += wj * hi[1]; }
            }
            asm volatile("" ::: "memory");
#pragma unroll
            for (int ii = 0; ii < 8; ++ii) { const int ej = __shfl(n0, ii * 8 + e); vbA[ii] = *(const u32x4*)(Vs + (unsigned)(ej * 128 + c * 16)); }
#pragma unroll
            for (int ii = 0; ii < 8; ++ii) {
                const float wj = __shfl(w1, ii * 8 + e);
#pragma unroll
                for (int q = 0; q < 4; ++q) { CVT8(vbB[ii][q], lo, hi); acc[4 * q] += wj * lo[0]; acc[4 * q + 1] += wj * lo[1]; acc[4 * q + 2] += wj * hi[0]; acc[4 * q + 3] += wj * hi[1]; }
            }
            float r8[8], r4[4], r2[2];
#pragma unroll
            for (int j = 0; j < 8; ++j) { const bool up = lane >= 32; const float snd = up ? acc[j] : acc[j + 8], keep = up ? acc[j + 8] : acc[j]; r8[j] = keep + __shfl_xor(snd, 32); }
#pragma unroll
            for (int j = 0; j < 4; ++j) { const bool up = (lane & 16) != 0; const float snd = up ? r8[j] : r8[j + 4], keep = up ? r8[j + 4] : r8[j]; r4[j] = keep + __shfl_xor(snd, 16); }
#pragma unroll
            for (int j = 0; j < 2; ++j) { const bool up = (lane & 8) != 0; const float snd = up ? r4[j] : r4[j + 2], keep = up ? r4[j + 2] : r4[j]; r2[j] = keep + __shfl_xor(snd, 8); }
            const int col = sl * 128 + c * 16 + ((lane >> 5) & 1) * 8 + ((lane >> 4) & 1) * 4 + ((lane >> 3) & 1) * 2;
            *(unsigned*)(F + (size_t)t * 1024 + col) = cvt_pk_bf16(r2[0], r2[1]);
            w0 = nw0; w1 = nw1; i0 = n0; i1 = n1;
        }
    };
    volatile LDSP unsigned* st_ = (volatile LDSP unsigned*)(lds + LDS_BYTES);
    if (st_[3] != 0u) {
        process(own, 65 * ((int)st_[2] * 4 + wave), 65);
    } else for (;;) {
        const int item = __builtin_amdgcn_readfirstlane(queue_take(cnt, own, (volatile LDSP int*)lds, TID));
        if (item < 0) break;
        process(item / GQ_PER_SLICE, (item % GQ_PER_SLICE) * (4 * GQ_TW) + wave * GQ_TW, GQ_TW);
    }
}

#define XB_TMO      128
#define XB_XCNT(j)  (256  + 64 * (j))
#define XB_XSUB(j)  (1280 + 64 * (j))
#define XB_XGEN(j)  (2304 + 64 * (j))
#define XB_TOP      3328
#define XB_TOPGEN   3392
#define XB_SPIN_CAP (1u << 22)
__device__ __forceinline__ unsigned xb_ld(unsigned* p)              { return __hip_atomic_load(p, __ATOMIC_RELAXED, __HIP_MEMORY_SCOPE_AGENT); }
__device__ __forceinline__ unsigned xb_add(unsigned* p, unsigned v) { return __hip_atomic_fetch_add(p, v, __ATOMIC_RELAXED, __HIP_MEMORY_SCOPE_AGENT); }
__device__ __forceinline__ unsigned xb_xcc_id() { return (unsigned)__builtin_amdgcn_s_getreg((3 << 11) | 20) & 0xFu; }
#define XB_SPIN(cond, bar) do { unsigned _sp = 0; while (cond) { __builtin_amdgcn_s_sleep(1); \
    if ((++_sp & 255u) == 0u) { if (xb_ld(&(bar)[XB_TMO])) break; if (_sp > XB_SPIN_CAP) { atomicAdd(&(bar)[XB_TMO], 1u); break; } } } } while (0)
struct XcdBarrier { unsigned* bar; unsigned x; volatile LDSP unsigned* st; };
__device__ __forceinline__ XcdBarrier xcd_barrier_post(unsigned* bar, volatile LDSP unsigned* st) {
    XcdBarrier b; b.bar = bar; b.x = xb_xcc_id(); b.st = st;
    if (threadIdx.x == 0) st[2] = xb_add(&bar[XB_XCNT(b.x)], 1u);
    return b;
}
__device__ __forceinline__ void xcd_barrier_complete(unsigned* bar, unsigned x, unsigned& nloc, unsigned& nx, unsigned& balanced) {
    const unsigned G = gridDim.x * gridDim.y * gridDim.z;
    unsigned sum, cnt, mine, sp = 0u;
    for (;;) {
        sum = 0u; cnt = 0u; mine = 0u;
#pragma unroll
        for (unsigned j = 0; j < 16; ++j) { const unsigned c = xb_ld(&bar[XB_XCNT(j)]); sum += c; cnt += (c > 0u) ? 1u : 0u; mine = (j == x) ? c : mine; }
        if (sum == G) break;
        __builtin_amdgcn_s_sleep(1);
        if ((++sp & 255u) == 0u) { if (xb_ld(&bar[XB_TMO])) break; if (sp > XB_SPIN_CAP) { atomicAdd(&bar[XB_TMO], 1u); break; } }
    }
    nloc = mine > 0u ? mine : 1u; nx = cnt > 0u ? cnt : 1u;
    unsigned ok = 1u;
#pragma unroll
    for (unsigned j = 0; j < 8; ++j) ok &= (xb_ld(&bar[XB_XCNT(j)]) == 64u) ? 1u : 0u;
    balanced = (ok && G == 512u) ? 1u : 0u;
}
__device__ __forceinline__ void xcd_barrier(const XcdBarrier& b) {
    asm volatile("s_waitcnt vmcnt(0)" ::: "memory");
    __syncthreads();
    if (threadIdx.x == 0) {
        unsigned* bar = b.bar;
        __builtin_amdgcn_s_waitcnt(0);
        unsigned nloc = b.st[0], nx = b.st[1];
        if (nloc == 0u) { unsigned bal; xcd_barrier_complete(bar, b.x, nloc, nx, bal); b.st[0] = nloc; b.st[1] = nx; b.st[3] = bal; }
        const unsigned old = xb_add(&bar[XB_XSUB(b.x)], 1u);
        const unsigned gen = old / nloc;
        if (old + 1u == (gen + 1u) * nloc) {
            __builtin_amdgcn_fence(__ATOMIC_RELEASE, "agent");
            asm volatile("s_waitcnt vmcnt(0)" ::: "memory");
            const unsigned og = xb_add(&bar[XB_TOP], 1u);
            const unsigned tg = og / nx;
            if (og + 1u == (tg + 1u) * nx) xb_add(&bar[XB_TOPGEN], 1u);
            else XB_SPIN(xb_ld(&bar[XB_TOPGEN]) == tg, bar);
            __builtin_amdgcn_fence(__ATOMIC_ACQUIRE, "agent");
            xb_add(&bar[XB_XGEN(b.x)], 1u);
            asm volatile("s_waitcnt vmcnt(0)" ::: "memory");
        } else {
            XB_SPIN(xb_ld(&bar[XB_XGEN(b.x)]) == gen, bar);
            __builtin_amdgcn_fence(__ATOMIC_ACQUIRE, "agent");
            asm volatile("s_waitcnt vmcnt(0)" ::: "memory");
        }
    }
    __syncthreads();
}

constexpr int NSUB = 13;
constexpr int NPHASE = 1 + 4 * NSUB;
static_assert(OFF_DF + (size_t)NCHUNK_MAX * 128 * 4 <= OFF_KF, "chunk record overlay overflow");
static_assert(WS_NEED <= (size_t)940 * 1024 * 1024, "workspace map exceeds the guaranteed workspace (sum of inputs = 946 MiB)");

__device__ __forceinline__ void run_phase(const Params& p, int ph, unsigned char* lds, bool dry) {
    unsigned char* ws = opaque_ptr(p.ws);
    if (ph == 0) { phase_prologue(p, (float*)lds); return; }
    const int layer = (ph - 1) / NSUB, pos = (ph - 1) % NSUB;
    const int sub = (pos < 2) ? pos : (pos == 2) ? 9 : (pos < 10) ? pos - 1 : pos;
    const bf16_t* Hb = (const bf16_t*)(ws + OFF_HB);
    switch (sub) {
    case 0: {
        const int wrow = (layer == 0) ? WIN_ROWS0 : (layer == 1) ? WIN_ROWS1 : (layer == 2) ? WIN_ROWS2 : WIN_ROWS3;
        const int nmain = (layer == 3) ? 3072 : 4096;
        if (layer > 0) skinny16_phase((const bf16_t*)(ws + OFF_WIN) + (size_t)(wrow + 3072) * 1024, Hb, (float*)(ws + OFF_PG), 16);
        gemm130_phase<true>((const bf16_t*)(ws + OFF_WIN) + (size_t)wrow * 1024, Hb, ws + OFF_P, PLD, nmain, 1024, lds, LnEpi{}, (layer == 1 || layer == 2) ? 3072 : (1 << 30));
    } break;
    case 1:
        if (layer == 0) scanA_phase<0>(p, (float*)lds); else if (layer == 1) scanA_phase<1>(p, (float*)lds);
        else if (layer == 2) scanA_phase<2>(p, (float*)lds); else scanA_phase<3>(p, (float*)lds);
        break;
    case 9:
#if PROBE_LITE
        if (dry) { if (layer == 0) seq_phase<0, true>(p, lds); else if (layer == 3) seq_phase<3, true>(p, lds); break; }
#endif
        if (layer == 0) seq_phase<0>(p, lds); else if (layer == 1) seq_phase<1>(p, lds);
        else if (layer == 2) seq_phase<2>(p, lds); else seq_phase<3>(p, lds);
        break;
    case 2:
        if (layer == 0) normgate_phase<0>(p); else if (layer == 1) normgate_phase<1>(p);
        else if (layer == 2) normgate_phase<2>(p); else normgate_phase<3>(p);
        break;
    case 3:
        if (gridDim.x >= 512 && !dry) {
            LnEpi le; le.H = (float*)(ws + OFF_H); le.Hb = (bf16_t*)(ws + OFF_HB); le.Hq = ws + OFF_HQ; le.g = p.in[35] + (size_t)(layer * 2) * 1024; le.b = p.in[36] + (size_t)(layer * 2) * 1024;
            le.xch = (unsigned long long*)(ws + OFF_XCH) + (size_t)layer * 128 * 4 * 144; le.cnt = (unsigned*)(ws + OFF_BAR) + XCD_BAR_WORDS + 2048 + layer * 128;
            gemm130_phase<false, true>((const bf16_t*)(ws + OFF_WOUT) + (size_t)layer * 1024 * 1024, (const bf16_t*)(ws + OFF_A2), nullptr, 1024, 1024, 1024, lds, le);
        } else gemm130_phase<false>((const bf16_t*)(ws + OFF_WOUT) + (size_t)layer * 1024 * 1024, (const bf16_t*)(ws + OFF_A2), ws + OFF_O, 1024, 1024, 1024, lds);
        break;
    case 4: if (gridDim.x < 512) ln_phase(p, layer, 0, dry); break;
    case 5:
        gemm130_phase<true>((const bf16_t*)(ws + OFF_WQ) + (size_t)layer * 2048 * 1024, Hb, ws + OFF_Q, 2048, 2048, 1024, lds);
        break;
    case 6: break;
    case 7: scoretopk_phase(p, layer, lds); break;
    case 8: gatherU_phase(p, layer, lds, dry ? 1 : 0); break;
    case 10: if (!dry) gatherW_phase(p, layer); break;
    case 11: gatherV_phase(p, layer, lds, dry ? 1 : 0); break;
    case 12: ln_phase(p, layer, 1, dry); break;
    }
}

__global__ void __launch_bounds__(NTH, 2) mega_kernel(Params p, int ph_lo, int ph_hi) {
    __shared__ __attribute__((aligned(16))) unsigned char lds[LDS_BYTES + 16];
    cg::grid_group grid = cg::this_grid();
    volatile LDSP unsigned* st = (volatile LDSP unsigned*)(lds + LDS_BYTES);
    if (threadIdx.x < 4) st[threadIdx.x] = 0u;
    __syncthreads();
    XcdBarrier xb = xcd_barrier_post((unsigned*)(p.ws + OFF_BAR), st);
    for (int ph = ph_lo; ph < ph_hi; ++ph) {
        if (ph > 0 && (ph - 1) % NSUB == 5 && gridDim.x >= 512) continue;
        if (ph > 0 && (ph - 1) % NSUB == 7) continue;
        int reps = 1;
#if PROBE_MASK
        if (ph > 0 && ((PROBE_MASK >> ((ph - 1) % NSUB)) & 1)) reps = 2;
        if (ph == 0 && (PROBE_MASK & 8192)) reps = 2;
#endif
        for (int rep = 0; rep < reps; ++rep) {
            if (rep) xcd_barrier(xb);
            run_phase(p, ph, lds, rep > 0);
        }
        if (ph + 1 < ph_hi) { if (ph == ph_lo) grid.sync(); else xcd_barrier(xb); }
#if PROBE_BARRIERS
        if (ph == 7) { for (int k_ = 0; k_ < PROBE_BARRIERS; ++k_) xcd_barrier(xb); }
#endif
    }
}

extern "C" void kernel_launch(void* const* d_in, const int* in_sizes, int n_in, void* d_out, int out_size, void* d_ws, size_t ws_size, hipStream_t stream) {
    static int grid_blocks = 0;
    if (!grid_blocks) {
        int dev = 0, cus = 0, per_cu = 0;
        hipGetDevice(&dev);
        hipDeviceGetAttribute(&cus, hipDeviceAttributeMultiprocessorCount, dev);
        hipOccupancyMaxActiveBlocksPerMultiprocessor(&per_cu, mega_kernel, NTH, 0);
        if (per_cu > 2) per_cu = 2;
        if (per_cu < 1) per_cu = 1;
        grid_blocks = cus * per_cu;
    }
    if (ws_size < WS_NEED) { fprintf(stderr, "workspace too small: %zu < %zu\n", ws_size, (size_t)WS_NEED); return; }
    if ((size_t)out_size != OUT_TOTAL) fprintf(stderr, "unexpected out_size %d vs %zu\n", out_size, (size_t)OUT_TOTAL);
    Params p{};
    for (int i = 0; i < 37; ++i) p.in[i] = (const float*)d_in[i];
    p.out = (float*)d_out;
    p.ws = (unsigned char*)d_ws;
#if SINGLE_LAUNCH
    hipMemsetAsync((unsigned char*)d_ws + OFF_BAR, 0, (XCD_BAR_WORDS + 2048 + 512) * 4, stream);
    int lo = 0, hi = NPHASE;
    void* args[] = {&p, &lo, &hi};
    hipError_t e = hipLaunchCooperativeKernel((void*)mega_kernel, dim3(grid_blocks), dim3(NTH), args, 0, stream);
    if (e != hipSuccess) fprintf(stderr, "cooperative launch failed: %s (grid %d)\n", hipGetErrorString(e), grid_blocks);
#else
    for (int ph = 0; ph < NPHASE; ++ph) mega_kernel<<<grid_blocks, NTH, 0, stream>>>(p, ph, ph + 1);
#endif
}
```

```cpp
#include <hip/hip_runtime.h>
#include <hip/hip_cooperative_groups.h>
#include <cstdio>
#include <cstdint>
namespace cg = cooperative_groups;

#ifndef OLD_PREPASS_MASK
#define OLD_PREPASS_MASK 0
#endif
#ifndef PROBE_BARRIERS
#define PROBE_BARRIERS 0
#endif
#ifndef PROBE_LITE
#define PROBE_LITE 0
#endif
#ifndef PROBE_MASK
#define PROBE_MASK 0
#endif
#ifndef SAMPLE_IN_SEQ
#define SAMPLE_IN_SEQ 1
#endif
#ifndef SINGLE_LAUNCH
#define SINGLE_LAUNCH 1
#endif

typedef unsigned short bf16_t;
typedef short bf16x8 __attribute__((ext_vector_type(8)));
typedef float f32x4 __attribute__((ext_vector_type(4)));
typedef __bf16 bf16x2 __attribute__((ext_vector_type(2)));
typedef short bf16x4 __attribute__((ext_vector_type(4)));
typedef unsigned u32x4 __attribute__((ext_vector_type(4)));
typedef unsigned u32x2 __attribute__((ext_vector_type(2)));
#define LDSP __attribute__((address_space(3)))

constexpr int D = 1024;
constexpr int NB_P = 8, T_P = 2064, NB_S = 128;
constexpr int ROWS_P = NB_P * T_P;
constexpr int MTOK = ROWS_P + NB_S;
constexpr int NSEQ = NB_P + NB_S;
constexpr int PLD = 4352;
constexpr int NEXP = 16384;
constexpr float DN_ALPHA = 1.6817928305074292f;
constexpr int NTH = 256;
constexpr int LDS_BYTES = 79872;

constexpr size_t al256(size_t x) { return (x + 255) & ~(size_t)255; }
constexpr int WIN_ROWS0 = 0, WIN_ROWS1 = 4096, WIN_ROWS2 = 4096 + 4352, WIN_ROWS3 = 4096 + 2 * 4352, WIN_ROWS = 4096 + 2 * 4352 + 3328;
constexpr size_t OFF_WIN = 0;
constexpr size_t OFF_WOUT = OFF_WIN + al256((size_t)WIN_ROWS * 1024 * 2);
constexpr size_t OFF_WQ = OFF_WOUT + al256((size_t)4 * 1024 * 1024 * 2);
constexpr size_t OFF_KEYS = OFF_WQ + al256((size_t)4 * 2048 * 1024 * 2);
constexpr size_t OFF_UB = OFF_KEYS + al256((size_t)4 * 2 * 128 * 128 * 2);
constexpr size_t OFF_VB = OFF_UB + al256((size_t)4 * NEXP * 1024);
constexpr size_t OFF_SU = OFF_VB + al256((size_t)4 * NEXP * 1024);
constexpr size_t OFF_SV = OFF_SU + al256((size_t)4 * NEXP * 4);
constexpr size_t OFF_LB = OFF_SV + al256((size_t)4 * NEXP * 4);
constexpr size_t OFF_H = OFF_LB + al256(1024 * 4);
constexpr size_t OFF_PG = OFF_H;
constexpr size_t OFF_HB = OFF_H + al256((size_t)MTOK * 1024 * 4);
constexpr size_t OFF_P = OFF_HB + al256((size_t)MTOK * 1024 * 2);
constexpr size_t OFF_Q = OFF_P;
constexpr size_t OFF_S1 = OFF_P + al256((size_t)MTOK * 2048 * 2);
constexpr size_t OFF_S2 = OFF_S1 + al256((size_t)128 * MTOK * 8 * 4);
constexpr size_t OFF_PD = OFF_P;
constexpr size_t OFF_F = OFF_P + al256((size_t)8 * MTOK * 128 * 4);
constexpr size_t OFF_DRY = OFF_F + al256((size_t)MTOK * 1024 * 4);
constexpr size_t OFF_O = OFF_P + al256((size_t)MTOK * PLD * 4);
constexpr size_t OFF_A2 = OFF_O + al256((size_t)MTOK * 1024 * 4);
constexpr size_t OFF_TI = OFF_A2 + al256((size_t)MTOK * 1024 * 2);
constexpr size_t OFF_TW = OFF_TI + al256((size_t)MTOK * 128 * 4);
constexpr int NCHUNK_MAX = 8 * 8 * 129;
constexpr size_t OFF_QF = OFF_A2;
constexpr size_t OFF_AF = OFF_QF + al256((size_t)NCHUNK_MAX * 2048 * 2);
constexpr size_t OFF_DF = OFF_AF + al256((size_t)NCHUNK_MAX * 256 * 4);
constexpr size_t OFF_KF = OFF_TW + al256((size_t)MTOK * 128 * 4);
constexpr size_t OFF_WF = OFF_KF + al256((size_t)NCHUNK_MAX * 2048 * 2);
constexpr size_t OFF_VF = OFF_WF + al256((size_t)NCHUNK_MAX * 2048 * 2);
constexpr size_t OFF_DEN = OFF_VF + al256((size_t)NCHUNK_MAX * 2048 * 4);
constexpr size_t OFF_MT = OFF_DEN + al256((size_t)MTOK * 8 * 4);
constexpr size_t OFF_BAR = OFF_MT + al256((size_t)MTOK * 8 * 4);
constexpr size_t OFF_XCH = OFF_BAR + al256((3456 + 2048 + 512) * 4);
constexpr size_t OFF_HQ = OFF_XCH + al256((size_t)4 * 128 * 4 * 144 * 8);
constexpr size_t WS_NEED = OFF_HQ + al256((size_t)MTOK * 1024);
static_assert(OFF_S2 + (size_t)128 * MTOK * 8 * 4 <= OFF_O, "alias overflow");
static_assert(OFF_DRY + (size_t)MTOK * 1024 * 6 <= OFF_O, "alias overflow");

constexpr size_t OUT_YP = 0;
constexpr size_t OUT_YS = OUT_YP + (size_t)8 * 2048 * 1024;
constexpr size_t OUT_P_HGRN = OUT_YS + (size_t)128 * 1024;
constexpr size_t OUT_P_GDN = OUT_P_HGRN + (size_t)8 * 8 * 128 * 128;
constexpr size_t OUT_P_CONV = OUT_P_GDN + (size_t)8 * 8 * 128 * 128;
constexpr size_t OUT_P_MC = OUT_P_CONV + (size_t)8 * 3 * 3072;
constexpr size_t OUT_P_MN = OUT_P_MC + (size_t)8 * 8 * 128 * 128;
constexpr size_t OUT_P_MM = OUT_P_MN + (size_t)8 * 8 * 128;
constexpr size_t OUT_P_GLA = OUT_P_MM + (size_t)8 * 8;
constexpr size_t OUT_S_HGRN = OUT_P_GLA + (size_t)8 * 4 * 128 * 256;
constexpr size_t OUT_S_GDN = OUT_S_HGRN + (size_t)128 * 8 * 128 * 128;
constexpr size_t OUT_S_CONV = OUT_S_GDN + (size_t)128 * 8 * 128 * 128;
constexpr size_t OUT_S_MC = OUT_S_CONV + (size_t)128 * 3 * 3072;
constexpr size_t OUT_S_MN = OUT_S_MC + (size_t)128 * 8 * 128 * 128;
constexpr size_t OUT_S_MM = OUT_S_MN + (size_t)128 * 8 * 128;
constexpr size_t OUT_S_GLA = OUT_S_MM + (size_t)128 * 8;
constexpr size_t OUT_TOTAL = OUT_S_GLA + (size_t)128 * 4 * 128 * 256;

struct Params {
    const float* in[37];
    float* out;
    unsigned char* ws;
};

typedef float f32x2 __attribute__((ext_vector_type(2)));
__device__ __forceinline__ unsigned cvt_pk_bf16(float lo, float hi) { const f32x2 v = {lo, hi}; return __builtin_bit_cast(unsigned, __builtin_convertvector(v, bf16x2)); }
__device__ __forceinline__ bf16_t f2bf(float f) { return (bf16_t)(cvt_pk_bf16(f, f) & 0xffffu); }
__device__ __forceinline__ float bf2f(bf16_t h) { return __uint_as_float(((unsigned)h) << 16); }
__device__ __forceinline__ unsigned pack2bf(float lo, float hi) { return cvt_pk_bf16(lo, hi); }
__device__ __forceinline__ float sigmoidf_(float x) { return __builtin_amdgcn_rcpf(1.0f + __expf(-x)); }
__device__ __forceinline__ float siluf_(float x) { return x * __builtin_amdgcn_rcpf(1.0f + __expf(-x)); }
__device__ __forceinline__ float softplusf_(float x) { return fmaxf(x, 0.f) + __logf(1.f + __expf(-fabsf(x))); }
__device__ __forceinline__ float logsigmoidf_(float x) { return -softplusf_(-x); }
__device__ __forceinline__ float wave_sum(float v) {
    v += __shfl_xor(v, 32); v += __shfl_xor(v, 16); v += __shfl_xor(v, 8); v += __shfl_xor(v, 4); v += __shfl_xor(v, 2); v += __shfl_xor(v, 1); return v;
}

__device__ __forceinline__ float dpp_max(float v, int ctrl_sel) {
    const int x = __builtin_bit_cast(int, v);
    int y;
    if (ctrl_sel == 0) y = __builtin_amdgcn_update_dpp(0, x, 0xB1, 0xF, 0xF, true);
    else if (ctrl_sel == 1) y = __builtin_amdgcn_update_dpp(0, x, 0x4E, 0xF, 0xF, true);
    else if (ctrl_sel == 2) y = __builtin_amdgcn_update_dpp(0, x, 0x141, 0xF, 0xF, true);
    else y = __builtin_amdgcn_update_dpp(0, x, 0x140, 0xF, 0xF, true);
    return fmaxf(v, __builtin_bit_cast(float, y));
}
__device__ __forceinline__ float wave_max_u(float v) {
    v = dpp_max(v, 0); v = dpp_max(v, 1); v = dpp_max(v, 2); v = dpp_max(v, 3);
    const int x = __builtin_bit_cast(int, v);
    const float a = __builtin_bit_cast(float, __builtin_amdgcn_readlane(x, 0)), b = __builtin_bit_cast(float, __builtin_amdgcn_readlane(x, 16));
    const float c = __builtin_bit_cast(float, __builtin_amdgcn_readlane(x, 32)), d = __builtin_bit_cast(float, __builtin_amdgcn_readlane(x, 48));
    return fmaxf(fmaxf(a, b), fmaxf(c, d));
}
__device__ __forceinline__ f32x2 ldbf2(const bf16_t* a) { const unsigned w = *(const unsigned*)a; return (f32x2){__uint_as_float(w << 16), __uint_as_float(w & 0xffff0000u)}; }
__device__ __forceinline__ f32x4 ldbf4(const bf16_t* a) { const u32x2 w = *(const u32x2*)a; return (f32x4){__uint_as_float(w.x << 16), __uint_as_float(w.x & 0xffff0000u), __uint_as_float(w.y << 16), __uint_as_float(w.y & 0xffff0000u)}; }
constexpr float XQ_SCALE = 8.0f / 127.0f;
__device__ __forceinline__ unsigned pack_i8x4(float a, float b, float c, float d) {
    const int ia = (int)rintf(fminf(fmaxf(a, -127.f), 127.f)), ib = (int)rintf(fminf(fmaxf(b, -127.f), 127.f));
    const int ic = (int)rintf(fminf(fmaxf(c, -127.f), 127.f)), id = (int)rintf(fminf(fmaxf(d, -127.f), 127.f));
    return (unsigned)(ia & 255) | ((unsigned)(ib & 255) << 8) | ((unsigned)(ic & 255) << 16) | ((unsigned)(id & 255) << 24);
}
__device__ __forceinline__ int opaque_tid() { int t = threadIdx.x; asm volatile("" : "+v"(t)); return t; }
__device__ __forceinline__ unsigned char* opaque_ptr(unsigned char* q) {
    unsigned lo = __builtin_amdgcn_readfirstlane((unsigned)(uintptr_t)q), hi = __builtin_amdgcn_readfirstlane((unsigned)((uintptr_t)q >> 32));
    asm volatile("" : "+s"(lo), "+s"(hi));
    typedef __attribute__((address_space(1))) unsigned char* gptr_t;
    return (unsigned char*)(gptr_t)(((uintptr_t)hi << 32) | (uintptr_t)lo);
}

__device__ __forceinline__ void transpose_convert(const float* __restrict__ W, int nraw, int npad, bf16_t* __restrict__ Wt, float* lds, int base) {
    const int TID = opaque_tid();
    const int tiles_n = npad / 64, tiles = tiles_n * 16, G = gridDim.x;
    const int tx = TID & 63, ty = TID >> 6;
    int tile = ((int)blockIdx.x - base % G + G) % G, buf = 0;
    float v[16];
    if (tile < tiles) {
        const int n = (tile % tiles_n) * 64 + tx, k0 = (tile / tiles_n) * 64;
#pragma unroll
        for (int i = 0; i < 16; ++i) v[i] = (n < nraw) ? W[(size_t)(k0 + ty + 4 * i) * nraw + n] : 0.f;
    }
    for (; tile < tiles; tile += G) {
        float* L = lds + buf * (64 * 65);
#pragma unroll
        for (int i = 0; i < 16; ++i) L[(ty + 4 * i) * 65 + tx] = v[i];
        __syncthreads();
        if (tile + G < tiles) {
            const int n = ((tile + G) % tiles_n) * 64 + tx, k0 = ((tile + G) / tiles_n) * 64;
#pragma unroll
            for (int i = 0; i < 16; ++i) v[i] = (n < nraw) ? W[(size_t)(k0 + ty + 4 * i) * nraw + n] : 0.f;
        }
        bf16_t* dst = Wt + (size_t)((tile % tiles_n) * 64) * 1024 + (tile / tiles_n) * 64;
#pragma unroll
        for (int i = 0; i < 16; ++i) { const int r = ty + 4 * i; dst[(size_t)r * 1024 + tx] = f2bf(L[tx * 65 + r]); }
        buf ^= 1;
    }
    __syncthreads();
}

__device__ __forceinline__ void convert_bf16(const float* __restrict__ src, bf16_t* __restrict__ dst, size_t n) {
    const int TID = opaque_tid();
    const size_t n8 = n / 8;
    for (size_t i = (size_t)blockIdx.x * NTH + TID; i < n8; i += (size_t)gridDim.x * NTH) {
        const f32x4 a = *(const f32x4*)(src + i * 8), b = *(const f32x4*)(src + i * 8 + 4);
        uint4 w; w.x = pack2bf(a[0], a[1]); w.y = pack2bf(a[2], a[3]); w.z = pack2bf(b[0], b[1]); w.w = pack2bf(b[2], b[3]);
        *(uint4*)(dst + i * 8) = w;
    }
}

template <bool AS_INT8>
__device__ __forceinline__ void convert_fp8_rows(const float* __restrict__ src, unsigned char* __restrict__ dst, float* __restrict__ scales, int row_lo, int row_hi, int wrank, int nwaves, int lane) {
    for (int row = row_lo + wrank; row < row_hi; row += 4 * nwaves) {
        f32x4 v[4][4];
#pragma unroll
        for (int u = 0; u < 4; ++u) {
            const int rr = (row + u * nwaves < row_hi) ? row + u * nwaves : row;
            const float* r = src + (size_t)rr * 1024 + lane * 16;
#pragma unroll
            for (int j = 0; j < 4; ++j) v[u][j] = *(const f32x4*)(r + j * 4);
        }
#pragma unroll
        for (int u = 0; u < 4; ++u) {
            const int rr = row + u * nwaves;
            float m = 0.f;
#pragma unroll
            for (int j = 0; j < 4; ++j) m = fmaxf(m, fmaxf(fmaxf(fabsf(v[u][j][0]), fabsf(v[u][j][1])), fmaxf(fabsf(v[u][j][2]), fabsf(v[u][j][3]))));
            m = wave_max_u(m);
            const float sc = (m > 0.f) ? m * (AS_INT8 ? (1.f / 127.f) : (1.f / 448.f)) : 1.f, inv = 1.f / sc;
            u32x4 w;
#pragma unroll
            for (int j = 0; j < 4; ++j) {
                if (AS_INT8) w[j] = pack_i8x4(v[u][j][0] * inv, v[u][j][1] * inv, v[u][j][2] * inv, v[u][j][3] * inv);
                else { int t = 0; t = __builtin_amdgcn_cvt_pk_fp8_f32(v[u][j][0] * inv, v[u][j][1] * inv, t, false); t = __builtin_amdgcn_cvt_pk_fp8_f32(v[u][j][2] * inv, v[u][j][3] * inv, t, true); w[j] = (unsigned)t; }
            }
            if (rr < row_hi) {
                *(u32x4*)(dst + ((size_t)((rr / NEXP) * 8 + (lane >> 3)) * NEXP + (rr % NEXP)) * 128 + (lane & 7) * 16) = w;
                if (lane == 0) scales[rr] = sc;
            }
        }
    }
}

__device__ __forceinline__ void phase_prologue(const Params& p, float* lds) {
    const int TID = opaque_tid();
    unsigned char* ws = opaque_ptr(p.ws);
    bf16_t* win = (bf16_t*)(ws + OFF_WIN);
    transpose_convert(p.in[10], 4096, 4096, win + (size_t)WIN_ROWS0 * 1024, lds, 0);
    transpose_convert(p.in[14], 4112, 4352, win + (size_t)WIN_ROWS1 * 1024, lds, 1024);
    transpose_convert(p.in[20], 4112, 4352, win + (size_t)WIN_ROWS2 * 1024, lds, 2112);
    transpose_convert(p.in[25], 3088, 3328, win + (size_t)WIN_ROWS3 * 1024, lds, 3200);
    bf16_t* wout = (bf16_t*)(ws + OFF_WOUT);
    transpose_convert(p.in[13], 1024, 1024, wout + (size_t)0 * 1024 * 1024, lds, 4032);
    transpose_convert(p.in[19], 1024, 1024, wout + (size_t)1 * 1024 * 1024, lds, 4288);
    transpose_convert(p.in[24], 1024, 1024, wout + (size_t)2 * 1024 * 1024, lds, 4544);
    transpose_convert(p.in[29], 1024, 1024, wout + (size_t)3 * 1024 * 1024, lds, 4800);
    bf16_t* wq = (bf16_t*)(ws + OFF_WQ);
    for (int l = 0; l < 4; ++l) transpose_convert(p.in[30] + (size_t)l * 1024 * 2048, 2048, 2048, wq + (size_t)l * 2048 * 1024, lds, 5056 + l * 512);
    bf16_t* keys = (bf16_t*)(ws + OFF_KEYS);
    for (int l = 0; l < 4; ++l) {
        convert_bf16(p.in[31] + (size_t)l * 16384, keys + (size_t)(l * 2 + 0) * 16384, 16384);
        convert_bf16(p.in[32] + (size_t)l * 16384, keys + (size_t)(l * 2 + 1) * 16384, 16384);
    }
    float* lb = (float*)(ws + OFF_LB);
    for (int c = blockIdx.x * NTH + TID; c < 1024; c += gridDim.x * NTH) {
        const float* L = p.in[11];
        float mx = L[c];
        for (int j = 1; j < 5; ++j) mx = fmaxf(mx, L[j * 1024 + c]);
        float s = 0.f;
        for (int j = 0; j < 5; ++j) s += expf(L[j * 1024 + c] - mx);
        lb[c] = expf(L[c] - mx) / s;
    }
    bf16_t* Hb = (bf16_t*)(ws + OFF_HB);
    const size_t nvec = (size_t)MTOK * 256;
    for (size_t i = (size_t)blockIdx.x * NTH + TID; i < nvec; i += (size_t)gridDim.x * NTH) {
        const int row = (int)(i >> 8), c4 = (int)(i & 255) * 4;
        const float* src;
        if (row < ROWS_P) { const int b = row / T_P, t = row % T_P; src = (t < 16) ? p.in[9] + (size_t)t * 1024 : p.in[0] + ((size_t)b * 2048 + (t - 16)) * 1024; }
        else src = p.in[1] + (size_t)(row - ROWS_P) * 1024;
        const f32x4 v = *(const f32x4*)(src + c4);
        uint2 w; w.x = pack2bf(v[0], v[1]); w.y = pack2bf(v[2], v[3]);
        *(uint2*)(Hb + (size_t)row * 1024 + c4) = w;
    }
}

#define GEMM_WAIT(n) asm volatile("s_waitcnt vmcnt(" #n ")" ::: "memory")
template <bool OUT_BF16, bool TILED = false, bool DUAL = false>
__device__ __forceinline__ void gemm_phase(const bf16_t* __restrict__ A, int lda, const bf16_t* __restrict__ Bt, int ldb, void* __restrict__ Cv0, int ldc,
                           int M, int N, int K, unsigned char* lds, size_t a2 = 0, size_t b2 = 0, size_t c2 = 0) {
    const int TID = opaque_tid();
    constexpr int BMA = 256, BNB = 128, BK = 32, STG = 24576;
    const int tid = TID, wid = tid >> 6, lane = tid & 63, wr = wid >> 1, wc = wid & 1, fr = lane & 15, fq = lane >> 4;
    const int tn = N / BNB, tiles = (M / BMA) * tn * (DUAL ? 2 : 1), nk = K / BK;
    const int sr = tid >> 2, scc = (((tid & 3) ^ ((0 - (tid >> 4)) & 3)) * 8);
    const int rsw = (0 - (fr >> 2)) & 3;
    const int aoff = (wr * 128 + fr) * 64 + ((fq ^ rsw) * 16), boff = 16384 + (wc * 64 + fr) * 64 + ((fq ^ rsw) * 16);
    for (int tile_ = blockIdx.x; tile_ < tiles; tile_ += gridDim.x) {
        const int half = DUAL ? (tile_ & 1) : 0, tile = DUAL ? (tile_ >> 1) : tile_;
        void* Cv = (unsigned char*)Cv0 + (size_t)half * c2;
        const int brow = (tile / tn) * BMA, bcol = (tile % tn) * BNB;
        f32x4 acc[8][4];
#pragma unroll
        for (int m = 0; m < 8; ++m)
#pragma unroll
            for (int n = 0; n < 4; ++n) acc[m][n] = (f32x4){0.f, 0.f, 0.f, 0.f};
        const bf16_t* ga = A + (size_t)half * a2 + (size_t)(brow + sr) * lda + scc;
        const bf16_t* gb = Bt + (size_t)half * b2 + (size_t)(bcol + sr) * ldb + scc;
#define GEMM_STAGE(kt_) do { unsigned char* sb_ = lds + ((kt_) % 3) * STG + tid * 16; \
            __builtin_amdgcn_global_load_lds((const unsigned*)(ga + (kt_) * BK), (LDSP unsigned*)(sb_), 16, 0, 0); \
            __builtin_amdgcn_global_load_lds((const unsigned*)(ga + (size_t)64 * lda + (kt_) * BK), (LDSP unsigned*)(sb_ + 4096), 16, 0, 0); \
            __builtin_amdgcn_global_load_lds((const unsigned*)(ga + (size_t)128 * lda + (kt_) * BK), (LDSP unsigned*)(sb_ + 8192), 16, 0, 0); \
            __builtin_amdgcn_global_load_lds((const unsigned*)(ga + (size_t)192 * lda + (kt_) * BK), (LDSP unsigned*)(sb_ + 12288), 16, 0, 0); \
            __builtin_amdgcn_global_load_lds((const unsigned*)(gb + (kt_) * BK), (LDSP unsigned*)(sb_ + 16384), 16, 0, 0); \
            __builtin_amdgcn_global_load_lds((const unsigned*)(gb + (size_t)64 * ldb + (kt_) * BK), (LDSP unsigned*)(sb_ + 20480), 16, 0, 0); } while (0)
        asm volatile("s_waitcnt lgkmcnt(0)" ::: "memory"); __builtin_amdgcn_s_barrier();
        GEMM_STAGE(0);
        if (nk > 1) GEMM_STAGE(1);
        for (int kt = 0; kt < nk; ++kt) {
            if (kt + 1 < nk) GEMM_WAIT(6); else GEMM_WAIT(0);
            asm volatile("s_waitcnt lgkmcnt(0)" ::: "memory"); __builtin_amdgcn_s_barrier();
            if (kt + 2 < nk) GEMM_STAGE(kt + 2);
            const unsigned char* st = lds + (kt % 3) * STG;
            bf16x8 At[8], Bl[4];
#pragma unroll
            for (int n = 0; n < 4; ++n) Bl[n] = *(const bf16x8*)(st + boff + n * 1024);
#pragma unroll
            for (int m = 0; m < 8; ++m) At[m] = *(const bf16x8*)(st + aoff + m * 1024);
#pragma unroll
            for (int m = 0; m < 8; ++m)
#pragma unroll
                for (int n = 0; n < 4; ++n) acc[m][n] = __builtin_amdgcn_mfma_f32_16x16x32_bf16(At[m], Bl[n], acc[m][n], 0, 0, 0);
        }
#undef GEMM_STAGE
#pragma unroll
        for (int n = 0; n < 4; ++n) {
            const size_t base = TILED ? (size_t)(brow + wr * 128) * N + (size_t)(bcol + wc * 64 + n * 16 + fr) * 128 + fq * 4
                                      : (size_t)(bcol + wc * 64 + n * 16 + fr) * ldc + brow + wr * 128 + fq * 4;
#pragma unroll
            for (int m = 0; m < 8; ++m) {
                if (OUT_BF16) { uint2 w; w.x = pack2bf(acc[m][n][0], acc[m][n][1]); w.y = pack2bf(acc[m][n][2], acc[m][n][3]); *(uint2*)((bf16_t*)Cv + base + m * 16) = w; }
                else *(f32x4*)((float*)Cv + base + m * 16) = acc[m][n];
            }
        }
    }
    asm volatile("s_waitcnt vmcnt(0) lgkmcnt(0)" ::: "memory");
    __syncthreads();
}

struct LnEpi { float* H; bf16_t* Hb; unsigned char* Hq; const float* g; const float* b; unsigned long long* xch; unsigned* cnt; };
template <bool OUT_BF16, bool EPI_LN = false>
__device__ __forceinline__ void gemm130_phase(const bf16_t* __restrict__ W, const bf16_t* __restrict__ X, void* __restrict__ Cv, int ldc, int NF, int K, unsigned char* lds, LnEpi le = LnEpi{}, int gap_at = 1 << 30) {
    const int TID = opaque_tid();
    constexpr int BK = 32, STG = 25600;
    const int tid = TID, wid = __builtin_amdgcn_readfirstlane(tid >> 6), lane = tid & 63, fr = lane & 15, fq = lane >> 4;
    const int tiles = (NF / 256) * 128, nk = K / BK;
    const int sr = tid >> 2, scc = (((tid & 3) ^ ((0 - (tid >> 4)) & 3)) * 8);
    const int rsw = (0 - (fr >> 2)) & 3;
    const int aoff = (wid * 64 + fr) * 64 + ((fq ^ rsw) * 16), boff = 16384 + fr * 64 + ((fq ^ rsw) * 16);
    for (int tile = blockIdx.x; tile < tiles; tile += gridDim.x) {
        const int brow0 = (tile >> 7) * 256, brow = brow0 + ((brow0 >= gap_at) ? 16 : 0), tok0 = (tile & 127) * 130;
        f32x4 acc[4][9];
#pragma unroll
        for (int m = 0; m < 4; ++m)
#pragma unroll
            for (int n = 0; n < 9; ++n) acc[m][n] = (f32x4){0.f, 0.f, 0.f, 0.f};
        const bf16_t* ga = W + (size_t)(brow + sr) * K + scc;
        const bf16_t* gb0 = X + (size_t)(tok0 + sr) * K + scc;
        const bf16_t* gb1 = X + (size_t)(tok0 + 64 + sr) * K + scc;
        const int r2 = 128 + sr; const bf16_t* gb2 = X + (size_t)(tok0 + (r2 < 130 ? r2 : 129)) * K + scc;
#define G130_STAGE(kt_) do { unsigned char* sb_ = lds + ((kt_) % 3) * STG + tid * 16; \
            __builtin_amdgcn_global_load_lds((const unsigned*)(ga + (kt_) * BK), (LDSP unsigned*)(sb_), 16, 0, 0); \
            __builtin_amdgcn_global_load_lds((const unsigned*)(ga + (size_t)64 * K + (kt_) * BK), (LDSP unsigned*)(sb_ + 4096), 16, 0, 0); \
            __builtin_amdgcn_global_load_lds((const unsigned*)(ga + (size_t)128 * K + (kt_) * BK), (LDSP unsigned*)(sb_ + 8192), 16, 0, 0); \
            __builtin_amdgcn_global_load_lds((const unsigned*)(ga + (size_t)192 * K + (kt_) * BK), (LDSP unsigned*)(sb_ + 12288), 16, 0, 0); \
            __builtin_amdgcn_global_load_lds((const unsigned*)(gb0 + (kt_) * BK), (LDSP unsigned*)(sb_ + 16384), 16, 0, 0); \
            __builtin_amdgcn_global_load_lds((const unsigned*)(gb1 + (kt_) * BK), (LDSP unsigned*)(sb_ + 20480), 16, 0, 0); \
            if (wid == 0) __builtin_amdgcn_global_load_lds((const unsigned*)(gb2 + (kt_) * BK), (LDSP unsigned*)(sb_ + 24576), 16, 0, 0); } while (0)
        asm volatile("s_waitcnt lgkmcnt(0)" ::: "memory"); __builtin_amdgcn_s_barrier();
        G130_STAGE(0);
        if (nk > 1) G130_STAGE(1);
#pragma unroll 1
        for (int kt = 0; kt < nk; ++kt) {
            if (kt + 1 < nk) { if (wid == 0) GEMM_WAIT(7); else GEMM_WAIT(6); } else GEMM_WAIT(0);
            asm volatile("s_waitcnt lgkmcnt(0)" ::: "memory"); __builtin_amdgcn_s_barrier();
            if (kt + 2 < nk) G130_STAGE(kt + 2);
            const unsigned char* st = lds + (kt % 3) * STG;
            bf16x8 At[4];
#pragma unroll
            for (int m = 0; m < 4; ++m) At[m] = *(const bf16x8*)(st + aoff + m * 1024);
            __builtin_amdgcn_s_setprio(1);
#pragma unroll
            for (int n = 0; n < 9; ++n) {
                const bf16x8 Bl = *(const bf16x8*)(st + boff + n * 1024);
#pragma unroll
                for (int m = 0; m < 4; ++m) acc[m][n] = __builtin_amdgcn_mfma_f32_16x16x32_bf16(At[m], Bl, acc[m][n], 0, 0, 0);
            }
            __builtin_amdgcn_s_setprio(0);
        }
#undef G130_STAGE
        if (EPI_LN) {
            const int tt = tile & 127, ft = tile >> 7;
            float* stat = (float*)lds;
            __syncthreads();
#pragma unroll
            for (int n = 0; n < 9; ++n) {
                const bool ok = (n < 8) || (fr < 2);
                const size_t base = (size_t)(tok0 + (ok ? n * 16 + fr : 0)) * 1024 + brow + wid * 64 + fq * 4;
                float a1 = 0.f, a2 = 0.f;
#pragma unroll
                for (int m = 0; m < 4; ++m) {
                    const u32x2 hw_ = *(const u32x2*)(le.Hb + base + m * 16);
                    const f32x4 hv = (f32x4){__uint_as_float(hw_.x << 16), __uint_as_float(hw_.x & 0xffff0000u), __uint_as_float(hw_.y << 16), __uint_as_float(hw_.y & 0xffff0000u)};
                    acc[m][n] = acc[m][n] + hv * DN_ALPHA;
                    a1 += (acc[m][n][0] + acc[m][n][1]) + (acc[m][n][2] + acc[m][n][3]);
                    a2 += (acc[m][n][0] * acc[m][n][0] + acc[m][n][1] * acc[m][n][1]) + (acc[m][n][2] * acc[m][n][2] + acc[m][n][3] * acc[m][n][3]);
                }
                a1 += __shfl_xor(a1, 16); a1 += __shfl_xor(a1, 32); a2 += __shfl_xor(a2, 16); a2 += __shfl_xor(a2, 32);
                if (fq == 0) { stat[(wid * 144 + n * 16 + fr) * 2] = a1; stat[(wid * 144 + n * 16 + fr) * 2 + 1] = a2; }
                asm volatile("" ::: "memory");
            }
            __syncthreads();
            unsigned long long* slot = le.xch + ((size_t)tt * 4) * 144;
            if (tid < 144) {
                const float p1 = (stat[tid * 2] + stat[(144 + tid) * 2]) + (stat[(288 + tid) * 2] + stat[(432 + tid) * 2]);
                const float p2 = (stat[tid * 2 + 1] + stat[(144 + tid) * 2 + 1]) + (stat[(288 + tid) * 2 + 1] + stat[(432 + tid) * 2 + 1]);
                __hip_atomic_store(slot + (size_t)ft * 144 + tid, ((unsigned long long)__float_as_uint(p2) << 32) | __float_as_uint(p1), __ATOMIC_RELAXED, __HIP_MEMORY_SCOPE_AGENT);
            }
            asm volatile("s_waitcnt vmcnt(0)" ::: "memory");
            __syncthreads();
            if (tid == 0) {
                __hip_atomic_fetch_add(le.cnt + tt, 1u, __ATOMIC_RELAXED, __HIP_MEMORY_SCOPE_AGENT);
                unsigned sp = 0;
                while (__hip_atomic_load(le.cnt + tt, __ATOMIC_RELAXED, __HIP_MEMORY_SCOPE_AGENT) < 4u) { __builtin_amdgcn_s_sleep(1); if (++sp > (1u << 22)) break; }
                __builtin_amdgcn_fence(__ATOMIC_ACQUIRE, "agent");
                asm volatile("s_waitcnt vmcnt(0)" ::: "memory");
            }
            __syncthreads();
            float* mr = stat + 1152;
            if (tid < 144) {
                float t1 = 0.f, t2 = 0.f;
#pragma unroll
                for (int f = 0; f < 4; ++f) { const unsigned long long w = __hip_atomic_load(slot + (size_t)f * 144 + tid, __ATOMIC_RELAXED, __HIP_MEMORY_SCOPE_AGENT); t1 += __uint_as_float((unsigned)w); t2 += __uint_as_float((unsigned)(w >> 32)); }
                const float mean = t1 * (1.f / 1024.f), var = t2 * (1.f / 1024.f) - mean * mean;
                mr[tid * 2] = mean; mr[tid * 2 + 1] = rsqrtf(fmaxf(var, 0.f) + 1e-5f);
            }
            __syncthreads();
#pragma unroll
            for (int n = 0; n < 9; ++n) {
                const bool ok = (n < 8) || (fr < 2);
                const size_t base = (size_t)(tok0 + (ok ? n * 16 + fr : 0)) * 1024 + brow + wid * 64 + fq * 4;
                const float mean = mr[(n * 16 + fr) * 2], rs = mr[(n * 16 + fr) * 2 + 1];
#pragma unroll
                for (int m = 0; m < 4; ++m) {
                    const f32x4 gvm = *(const f32x4*)(le.g + brow + wid * 64 + m * 16 + fq * 4), bvm = *(const f32x4*)(le.b + brow + wid * 64 + m * 16 + fq * 4);
                    const f32x4 o = (acc[m][n] - mean) * rs * gvm + bvm;
                    if (ok) { u32x2 w; w.x = cvt_pk_bf16(o[0], o[1]); w.y = cvt_pk_bf16(o[2], o[3]); *(u32x2*)(le.Hb + base + m * 16) = w;
                              *(unsigned*)(le.Hq + base + m * 16) = pack_i8x4(o[0] * (1.f / XQ_SCALE), o[1] * (1.f / XQ_SCALE), o[2] * (1.f / XQ_SCALE), o[3] * (1.f / XQ_SCALE)); }
                }
                asm volatile("" ::: "memory");
            }
        } else
#pragma unroll
        for (int n = 0; n < 9; ++n) {
            const bool ok = (n < 8) || (fr < 2);
            const size_t base = (size_t)(tok0 + (ok ? n * 16 + fr : 0)) * ldc + brow + wid * 64 + fq * 4;
#pragma unroll
            for (int m = 0; m < 4; ++m) {
                const f32x4 v = acc[m][n];
                if (OUT_BF16) { u32x2 w; w.x = cvt_pk_bf16(v[0], v[1]); w.y = cvt_pk_bf16(v[2], v[3]); if (ok) *(u32x2*)((bf16_t*)Cv + base + m * 16) = w; }
                else { if (ok) *(f32x4*)((float*)Cv + base + m * 16) = v; }
            }
            asm volatile("" ::: "memory");
        }
    }
    asm volatile("s_waitcnt vmcnt(0) lgkmcnt(0)" ::: "memory");
    __syncthreads();
}

__device__ __forceinline__ void skinny16_phase(const bf16_t* __restrict__ W16, const bf16_t* __restrict__ X, float* __restrict__ C, int ldc) {
    const int TID = opaque_tid();
    const int wave = TID >> 6, lane = TID & 63, q = lane >> 4, c = lane & 15;
    for (int t = blockIdx.x + wave * gridDim.x; t < MTOK / 16; t += gridDim.x * 4) {
        const bf16_t* wa = W16 + (size_t)c * 1024 + q * 8;
        const bf16_t* xb = X + (size_t)(t * 16 + c) * 1024 + q * 8;
        f32x4 acc0 = (f32x4){0.f, 0.f, 0.f, 0.f}, acc1 = (f32x4){0.f, 0.f, 0.f, 0.f};
#pragma unroll 1
        for (int k0 = 0; k0 < 1024; k0 += 512) {
            bf16x8 a[16], b[16];
#pragma unroll
            for (int j = 0; j < 16; ++j) { a[j] = *(const bf16x8*)(wa + k0 + j * 32); b[j] = *(const bf16x8*)(xb + k0 + j * 32); }
#pragma unroll
            for (int j = 0; j < 16; j += 2) {
                acc0 = __builtin_amdgcn_mfma_f32_16x16x32_bf16(a[j], b[j], acc0, 0, 0, 0);
                acc1 = __builtin_amdgcn_mfma_f32_16x16x32_bf16(a[j + 1], b[j + 1], acc1, 0, 0, 0);
            }
        }
        *(f32x4*)(C + (size_t)(t * 16 + c) * ldc + 4 * q) = acc0 + acc1;
    }
}

constexpr int NCH = 129;
constexpr int QS = 132;
__device__ __forceinline__ f32x4 mfma16(bf16x4 a, bf16x4 b, f32x4 c, int, int, int) {
    const bf16x8 a8 = {a[0], a[1], a[2], a[3], 0, 0, 0, 0}, b8 = {b[0], b[1], b[2], b[3], 0, 0, 0, 0};
    return __builtin_amdgcn_mfma_f32_16x16x32_bf16(a8, b8, c, 0, 0, 0);
}
__device__ __forceinline__ int qf_index(int t, int k) { const int m = k >> 5, kk = k & 31, half = kk >> 4, rem = kk & 15, q = rem >> 2, j = (rem & 3) + 4 * half; return (m * 64 + q * 16 + t) * 8 + j; }
__device__ __forceinline__ int kf_index(int t, int k) { return (((t >> 2) * 16 + (k & 15)) * 8 + (k >> 4)) * 4 + (t & 3); }
__device__ __forceinline__ int af_index(int t, int s_) { return ((s_ >> 2) * 16 + t) * 4 + (s_ & 3); }
__device__ __forceinline__ int vf_index(int t, int v) { return ((v >> 4) * 64 + (t >> 2) * 16 + (v & 15)) * 4 + (t & 3); }

template <int MIX>
__device__ __forceinline__ void stage_qk(const Params& p, const float* __restrict__ P, const float* __restrict__ lbv, float* qs, float* ks, float* fs, float* sc,
                                         int tid, int h, int row0, int t0, int nt, bool has_init, int sseq) {
    const int tt = tid >> 4, d0 = (tid & 15) * 8;
    if (tt < nt) {
        const int t = t0 + tt; const float* Pr = P + (size_t)(row0 + t) * PLD;
        if (MIX == 0) {
#pragma unroll
            for (int j = 0; j < 8; ++j) {
                const int d = d0 + j, cc = h * 128 + d;
                const float qr = Pr[cc], fr_ = Pr[1024 + cc], lb = lbv[cc];
                const float fg = lb + (1.f - lb) * sigmoidf_(fr_);
                qs[tt * QS + d] = siluf_(qr); ks[tt * QS + d] = 1.f - fg; fs[tt * QS + d] = logf(fg);
            }
        } else if (MIX == 1) {
            const float* cw = p.in[15]; const float* cbuf = p.in[4];
            float sq = 0.f, sk = 0.f;
#pragma unroll 1
            for (int j = 0; j < 8; ++j) {
                const int cq = h * 128 + d0 + j, ck = 1024 + cq;
                float yq = 0.f, yk = 0.f;
#pragma unroll
                for (int w = 0; w < 4; ++w) {
                    const int tp = t - 3 + w; float xq, xk;
                    if (tp >= 0) { xq = P[(size_t)(row0 + tp) * PLD + cq]; xk = P[(size_t)(row0 + tp) * PLD + ck]; }
                    else if (has_init) { xq = cbuf[((size_t)sseq * 3 + (3 + tp)) * 3072 + cq]; xk = cbuf[((size_t)sseq * 3 + (3 + tp)) * 3072 + ck]; }
                    else { xq = 0.f; xk = 0.f; }
                    yq += cw[w * 3072 + cq] * xq; yk += cw[w * 3072 + ck] * xk;
                }
                const float qv = siluf_(yq), kv = siluf_(yk);
                sq += qv * qv; sk += kv * kv;
                qs[tt * QS + d0 + j] = qv; ks[tt * QS + d0 + j] = kv;
            }
            sq += __shfl_xor(sq, 1); sq += __shfl_xor(sq, 2); sq += __shfl_xor(sq, 4); sq += __shfl_xor(sq, 8);
            sk += __shfl_xor(sk, 1); sk += __shfl_xor(sk, 2); sk += __shfl_xor(sk, 4); sk += __shfl_xor(sk, 8);
            const float rq = rsqrtf(sq + 1e-6f) * 0.08838834764831845f, rk = rsqrtf(sk + 1e-6f);
#pragma unroll 1
            for (int j = 0; j < 8; ++j) { qs[tt * QS + d0 + j] *= rq; ks[tt * QS + d0 + j] *= rk; }
            if ((tid & 15) == 0) {
                const float ar = Pr[3072 + h], br = Pr[3080 + h];
                sc[tt * 2] = -expf(p.in[16][h]) * softplusf_(ar + p.in[17][h]);
                sc[tt * 2 + 1] = sigmoidf_(br);
            }
        } else if (MIX == 2) {
#pragma unroll
            for (int j = 0; j < 8; ++j) {
                const int d = d0 + j, cc = h * 128 + d;
                qs[tt * QS + d] = Pr[cc]; ks[tt * QS + d] = Pr[1024 + cc] * 0.08838834764831845f;
            }
            if ((tid & 15) == 0) {
                sc[tt * 2] = Pr[3072 + h] + p.in[21][h];
                sc[tt * 2 + 1] = logsigmoidf_(Pr[3080 + h] + p.in[22][h]);
            }
        } else {
            const float* wg = p.in[26]; const float* bg = p.in[27];
            float rr[16];
#pragma unroll
            for (int j = 0; j < 16; ++j) rr[j] = Pr[3072 + j];
#pragma unroll
            for (int j = 0; j < 8; ++j) {
                const int d = d0 + j, cc = h * 128 + d;
                float pre = bg[cc];
#pragma unroll
                for (int q = 0; q < 16; ++q) pre += rr[q] * wg[q * 512 + cc];
                qs[tt * QS + d] = Pr[cc] * 0.08838834764831845f; ks[tt * QS + d] = Pr[512 + cc];
                fs[tt * QS + d] = logsigmoidf_(pre) * 0.0625f;
            }
        }
    }
}

template <int MIX>
__device__ __forceinline__ float load_v(const Params& p, const float* __restrict__ P, int row0, int t, int cv, bool has_init, int sseq) {
    if (MIX == 1) {
        const float* cw = p.in[15]; const float* cbuf = p.in[4];
        float y = 0.f;
#pragma unroll
        for (int w = 0; w < 4; ++w) {
            const int tp = t - 3 + w; float x;
            if (tp >= 0) x = P[(size_t)(row0 + tp) * PLD + cv];
            else if (has_init) x = cbuf[((size_t)sseq * 3 + (3 + tp)) * 3072 + cv];
            else x = 0.f;
            y += cw[w * 3072 + cv] * x;
        }
        return siluf_(y);
    }
    return P[(size_t)(row0 + t) * PLD + cv];
}

template <int MIX>
__device__ __forceinline__ void scan_sample_item(const Params& p, float* lds, int tid, int item) {
    unsigned char* ws = opaque_ptr(p.ws);
    const float* P = (const float*)(ws + OFF_P);
    float* O = (float*)(ws + OFF_O);
    const float* lbv = (const float*)(ws + OFF_LB);
    float* qs = lds; float* ks = lds + 16 * QS; float* fs = lds + 32 * QS; float* vs = lds + 48 * QS; float* sc = lds + 64 * QS;
    const int wave = tid >> 6, lane = tid & 63, g = lane >> 4, c = lane & 15;
    constexpr int DV = (MIX == 3) ? 256 : 128;
    constexpr int NH = (MIX == 3) ? 4 : 8;
    constexpr int VG = DV / 64;
    constexpr int VBASE = (MIX == 3) ? 1024 : 2048;
    const int sseq = item >> 4, sub = item & 15, h = sub / VG, vg = sub % VG;
    const int row0 = ROWS_P + sseq;
    const int vcol = vg * 64 + wave * 16 + c;
    float s[32];
    const float* init_S = (MIX == 0) ? p.in[2] : (MIX == 1) ? p.in[3] : (MIX == 2) ? p.in[5] : p.in[8];
    float* out_S = p.out + ((MIX == 0) ? OUT_S_HGRN : (MIX == 1) ? OUT_S_GDN : (MIX == 2) ? OUT_S_MC : OUT_S_GLA);
    const size_t st_off = ((size_t)sseq * NH + h) * 128 * DV;
#pragma unroll
    for (int i = 0; i < 32; ++i) s[i] = init_S[st_off + (size_t)(g * 32 + i) * DV + vcol];
    float nn0 = 0.f, nn1 = 0.f, mrun = 0.f;
    if (MIX == 2) {
        nn0 = p.in[6][((size_t)sseq * 8 + h) * 128 + 2 * lane]; nn1 = p.in[6][((size_t)sseq * 8 + h) * 128 + 2 * lane + 1];
        mrun = p.in[7][(size_t)sseq * 8 + h];
    }
    __syncthreads();
    stage_qk<MIX>(p, P, lbv, qs, ks, fs, sc, tid, h, row0, 0, 1, true, sseq);
    if (tid < 64) vs[tid] = load_v<MIX>(p, P, row0, 0, VBASE + h * DV + vg * 64 + tid, true, sseq);
    __syncthreads();
    {
        const float vv = vs[wave * 16 + c];
        const f32x4* q4 = (const f32x4*)(qs + g * 32);
        const f32x4* k4 = (const f32x4*)(ks + g * 32);
        const f32x4* f4 = (const f32x4*)(fs + g * 32);
        float o = 0.f;
        if (MIX == 0 || MIX == 3) {
#pragma unroll
            for (int i4 = 0; i4 < 8; ++i4) {
                const f32x4 qq = q4[i4], kk = k4[i4], ff = f4[i4];
#pragma unroll
                for (int j = 0; j < 4; ++j) { const int i = i4 * 4 + j; s[i] = expf(ff[j]) * s[i] + kk[j] * vv; o += qq[j] * s[i]; }
            }
            o += __shfl_xor(o, 16); o += __shfl_xor(o, 32);
        } else if (MIX == 1) {
            const float a = expf(sc[0]), beta = sc[1];
            float r = 0.f;
#pragma unroll
            for (int i4 = 0; i4 < 8; ++i4) {
                const f32x4 kk = k4[i4];
#pragma unroll
                for (int j = 0; j < 4; ++j) { const int i = i4 * 4 + j; s[i] *= a; r += kk[j] * s[i]; }
            }
            r += __shfl_xor(r, 16); r += __shfl_xor(r, 32);
            const float vn = beta * (vv - r);
#pragma unroll
            for (int i4 = 0; i4 < 8; ++i4) {
                const f32x4 qq = q4[i4], kk = k4[i4];
#pragma unroll
                for (int j = 0; j < 4; ++j) { const int i = i4 * 4 + j; s[i] += kk[j] * vn; o += qq[j] * s[i]; }
            }
            o += __shfl_xor(o, 16); o += __shfl_xor(o, 32);
        } else {
            const float li = sc[0], lf = sc[1];
            const float mn = fmaxf(lf + mrun, li);
            const float a = expf(lf + mrun - mn), w = expf(li - mn);
            mrun = mn;
            const float wv = w * vv;
#pragma unroll
            for (int i4 = 0; i4 < 8; ++i4) {
                const f32x4 qq = q4[i4], kk = k4[i4];
#pragma unroll
                for (int j = 0; j < 4; ++j) { const int i = i4 * 4 + j; s[i] = a * s[i] + kk[j] * wv; o += qq[j] * s[i]; }
            }
            o += __shfl_xor(o, 16); o += __shfl_xor(o, 32);
            const float k0 = ks[2 * lane], k1 = ks[2 * lane + 1];
            const float q0 = qs[2 * lane], q1 = qs[2 * lane + 1];
            nn0 = a * nn0 + w * k0; nn1 = a * nn1 + w * k1;
            const float den = wave_sum(q0 * nn0 + q1 * nn1);
            o = o / fmaxf(fabsf(den), expf(-mn));
        }
        if (g == 0) O[(size_t)row0 * 1024 + sub * 64 + wave * 16 + c] = o;
    }
#pragma unroll
    for (int i = 0; i < 32; ++i) out_S[st_off + (size_t)(g * 32 + i) * DV + vcol] = s[i];
    if (MIX == 2 && vg == 0 && wave == 0) {
        float* on = p.out + OUT_S_MN + ((size_t)sseq * 8 + h) * 128;
        on[2 * lane] = nn0; on[2 * lane + 1] = nn1;
        if (lane == 0) {
            p.out[OUT_S_MM + (size_t)sseq * 8 + h] = mrun;
            ((float*)(ws + OFF_DEN))[(size_t)row0 * 8 + h] = 1.f;
            ((float*)(ws + OFF_MT))[(size_t)row0 * 8 + h] = 100.f;
        }
    }
}

template <int MIX>
__device__ __forceinline__ void prepass_chunk(const Params& p, float* lds, int tid, int item) {
    unsigned char* ws = opaque_ptr(p.ws);
    const float* P = (const float*)(ws + OFF_P);
    const float* lbv = (const float*)(ws + OFF_LB);
    float* qs = lds; float* ks = lds + 16 * QS; float* fs = lds + 32 * QS; float* vs = lds + 48 * QS; float* sc = lds + 64 * QS;
    float* nm = sc + 32;
    constexpr int DV = (MIX == 3) ? 256 : 128;
    constexpr int NH = (MIX == 3) ? 4 : 8;
    constexpr int VBASE = (MIX == 3) ? 1024 : 2048;
    const int ci = item, ch = item % NCH, bh = item / NCH, h = bh % NH, b = bh / NH;
    const int row0 = b * T_P, t0 = ch * 16;
    bf16_t* QF = (bf16_t*)(ws + OFF_QF) + (size_t)ci * 2048;
    bf16_t* KF = (bf16_t*)(ws + OFF_KF) + (size_t)ci * 2048;
    bf16_t* WF = (bf16_t*)(ws + OFF_WF) + (size_t)ci * 2048;
    float* DF = (float*)(ws + OFF_DF) + (size_t)ci * 128;
    __syncthreads();
    stage_qk<MIX>(p, P, lbv, qs, ks, fs, sc, tid, h, row0, t0, 16, false, 0);
    if (MIX == 1) {
        for (int e = tid; e < 16 * 128; e += NTH) { const int tt = e >> 7, col = e & 127; vs[tt * QS + col] = load_v<1>(p, P, row0, t0 + tt, VBASE + h * 128 + col, false, 0); }
    }
    __syncthreads();
    if (MIX == 0 || MIX == 3) {
        if (tid < 128) { float bb = 0.f;
#pragma unroll
            for (int t = 0; t < 16; ++t) { bb += fs[t * QS + tid]; fs[t * QS + tid] = bb; } }
        __syncthreads();
        for (int e = tid; e < 512; e += NTH) {
            const int t = e >> 5, k0 = (e & 31) * 4;
            float qv[4];
#pragma unroll
            for (int j = 0; j < 4; ++j) { const float bb = fs[t * QS + k0 + j]; qv[j] = qs[t * QS + k0 + j] * expf(bb); }
            u32x2 w; w.x = cvt_pk_bf16(qv[0], qv[1]); w.y = cvt_pk_bf16(qv[2], qv[3]);
            *(u32x2*)(QF + qf_index(t, k0)) = w;
#pragma unroll
            for (int j = 0; j < 4; ++j) qs[t * QS + k0 + j] = qv[j];
        }
        for (int e = tid; e < 512; e += NTH) {
            const int k = e & 127, tq = e >> 7;
            const float be = fs[15 * QS + k];
            float kv[4];
#pragma unroll
            for (int j = 0; j < 4; ++j) { const int t = tq * 4 + j; kv[j] = ks[t * QS + k] * expf(be - fs[t * QS + k]); }
            u32x2 w; w.x = cvt_pk_bf16(kv[0], kv[1]); w.y = cvt_pk_bf16(kv[2], kv[3]);
            *(u32x2*)(KF + kf_index(tq * 4, k)) = w;
        }
        if (tid < 128) { const int k = tid; DF[((k >> 2) & 3) * 32 + (k >> 4) * 4 + (k & 3)] = expf(fs[15 * QS + k]); }
        __syncthreads();
        for (int e = tid; e < 2048; e += NTH) { const int t = e >> 7, k = e & 127; ks[t * QS + k] *= expf(-fs[t * QS + k]); }
        __syncthreads();
        {
            const int t = tid >> 4, s_ = tid & 15;
            const f32x4* a4 = (const f32x4*)(qs + t * QS); const f32x4* b4 = (const f32x4*)(ks + s_ * QS);
            float acc = 0.f;
#pragma unroll 8
            for (int i = 0; i < 32; ++i) { const f32x4 x = a4[i], y = b4[i]; acc += x[0] * y[0] + x[1] * y[1] + x[2] * y[2] + x[3] * y[3]; }
            ((bf16_t*)(ws + OFF_AF))[(size_t)ci * 512 + af_index(t, s_)] = f2bf(s_ <= t ? acc : 0.f);
        }
    } else if (MIX == 1) {
        float bc[16];
        { float bb = 0.f;
#pragma unroll
          for (int t = 0; t < 16; ++t) { bb += sc[t * 2]; bc[t] = bb; } }
        {
            const int t = tid >> 4, s_ = tid & 15;
            const f32x4* a4 = (const f32x4*)(ks + t * QS); const f32x4* q4 = (const f32x4*)(qs + t * QS); const f32x4* b4 = (const f32x4*)(ks + s_ * QS);
            float kk = 0.f, qk = 0.f;
#pragma unroll 8
            for (int i = 0; i < 32; ++i) { const f32x4 x = a4[i], z = q4[i], y = b4[i]; kk += x[0] * y[0] + x[1] * y[1] + x[2] * y[2] + x[3] * y[3]; qk += z[0] * y[0] + z[1] * y[1] + z[2] * y[2] + z[3] * y[3]; }
            float bt = 0.f, bs_ = 0.f;
#pragma unroll
            for (int i = 0; i < 16; ++i) { bt = (i == t) ? bc[i] : bt; bs_ = (i == s_) ? bc[i] : bs_; }
            const float e = (s_ <= t) ? expf(bt - bs_) : 0.f;
            nm[t * 17 + s_] = (s_ < t) ? sc[t * 2 + 1] * kk * e : 0.f;
            ((bf16_t*)(ws + OFF_AF))[(size_t)ci * 512 + af_index(t, s_)] = f2bf(qk * e);
        }
        for (int e = tid; e < 512; e += NTH) {
            const int t = e >> 5, k0 = (e & 31) * 4;
            float bt = 0.f;
#pragma unroll
            for (int i = 0; i < 16; ++i) bt = (i == t) ? bc[i] : bt;
            const float eb = expf(bt);
            u32x2 w; w.x = cvt_pk_bf16(qs[t * QS + k0] * eb, qs[t * QS + k0 + 1] * eb); w.y = cvt_pk_bf16(qs[t * QS + k0 + 2] * eb, qs[t * QS + k0 + 3] * eb);
            *(u32x2*)(QF + qf_index(t, k0)) = w;
        }
        for (int e = tid; e < 512; e += NTH) {
            const int k = e & 127, tq = e >> 7;
            float kv[4];
#pragma unroll
            for (int j = 0; j < 4; ++j) { float bt = 0.f;
#pragma unroll
                for (int i = 0; i < 16; ++i) bt = (i == tq * 4 + j) ? bc[i] : bt;
                kv[j] = ks[(tq * 4 + j) * QS + k] * expf(bc[15] - bt); }
            u32x2 w; w.x = cvt_pk_bf16(kv[0], kv[1]); w.y = cvt_pk_bf16(kv[2], kv[3]);
            *(u32x2*)(KF + kf_index(tq * 4, k)) = w;
        }
        if (tid == 0) DF[0] = expf(bc[15]);
        __syncthreads();
        {
            float x[16];
            const bool isv = tid < 128; const int col = tid & 127;
#pragma unroll
            for (int t = 0; t < 16; ++t) { const float beta = sc[t * 2 + 1]; x[t] = isv ? beta * vs[t * QS + col] : beta * expf(bc[t]) * ks[t * QS + col]; }
#pragma unroll
            for (int t = 1; t < 16; ++t)
#pragma unroll
                for (int s_ = 0; s_ < t; ++s_) x[t] -= nm[t * 17 + s_] * x[s_];
            if (isv) {
                float* UF = (float*)(ws + OFF_VF) + (size_t)ci * 2048;
#pragma unroll
                for (int tq = 0; tq < 4; ++tq) *(f32x4*)(UF + vf_index(tq * 4, col)) = (f32x4){x[tq * 4], x[tq * 4 + 1], x[tq * 4 + 2], x[tq * 4 + 3]};
            } else {
#pragma unroll
                for (int t = 0; t < 16; ++t) WF[qf_index(t, col)] = f2bf(x[t]);
            }
        }
    } else {
        float cc[16], gg[16], bc[16];
        { float bb = 0.f, gm = -INFINITY;
#pragma unroll
          for (int t = 0; t < 16; ++t) { bb += sc[t * 2 + 1]; bc[t] = bb; cc[t] = sc[t * 2] - bb; gm = fmaxf(gm, cc[t]); gg[t] = gm; } }
        {
            const int t = tid >> 4, s_ = tid & 15;
            const f32x4* a4 = (const f32x4*)(qs + t * QS); const f32x4* b4 = (const f32x4*)(ks + s_ * QS);
            float acc = 0.f;
#pragma unroll 8
            for (int i = 0; i < 32; ++i) { const f32x4 x = a4[i], y = b4[i]; acc += x[0] * y[0] + x[1] * y[1] + x[2] * y[2] + x[3] * y[3]; }
            ((float*)(ws + OFF_AF))[(size_t)ci * 256 + af_index(t, s_)] = (s_ <= t) ? acc : 0.f;
        }
        for (int e = tid; e < 512; e += NTH) {
            const int t = e >> 5, k0 = (e & 31) * 4;
            u32x2 w; w.x = cvt_pk_bf16(qs[t * QS + k0], qs[t * QS + k0 + 1]); w.y = cvt_pk_bf16(qs[t * QS + k0 + 2], qs[t * QS + k0 + 3]);
            *(u32x2*)(QF + qf_index(t, k0)) = w;
        }
        for (int e = tid; e < 512; e += NTH) {
            const int k = e & 127, tq = e >> 7;
            float kv[4];
#pragma unroll
            for (int j = 0; j < 4; ++j) { float ct = 0.f;
#pragma unroll
                for (int i = 0; i < 16; ++i) ct = (i == tq * 4 + j) ? cc[i] : ct;
                kv[j] = ks[(tq * 4 + j) * QS + k] * expf(ct - gg[15]); }
            u32x2 w; w.x = cvt_pk_bf16(kv[0], kv[1]); w.y = cvt_pk_bf16(kv[2], kv[3]);
            *(u32x2*)(KF + kf_index(tq * 4, k)) = w;
        }
        if (tid < 16) {
            float cv = 0.f, gv = 0.f, bv = 0.f;
#pragma unroll
            for (int i = 0; i < 16; ++i) { cv = (i == tid) ? cc[i] : cv; gv = (i == tid) ? gg[i] : gv; bv = (i == tid) ? bc[i] : bv; }
            DF[tid] = cv; DF[16 + tid] = gv; DF[32 + tid] = bv;
        }
    }
    if (MIX != 1) {
        bf16_t* VF = (bf16_t*)(ws + OFF_VF) + (size_t)ci * (16 * DV);
        for (int e = tid; e < DV * 4; e += NTH) {
            const int v = e % DV, tq = e / DV;
            float x[4];
#pragma unroll
            for (int j = 0; j < 4; ++j) x[j] = P[(size_t)(row0 + t0 + tq * 4 + j) * PLD + VBASE + h * DV + v];
            u32x2 w; w.x = cvt_pk_bf16(x[0], x[1]); w.y = cvt_pk_bf16(x[2], x[3]);
            *(u32x2*)(VF + vf_index(tq * 4, v)) = w;
        }
    }
}

constexpr int PW_IMG = 272;
constexpr int PW_BYTES = 14336;
#define PW_FENCE() asm volatile("s_waitcnt lgkmcnt(0)" ::: "memory")
__device__ __forceinline__ float exp_fast(float x) { return __expf(x); }
__device__ __forceinline__ f32x4 img_mfma(const unsigned char* X, const unsigned char* Y, int lane) {
    f32x4 d = (f32x4){0.f, 0.f, 0.f, 0.f};
    const int r = lane & 15, q = lane >> 4;
#pragma unroll
    for (int m = 0; m < 4; ++m) {
        const bf16x8 a = *(const bf16x8*)(X + r * PW_IMG + m * 64 + q * 16), b = *(const bf16x8*)(Y + r * PW_IMG + m * 64 + q * 16);
        d = __builtin_amdgcn_mfma_f32_16x16x32_bf16(a, b, d, 0, 0, 0);
    }
    return d;
}
__device__ __forceinline__ void emit_qf(const unsigned char* img, bf16_t* rec, int lane, float rowscale, bool scaled) {
    const int t = lane & 15, q = lane >> 4;
#pragma unroll
    for (int m = 0; m < 4; ++m) {
        u32x2 lo = *(const u32x2*)(img + t * PW_IMG + (32 * m + 4 * q) * 2), hi = *(const u32x2*)(img + t * PW_IMG + (32 * m + 16 + 4 * q) * 2);
        if (scaled) {
            lo.x = cvt_pk_bf16(__uint_as_float(lo.x << 16) * rowscale, __uint_as_float(lo.x & 0xffff0000u) * rowscale); lo.y = cvt_pk_bf16(__uint_as_float(lo.y << 16) * rowscale, __uint_as_float(lo.y & 0xffff0000u) * rowscale);
            hi.x = cvt_pk_bf16(__uint_as_float(hi.x << 16) * rowscale, __uint_as_float(hi.x & 0xffff0000u) * rowscale); hi.y = cvt_pk_bf16(__uint_as_float(hi.y << 16) * rowscale, __uint_as_float(hi.y & 0xffff0000u) * rowscale);
        }
        *(u32x4*)(rec + (m * 64 + lane) * 8) = (u32x4){lo.x, lo.y, hi.x, hi.y};
    }
}
__device__ __forceinline__ void emit_kf(const unsigned char* kt_img, bf16_t* rec, int lane) {
    const int i = lane & 15, q = lane >> 4;
#pragma unroll
    for (int g = 0; g < 4; ++g) {
        const u32x2 a = *(const u32x2*)(kt_img + (16 * (2 * g) + i) * 32 + q * 8), b = *(const u32x2*)(kt_img + (16 * (2 * g + 1) + i) * 32 + q * 8);
        *(u32x4*)(rec + lane * 32 + g * 8) = (u32x4){a.x, a.y, b.x, b.y};
    }
}
__device__ __forceinline__ void store_kt(unsigned char* kt_img, int lane, const float (&v0)[16], const float (&v1)[16]) {
#pragma unroll
    for (int hh = 0; hh < 2; ++hh) {
        u32x4 w0, w1;
#pragma unroll
        for (int j = 0; j < 4; ++j) { w0[j] = cvt_pk_bf16(v0[hh * 8 + 2 * j], v0[hh * 8 + 2 * j + 1]); w1[j] = cvt_pk_bf16(v1[hh * 8 + 2 * j], v1[hh * 8 + 2 * j + 1]); }
        *(u32x4*)(kt_img + (2 * lane) * 32 + hh * 16) = w0; *(u32x4*)(kt_img + (2 * lane + 1) * 32 + hh * 16) = w1;
    }
}
__device__ __forceinline__ void wave_sum16(float (&v)[16], int lane) {
    float a[8], b[4], c[2], d;
#pragma unroll
    for (int i = 0; i < 8; ++i) { const bool up = lane >= 32; const float snd = up ? v[i] : v[i + 8], keep = up ? v[i + 8] : v[i]; a[i] = keep + __shfl_xor(snd, 32); }
#pragma unroll
    for (int i = 0; i < 4; ++i) { const bool up = (lane & 16) != 0; const float snd = up ? a[i] : a[i + 4], keep = up ? a[i + 4] : a[i]; b[i] = keep + __shfl_xor(snd, 16); }
#pragma unroll
    for (int i = 0; i < 2; ++i) { const bool up = (lane & 8) != 0; const float snd = up ? b[i] : b[i + 2], keep = up ? b[i + 2] : b[i]; c[i] = keep + __shfl_xor(snd, 8); }
    { const bool up = (lane & 4) != 0; const float snd = up ? c[0] : c[1], keep = up ? c[1] : c[0]; d = keep + __shfl_xor(snd, 4); }
    d += __shfl_xor(d, 2); d += __shfl_xor(d, 1);
#pragma unroll
    for (int i = 0; i < 16; ++i) {
        const int src = ((i >> 3) & 1) * 32 + ((i >> 2) & 1) * 16 + ((i >> 1) & 1) * 8 + (i & 1) * 4;
        v[i] = __builtin_bit_cast(float, __builtin_amdgcn_readlane(__builtin_bit_cast(int, d), src));
    }
}

template <int MIX, int VARIANT = 0>
__device__ __forceinline__ void prepass_wave(const Params& p, unsigned char* wl, int lane, int item) {
    unsigned char* ws = opaque_ptr(p.ws);
    const bf16_t* P = (const bf16_t*)(ws + OFF_P);
    constexpr int DV = (MIX == 3) ? 256 : 128;
    constexpr int NH = (MIX == 3) ? 4 : 8;
    constexpr int VBASE = (MIX == 3) ? 1024 : 2048;
    const int ci = item, ch = item % NCH, bh = item / NCH, h = bh % NH, b = bh / NH;
    const int row0 = b * T_P, t0 = ch * 16;
    const int q = lane >> 4, c = lane & 15, kc = h * 128 + 2 * lane;
    bf16_t* QF = (bf16_t*)(ws + OFF_QF) + (size_t)ci * 2048;
    bf16_t* KF = (bf16_t*)(ws + OFF_KF) + (size_t)ci * 2048;
    float* DF = (float*)(ws + OFF_DF) + (size_t)ci * 128;
    unsigned char* imgA = wl; unsigned char* imgB = wl + 16 * PW_IMG; unsigned char* ktI = wl + 32 * PW_IMG; float* nm = (float*)(wl + 32 * PW_IMG + 4096);
    const bf16_t* Prow = P + (size_t)(row0 + t0) * PLD;
    const float* PGrow = (const float*)(ws + OFF_PG) + (size_t)(row0 + t0) * 16;
    unsigned x[DV / 16][4];
    if (MIX != 1) {
#pragma unroll
        for (int vt = 0; vt < DV / 16; ++vt)
#pragma unroll
            for (int j = 0; j < 4; ++j) x[vt][j] = Prow[(size_t)(4 * q + j) * PLD + VBASE + h * DV + vt * 16 + c];
    }
    auto vf_store = [&]() {
        if (MIX != 1) {
            bf16_t* VF = (bf16_t*)(ws + OFF_VF) + (size_t)ci * (16 * DV);
#pragma unroll
            for (int vt = 0; vt < DV / 16; ++vt) {
                u32x2 w; w.x = x[vt][0] | (x[vt][1] << 16); w.y = x[vt][2] | (x[vt][3] << 16);
                *(u32x2*)(VF + (vt * 64 + lane) * 4) = w;
            }
        }
    };
    if (MIX == 0 || MIX == 3) {
        float qv0[16], qv1[16], kv0[16], kv1[16], b0[16], b1[16];
        if (MIX == 0) {
            const float* lbv = (const float*)(ws + OFF_LB);
            const f32x2 lb = *(const f32x2*)(lbv + kc);
#pragma unroll
            for (int t = 0; t < 16; ++t) {
                const f32x2 qr = ldbf2(Prow + (size_t)t * PLD + kc), fr_ = ldbf2(Prow + (size_t)t * PLD + 1024 + kc);
                const float fg0 = lb[0] + (1.f - lb[0]) * sigmoidf_(fr_[0]), fg1 = lb[1] + (1.f - lb[1]) * sigmoidf_(fr_[1]);
                qv0[t] = siluf_(qr[0]); qv1[t] = siluf_(qr[1]); kv0[t] = 1.f - fg0; kv1[t] = 1.f - fg1; b0[t] = __logf(fg0); b1[t] = __logf(fg1);
            }
        } else {
            const float* wg = p.in[26]; const float* bg = p.in[27];
            f32x2 wgt[16];
#pragma unroll
            for (int j = 0; j < 16; ++j) wgt[j] = *(const f32x2*)(wg + j * 512 + kc);
            const f32x2 bgv = *(const f32x2*)(bg + kc);
#pragma unroll
            for (int t = 0; t < 16; ++t) {
                const bf16_t* Pr = Prow + (size_t)t * PLD;
                const f32x2 qr = ldbf2(Pr + kc), kr = ldbf2(Pr + 512 + kc);
                float p0 = bgv[0], p1 = bgv[1];
#pragma unroll
                for (int j4 = 0; j4 < 4; ++j4) { const f32x4 rr = *(const f32x4*)(PGrow + t * 16 + j4 * 4);
#pragma unroll
                    for (int j = 0; j < 4; ++j) { p0 += rr[j] * wgt[j4 * 4 + j][0]; p1 += rr[j] * wgt[j4 * 4 + j][1]; } }
                qv0[t] = qr[0] * 0.08838834764831845f; qv1[t] = qr[1] * 0.08838834764831845f; kv0[t] = kr[0]; kv1[t] = kr[1];
                b0[t] = logsigmoidf_(p0) * 0.0625f; b1[t] = logsigmoidf_(p1) * 0.0625f;
            }
        }
        vf_store();
#pragma unroll
        for (int t = 1; t < 16; ++t) { b0[t] += b0[t - 1]; b1[t] += b1[t - 1]; }
        float kh0[16], kh1[16];
#pragma unroll
        for (int t = 0; t < 16; ++t) {
            const float e0 = exp_fast(b0[t]), e1 = exp_fast(b1[t]);
            *(unsigned*)(imgA + t * PW_IMG + 4 * lane) = cvt_pk_bf16(qv0[t] * e0, qv1[t] * e1);
            *(unsigned*)(imgB + t * PW_IMG + 4 * lane) = cvt_pk_bf16(kv0[t] * exp_fast(-b0[t]), kv1[t] * exp_fast(-b1[t]));
            kh0[t] = kv0[t] * exp_fast(b0[15] - b0[t]); kh1[t] = kv1[t] * exp_fast(b1[15] - b1[t]);
        }
        store_kt(ktI, lane, kh0, kh1);
        { const int k = 2 * lane; *(f32x2*)(DF + ((k >> 2) & 3) * 32 + (k >> 4) * 4 + (k & 3)) = (f32x2){exp_fast(b0[15]), exp_fast(b1[15])}; }
        PW_FENCE();
        f32x4 d = img_mfma(imgB, imgA, lane);
        u32x2 aw; aw.x = cvt_pk_bf16((4 * q + 0 <= c) ? d[0] : 0.f, (4 * q + 1 <= c) ? d[1] : 0.f); aw.y = cvt_pk_bf16((4 * q + 2 <= c) ? d[2] : 0.f, (4 * q + 3 <= c) ? d[3] : 0.f);
        *(u32x2*)((bf16_t*)(ws + OFF_AF) + (size_t)ci * 512 + lane * 4) = aw;
        emit_qf(imgA, QF, lane, 1.f, false);
        emit_kf(ktI, KF, lane);
    } else if (MIX == 2) {
        float qv0[16], qv1[16], kv0[16], kv1[16];
#pragma unroll
        for (int t = 0; t < 16; ++t) {
            const f32x2 qr = ldbf2(Prow + (size_t)t * PLD + kc), kr = ldbf2(Prow + (size_t)t * PLD + 1024 + kc);
            qv0[t] = qr[0]; qv1[t] = qr[1]; kv0[t] = kr[0] * 0.08838834764831845f; kv1[t] = kr[1] * 0.08838834764831845f;
        }
        float cc[16], gg[16], bc[16];
        { float bb = 0.f, gm = -INFINITY; const float bi = p.in[21][h], bf_ = p.in[22][h];
#pragma unroll
          for (int t = 0; t < 16; ++t) { const float li = PGrow[t * 16 + h] + bi, lf = logsigmoidf_(PGrow[t * 16 + 8 + h] + bf_);
              bb += lf; bc[t] = bb; cc[t] = li - bb; gm = fmaxf(gm, cc[t]); gg[t] = gm; } }
        vf_store();
        float kh0[16], kh1[16];
#pragma unroll
        for (int t = 0; t < 16; ++t) {
            *(unsigned*)(imgA + t * PW_IMG + 4 * lane) = cvt_pk_bf16(qv0[t], qv1[t]);
            *(unsigned*)(imgB + t * PW_IMG + 4 * lane) = cvt_pk_bf16(kv0[t], kv1[t]);
            const float e = exp_fast(cc[t] - gg[15]); kh0[t] = kv0[t] * e; kh1[t] = kv1[t] * e;
        }
        store_kt(ktI, lane, kh0, kh1);
        if (lane < 16) {
            float cv = 0.f, gv = 0.f, bv = 0.f;
#pragma unroll
            for (int i = 0; i < 16; ++i) { cv = (i == lane) ? cc[i] : cv; gv = (i == lane) ? gg[i] : gv; bv = (i == lane) ? bc[i] : bv; }
            DF[lane] = cv; DF[16 + lane] = gv; DF[32 + lane] = bv;
        }
        PW_FENCE();
        f32x4 d = img_mfma(imgB, imgA, lane);
#pragma unroll
        for (int r = 0; r < 4; ++r) d[r] = (4 * q + r <= c) ? d[r] : 0.f;
        *(f32x4*)((float*)(ws + OFF_AF) + (size_t)ci * 256 + lane * 4) = d;
        emit_qf(imgA, QF, lane, 1.f, false);
        emit_kf(ktI, KF, lane);
    } else {
        const float* cw = p.in[15];
        bf16_t* WF = (bf16_t*)(ws + OFF_WF) + (size_t)ci * 2048;
        float qv0[16], qv1[16], kv0[16], kv1[16], vv0[16], vv1[16];
        unsigned rq_[19], rk_[19], rv_[19];
#pragma unroll
        for (int i = 0; i < 19; ++i) {
            const int t = t0 - 3 + i; const bf16_t* pr_ = P + (size_t)(row0 + (t >= 0 ? t : 0)) * PLD + kc;
            rq_[i] = (t >= 0) ? *(const unsigned*)(pr_) : 0u; rk_[i] = (t >= 0) ? *(const unsigned*)(pr_ + 1024) : 0u; rv_[i] = (t >= 0) ? *(const unsigned*)(pr_ + 2048) : 0u;
        }
#define PW_CONV(col_, raw_, o0, o1) do { const int cc_ = (col_); f32x2 w_[4]; \
            _Pragma("unroll") for (int w = 0; w < 4; ++w) w_[w] = *(const f32x2*)(cw + w * 3072 + cc_); \
            _Pragma("unroll") for (int t = 0; t < 16; ++t) { f32x2 y_ = {0.f, 0.f}; \
                _Pragma("unroll") for (int w = 0; w < 4; ++w) y_ += w_[w] * (f32x2){__uint_as_float(raw_[t + w] << 16), __uint_as_float(raw_[t + w] & 0xffff0000u)}; \
                o0[t] = siluf_(y_[0]); o1[t] = siluf_(y_[1]); } \
            } while (0)
        PW_CONV(kc, rq_, qv0, qv1);
        PW_CONV(1024 + kc, rk_, kv0, kv1);
        PW_CONV(2048 + kc, rv_, vv0, vv1);
#undef PW_CONV
        float sq[16], sk[16];
#pragma unroll
        for (int t = 0; t < 16; ++t) { sq[t] = qv0[t] * qv0[t] + qv1[t] * qv1[t]; sk[t] = kv0[t] * kv0[t] + kv1[t] * kv1[t]; }
        wave_sum16(sq, lane); wave_sum16(sk, lane);
        float bc[16], beta[16];
        { float bb = 0.f; const float ea = expf(p.in[16][h]), dtb = p.in[17][h];
#pragma unroll
          for (int t = 0; t < 16; ++t) { bb += -ea * softplusf_(PGrow[t * 16 + h] + dtb); bc[t] = bb; beta[t] = sigmoidf_(PGrow[t * 16 + 8 + h]); } }
#pragma unroll
        for (int t = 0; t < 16; ++t) {
            const float rq_ = rsqrtf(sq[t] + 1e-6f) * 0.08838834764831845f, rk_ = rsqrtf(sk[t] + 1e-6f);
            kv0[t] *= rk_; kv1[t] *= rk_;
            *(unsigned*)(imgA + t * PW_IMG + 4 * lane) = cvt_pk_bf16(qv0[t] * rq_, qv1[t] * rq_);
            *(unsigned*)(imgB + t * PW_IMG + 4 * lane) = cvt_pk_bf16(kv0[t], kv1[t]);
        }
#pragma unroll
        for (int hh = 0; hh < 2; ++hh) {
            u32x4 w0, w1;
#pragma unroll
            for (int j = 0; j < 4; ++j) {
                const int ta = hh * 8 + 2 * j; const float ea = exp_fast(bc[15] - bc[ta]), eb = exp_fast(bc[15] - bc[ta + 1]);
                w0[j] = cvt_pk_bf16(kv0[ta] * ea, kv0[ta + 1] * eb); w1[j] = cvt_pk_bf16(kv1[ta] * ea, kv1[ta + 1] * eb);
            }
            *(u32x4*)(ktI + (2 * lane) * 32 + hh * 16) = w0; *(u32x4*)(ktI + (2 * lane + 1) * 32 + hh * 16) = w1;
        }
        if (lane == 0) DF[0] = exp_fast(bc[15]);
        PW_FENCE();
        const unsigned char* imgB2 = imgB; asm volatile("" : "+v"(imgB2));
        const f32x4 dkk = img_mfma(imgB, imgB2, lane);
        const f32x4 dqk = img_mfma(imgB, imgA, lane);
        float bcol = 0.f, betac = 0.f;
#pragma unroll
        for (int i = 0; i < 16; ++i) { bcol = (i == c) ? bc[i] : bcol; betac = (i == c) ? beta[i] : betac; }
        u32x2 aw; float av[4];
#pragma unroll
        for (int r = 0; r < 4; ++r) {
            const int s_ = 4 * q + r; float bs_ = 0.f;
#pragma unroll
            for (int i = 0; i < 16; ++i) bs_ = (i == s_) ? bc[i] : bs_;
            const float e = (s_ <= c) ? exp_fast(bcol - bs_) : 0.f;
            nm[c * 17 + s_] = (s_ < c) ? betac * dkk[r] * e : 0.f;
            av[r] = dqk[r] * e;
        }
        aw.x = cvt_pk_bf16(av[0], av[1]); aw.y = cvt_pk_bf16(av[2], av[3]);
        *(u32x2*)((bf16_t*)(ws + OFF_AF) + (size_t)ci * 512 + lane * 4) = aw;
        { float bt = 0.f;
#pragma unroll
          for (int i = 0; i < 16; ++i) bt = (i == c) ? bc[i] : bt;
          emit_qf(imgA, QF, lane, exp_fast(bt), true); }
        emit_kf(ktI, KF, lane);
        PW_FENCE();
#pragma unroll
        for (int t = 0; t < 16; ++t) { const float bb = beta[t], be = bb * exp_fast(bc[t]); vv0[t] *= bb; vv1[t] *= bb; kv0[t] *= be; kv1[t] *= be; }
#pragma unroll
        for (int t = 1; t < 16; ++t)
#pragma unroll
            for (int s_ = 0; s_ < t; ++s_) { const float n_ = nm[t * 17 + s_]; vv0[t] -= n_ * vv0[s_]; vv1[t] -= n_ * vv1[s_]; kv0[t] -= n_ * kv0[s_]; kv1[t] -= n_ * kv1[s_]; }
        {
            bf16_t* UF = (bf16_t*)(ws + OFF_VF) + (size_t)ci * 2048;
#pragma unroll
            for (int tq = 0; tq < 4; ++tq) {
                u32x2 a_, b_;
                a_.x = cvt_pk_bf16(vv0[tq * 4], vv0[tq * 4 + 1]); a_.y = cvt_pk_bf16(vv0[tq * 4 + 2], vv0[tq * 4 + 3]);
                b_.x = cvt_pk_bf16(vv1[tq * 4], vv1[tq * 4 + 1]); b_.y = cvt_pk_bf16(vv1[tq * 4 + 2], vv1[tq * 4 + 3]);
                *(u32x2*)(UF + vf_index(tq * 4, 2 * lane)) = a_;
                *(u32x2*)(UF + vf_index(tq * 4, 2 * lane + 1)) = b_;
            }
        }
        PW_FENCE();
#pragma unroll
        for (int t = 0; t < 16; ++t) *(unsigned*)(imgA + t * PW_IMG + 4 * lane) = cvt_pk_bf16(kv0[t], kv1[t]);
        PW_FENCE();
        emit_qf(imgA, WF, lane, 1.f, false);
    }
    PW_FENCE();
}

template <int MIX>
__device__ __forceinline__ void scanA_phase(const Params& p, float* lds) {
    const int TID = opaque_tid();
    constexpr int NH = (MIX == 3) ? 4 : 8;
    const int nchunk = NB_P * NH * NCH;
    const int wave = TID >> 6, lane = TID & 63;
    if (OLD_PREPASS_MASK & (1 << MIX)) { for (int item = blockIdx.x; item < nchunk; item += gridDim.x) prepass_chunk<MIX>(p, lds, TID, item); }
    else { for (int item = blockIdx.x * 4 + wave; item < nchunk; item += gridDim.x * 4) prepass_wave<MIX>(p, (unsigned char*)lds + wave * PW_BYTES, lane, item); }
#if SAMPLE_IN_SEQ
    return;
#endif
    const int NW = (int)gridDim.x * 4, wr = ((int)gridDim.x - 1 - (int)blockIdx.x) * 4 + (3 - wave);
    if (NB_S * 32 == 2 * NW && nchunk % NW != 0 && 4 * (nchunk % NW) <= NW) {
        const int extra = nchunk % NW;
        const int nmine = (wr >= NW - extra) ? 0 : (wr < 2 * extra) ? 3 : 2;
#pragma unroll 1
        for (int k = 0; k < nmine; ++k) {
            const int it = (k < 2) ? wr + k * NW : ((wr < extra) ? NW - extra + wr : 2 * NW - extra + (wr - extra));
            sample_wave<MIX>(p, (unsigned char*)lds + wave * PW_BYTES, lane, it);
        }
    } else
    for (int it = wr; it < NB_S * 32; it += NW) sample_wave<MIX>(p, (unsigned char*)lds + wave * PW_BYTES, lane, it);
}

template <int MIX>
__device__ __forceinline__ void sample_wave(const Params& p, unsigned char* wl, int lane, int item) {
    unsigned char* ws = opaque_ptr(p.ws);
    const bf16_t* P = (const bf16_t*)(ws + OFF_P);
    float* O = (float*)(ws + OFF_O);
    constexpr int DV = (MIX == 3) ? 256 : 128;
    constexpr int NH = (MIX == 3) ? 4 : 8;
    constexpr int VBASE = (MIX == 3) ? 1024 : 2048;
    const int sseq = item >> 5, tile = item & 31, col0 = tile * 32;
    const int h = col0 / DV, vc0 = col0 % DV;
    const int row = ROWS_P + sseq;
    const int g = lane >> 5, c = lane & 31, kc = h * 128 + 2 * lane;
    const bf16_t* Pr = P + (size_t)row * PLD;
    const float* PGr = (const float*)(ws + OFF_PG) + (size_t)row * 16;
    float* qL = (float*)wl; float* kL = qL + 128; float* fL = kL + 128;
    float sc0 = 0.f, sc1 = 0.f;
    float q0, q1, k0, k1, f0 = 0.f, f1 = 0.f, vv;
    if (MIX == 0) {
        const float* lbv = (const float*)(ws + OFF_LB);
        const f32x2 qr = ldbf2(Pr + kc), fr_ = ldbf2(Pr + 1024 + kc), lb = *(const f32x2*)(lbv + kc);
        const float fg0 = lb[0] + (1.f - lb[0]) * sigmoidf_(fr_[0]), fg1 = lb[1] + (1.f - lb[1]) * sigmoidf_(fr_[1]);
        q0 = siluf_(qr[0]); q1 = siluf_(qr[1]); k0 = 1.f - fg0; k1 = 1.f - fg1; f0 = fg0; f1 = fg1;
        vv = bf2f(Pr[VBASE + col0 + c]);
    } else if (MIX == 3) {
        const float* wg = p.in[26]; const float* bg = p.in[27];
        const f32x2 qr = ldbf2(Pr + kc), kr = ldbf2(Pr + 512 + kc), bgv = *(const f32x2*)(bg + kc);
        float p0 = bgv[0], p1 = bgv[1];
#pragma unroll
        for (int j = 0; j < 16; ++j) { const float rr = PGr[j]; const f32x2 w = *(const f32x2*)(wg + j * 512 + kc); p0 += rr * w[0]; p1 += rr * w[1]; }
        q0 = qr[0] * 0.08838834764831845f; q1 = qr[1] * 0.08838834764831845f; k0 = kr[0]; k1 = kr[1];
        f0 = expf(logsigmoidf_(p0) * 0.0625f); f1 = expf(logsigmoidf_(p1) * 0.0625f);
        vv = bf2f(Pr[VBASE + col0 + c]);
    } else if (MIX == 2) {
        const f32x2 qr = ldbf2(Pr + kc), kr = ldbf2(Pr + 1024 + kc);
        q0 = qr[0]; q1 = qr[1]; k0 = kr[0] * 0.08838834764831845f; k1 = kr[1] * 0.08838834764831845f;
        sc0 = PGr[h] + p.in[21][h]; sc1 = logsigmoidf_(PGr[8 + h] + p.in[22][h]);
        vv = bf2f(Pr[VBASE + col0 + c]);
    } else {
        const float* cw = p.in[15]; const float* cbuf = p.in[4] + (size_t)sseq * 3 * 3072;
        f32x2 yq = {0.f, 0.f}, yk = {0.f, 0.f}; float yv = 0.f;
        const int cv = VBASE + col0 + c;
#pragma unroll
        for (int w = 0; w < 4; ++w) {
            const float* src = cbuf + (w < 3 ? w : 0) * 3072;
            yq += *(const f32x2*)(cw + w * 3072 + kc) * ((w < 3) ? *(const f32x2*)(src + kc) : ldbf2(Pr + kc));
            yk += *(const f32x2*)(cw + w * 3072 + 1024 + kc) * ((w < 3) ? *(const f32x2*)(src + 1024 + kc) : ldbf2(Pr + 1024 + kc));
            yv += cw[w * 3072 + cv] * ((w < 3) ? src[cv] : bf2f(Pr[cv]));
        }
        q0 = siluf_(yq[0]); q1 = siluf_(yq[1]); k0 = siluf_(yk[0]); k1 = siluf_(yk[1]); vv = siluf_(yv);
        const float rq = rsqrtf(wave_sum(q0 * q0 + q1 * q1) + 1e-6f) * 0.08838834764831845f, rk = rsqrtf(wave_sum(k0 * k0 + k1 * k1) + 1e-6f);
        q0 *= rq; q1 *= rq; k0 *= rk; k1 *= rk;
        sc0 = expf(-expf(p.in[16][h]) * softplusf_(PGr[h] + p.in[17][h])); sc1 = sigmoidf_(PGr[8 + h]);
    }
    *(f32x2*)(qL + 2 * lane) = (f32x2){q0, q1}; *(f32x2*)(kL + 2 * lane) = (f32x2){k0, k1};
    if (MIX == 0 || MIX == 3) *(f32x2*)(fL + 2 * lane) = (f32x2){f0, f1};
    const float* init_S = (MIX == 0) ? p.in[2] : (MIX == 1) ? p.in[3] : (MIX == 2) ? p.in[5] : p.in[8];
    float* out_S = p.out + ((MIX == 0) ? OUT_S_HGRN : (MIX == 1) ? OUT_S_GDN : (MIX == 2) ? OUT_S_MC : OUT_S_GLA);
    const size_t st_off = ((size_t)sseq * NH + h) * 128 * DV + (size_t)(64 * g) * DV + vc0 + c;
    float s[64];
#pragma unroll
    for (int i = 0; i < 64; ++i) s[i] = init_S[st_off + (size_t)i * DV];
    float nn0 = 0.f, nn1 = 0.f, mrun = 0.f;
    if (MIX == 2) { nn0 = p.in[6][((size_t)sseq * 8 + h) * 128 + 2 * lane]; nn1 = p.in[6][((size_t)sseq * 8 + h) * 128 + 2 * lane + 1]; mrun = p.in[7][(size_t)sseq * 8 + h]; }
    PW_FENCE();
    const f32x4* q4 = (const f32x4*)(qL + 64 * g); const f32x4* k4 = (const f32x4*)(kL + 64 * g); const f32x4* f4 = (const f32x4*)(fL + 64 * g);
    float o = 0.f;
    if (MIX == 0 || MIX == 3) {
#pragma unroll
        for (int i4 = 0; i4 < 16; ++i4) { const f32x4 qq = q4[i4], kk = k4[i4], ff = f4[i4];
#pragma unroll
            for (int j = 0; j < 4; ++j) { const int i = i4 * 4 + j; s[i] = ff[j] * s[i] + kk[j] * vv; o += qq[j] * s[i]; } }
        o += __shfl_xor(o, 32);
    } else if (MIX == 1) {
        float r = 0.f;
#pragma unroll
        for (int i4 = 0; i4 < 16; ++i4) { const f32x4 kk = k4[i4];
#pragma unroll
            for (int j = 0; j < 4; ++j) { const int i = i4 * 4 + j; s[i] *= sc0; r += kk[j] * s[i]; } }
        r += __shfl_xor(r, 32);
        const float vn = sc1 * (vv - r);
#pragma unroll
        for (int i4 = 0; i4 < 16; ++i4) { const f32x4 qq = q4[i4], kk = k4[i4];
#pragma unroll
            for (int j = 0; j < 4; ++j) { const int i = i4 * 4 + j; s[i] += kk[j] * vn; o += qq[j] * s[i]; } }
        o += __shfl_xor(o, 32);
    } else {
        const float mn = fmaxf(sc1 + mrun, sc0);
        const float a = expf(sc1 + mrun - mn), w = expf(sc0 - mn);
        mrun = mn;
        const float wv = w * vv;
#pragma unroll
        for (int i4 = 0; i4 < 16; ++i4) { const f32x4 qq = q4[i4], kk = k4[i4];
#pragma unroll
            for (int j = 0; j < 4; ++j) { const int i = i4 * 4 + j; s[i] = a * s[i] + kk[j] * wv; o += qq[j] * s[i]; } }
        o += __shfl_xor(o, 32);
        nn0 = a * nn0 + w * k0; nn1 = a * nn1 + w * k1;
        const float den = wave_sum(q0 * nn0 + q1 * nn1);
        o = o / fmaxf(fabsf(den), expf(-mn));
    }
    if (g == 0) ((bf16_t*)O)[(size_t)row * 1024 + col0 + c] = f2bf(o);
#pragma unroll
    for (int i = 0; i < 64; ++i) out_S[st_off + (size_t)i * DV] = s[i];
    if (MIX == 2 && vc0 == 0) {
        float* on = p.out + OUT_S_MN + ((size_t)sseq * 8 + h) * 128;
        *(f32x2*)(on + 2 * lane) = (f32x2){nn0, nn1};
        if (lane == 0) {
            p.out[OUT_S_MM + (size_t)sseq * 8 + h] = mrun;
            ((float*)(ws + OFF_DEN))[(size_t)row * 8 + h] = 1.f;
            ((float*)(ws + OFF_MT))[(size_t)row * 8 + h] = 100.f;
        }
    }
    PW_FENCE();
}

#define RING_BYTES_OF(M_) (((M_) == 2) ? 3 * 11264 : ((M_) == 1) ? 4 * 15360 : 5 * 11264)
template <int MIX, bool LITE = false>
__device__ __forceinline__ void seq_phase(const Params& p, unsigned char* lds, bool do_seq = true, bool do_sample = true) {
    const int TID = opaque_tid();
    unsigned char* ws = opaque_ptr(p.ws);
    constexpr int DV = (MIX == 3) ? 256 : 128;
    constexpr int NH = (MIX == 3) ? 4 : 8;
    constexpr int NVT = DV / 16;
    constexpr int NT = NVT + ((MIX == 2) ? 1 : 0);
    const int wave = TID >> 6, lane = TID & 63, q = lane >> 4, c = lane & 15;
    float* O = (float*)(ws + OFF_O);
    const int nitems = NB_P * NH * NT;
    if (wave >= 2 && !LITE) {
        const int layer_ = (MIX == 0) ? 0 : (MIX == 1) ? 1 : (MIX == 2) ? 2 : 3;
        const int wr_ = blockIdx.x * 2 + (wave - 2), nw_ = gridDim.x * 2;
        convert_fp8_rows<true>(p.in[33], ws + OFF_UB, (float*)(ws + OFF_SU), layer_ * NEXP, (layer_ + 1) * NEXP, wr_, nw_, lane);
        convert_fp8_rows<false>(p.in[34], ws + OFF_VB, (float*)(ws + OFF_SV), layer_ * NEXP, (layer_ + 1) * NEXP, wr_, nw_, lane);
#if SAMPLE_IN_SEQ
        for (int it = wr_; it < NB_S * 32; it += nw_) sample_wave<MIX>(p, lds + LDS_BYTES - 4096 + (wave - 2) * 2048, lane, it);
#endif
    }
    constexpr int NSW = (MIX == 2) ? 2 : 1;
    for (int lap = wave; do_seq && wave < NSW && lap * (int)gridDim.x + (int)blockIdx.x < 8 * NT * ((NB_P * NH + 7) / 8); lap += NSW) {
        const int slot = lap * (int)gridDim.x + (int)blockIdx.x;
        const int bh = ((slot >> 3) / NT) * 8 + (slot & 7), vt = (slot >> 3) % NT, b = bh / NH, h = bh % NH;
        if (bh >= NB_P * NH) continue;
        const bool ntile = (MIX == 2) && (vt == NVT);
        const int row0 = b * T_P;
        f32x4 S[8];
#pragma unroll
        for (int kt = 0; kt < 8; ++kt) S[kt] = (f32x4){0.f, 0.f, 0.f, 0.f};
        float mprev = 0.f;
        const size_t ci0 = (size_t)bh * NCH;
        bf16x8 qf[4], wf[4]; u32x4 kf[4]; u32x2 afb; f32x4 aff; u32x2 vfb; f32x4 uf; f32x4 df[8]; float dsc = 1.f;
        f32x4 c4, g4, b4; float grow = 0.f, g15 = 0.f, b15 = 0.f;
        bf16x8 nqf[4], nwf[4]; u32x4 nkf[4]; u32x2 nafb; f32x4 naff; u32x2 nvfb; f32x4 nuf; f32x4 ndf[8]; float ndsc = 1.f;
        f32x4 nc4, ng4, nb4; float ngrow = 0.f, ng15 = 0.f, nb15 = 0.f;
        constexpr int RING = (MIX == 2) ? 3 : (MIX == 1) ? 4 : 5;
        constexpr int NDMA = (MIX == 1) ? 15 : 11;
        constexpr int AOFF = (MIX == 1) ? 12288 : 8192, VOFF = AOFF + 1024, DOFF = AOFF + 2048, SLOT = AOFF + 3072;
        constexpr int OG = (MIX == 2) ? 4 : 8;
        constexpr int WAVE_LDS = RING_BYTES_OF(MIX) + OG * 1024;
        static_assert(((MIX == 2) ? 2 : 1) * WAVE_LDS <= LDS_BYTES - 4096, "chunk-walk rings overlap the sample-step scratch");
        unsigned char* ring = lds + ((MIX == 2) ? wave * WAVE_LDS : 0);
        float* ostage = (float*)(ring + RING_BYTES_OF(MIX));
        const int vsel = ntile ? 0 : vt;
#define SEQ_DMA(cc_) do { const size_t ci = ci0 + (cc_); unsigned char* sl_ = ring + ((cc_) % RING) * SLOT; \
        { const unsigned char* g_ = ws + OFF_QF + ci * 4096 + lane * 16; _Pragma("unroll") for (int m = 0; m < 4; ++m) __builtin_amdgcn_global_load_lds((const unsigned*)(g_ + m * 1024), (LDSP unsigned*)(sl_ + m * 1024), 16, 0, 0); } \
        { const unsigned char* g_ = ws + OFF_KF + ci * 4096 + lane * 16; _Pragma("unroll") for (int m = 0; m < 4; ++m) __builtin_amdgcn_global_load_lds((const unsigned*)(g_ + m * 1024), (LDSP unsigned*)(sl_ + 4096 + m * 1024), 16, 0, 0); } \
        if (MIX == 1) { const unsigned char* g_ = ws + OFF_WF + ci * 4096 + lane * 16; _Pragma("unroll") for (int m = 0; m < 4; ++m) __builtin_amdgcn_global_load_lds((const unsigned*)(g_ + m * 1024), (LDSP unsigned*)(sl_ + 8192 + m * 1024), 16, 0, 0); } \
        __builtin_amdgcn_global_load_lds((const unsigned*)(ws + OFF_AF + ci * 1024 + lane * 16), (LDSP unsigned*)(sl_ + AOFF), 16, 0, 0); \
        __builtin_amdgcn_global_load_lds((const unsigned*)(ws + OFF_VF + ci * (32 * DV) + (vsel >> 1) * 1024 + lane * 16), (LDSP unsigned*)(sl_ + VOFF), 16, 0, 0); \
        __builtin_amdgcn_global_load_lds((const unsigned*)(ws + OFF_DF + ci * 512 + lane * 16), (LDSP unsigned*)(sl_ + DOFF), 16, 0, 0); } while (0)
#define SEQ_LOAD(cc_, Q_, W_, K_, AB_, AFF_, VB_, U_, D_, DS_, C4_, G4_, B4_, GR_, G15_, B15_) do { const unsigned char* sl_ = ring + ((cc_) % RING) * SLOT; \
        _Pragma("unroll") for (int m = 0; m < 4; ++m) Q_[m] = *(const bf16x8*)(sl_ + m * 1024 + lane * 16); \
        _Pragma("unroll") for (int i = 0; i < 4; ++i) K_[i] = *(const u32x4*)(sl_ + 4096 + lane * 64 + i * 16); \
        if (MIX == 1) { _Pragma("unroll") for (int m = 0; m < 4; ++m) W_[m] = *(const bf16x8*)(sl_ + 8192 + m * 1024 + lane * 16); \
                        { const u32x2 uw_ = *(const u32x2*)(sl_ + VOFF + (vt & 1) * 512 + lane * 8); U_ = (f32x4){__uint_as_float(uw_.x << 16), __uint_as_float(uw_.x & 0xffff0000u), __uint_as_float(uw_.y << 16), __uint_as_float(uw_.y & 0xffff0000u)}; } DS_ = *(const float*)(sl_ + DOFF); } \
        if (MIX == 2) { AFF_ = *(const f32x4*)(sl_ + AOFF + lane * 16); const float* CG = (const float*)(sl_ + DOFF); \
                        C4_ = *(const f32x4*)(CG + 4 * q); G4_ = *(const f32x4*)(CG + 16 + 4 * q); B4_ = *(const f32x4*)(CG + 32 + 4 * q); GR_ = CG[16 + c]; G15_ = CG[31]; B15_ = CG[47]; } \
        else AB_ = *(const u32x2*)(sl_ + AOFF + lane * 8); \
        if (MIX != 1 && !ntile) VB_ = *(const u32x2*)(sl_ + VOFF + (vt & 1) * 512 + lane * 8); \
        if (MIX == 0 || MIX == 3) { _Pragma("unroll") for (int kt = 0; kt < 8; ++kt) D_[kt] = *(const f32x4*)(sl_ + DOFF + q * 128 + kt * 16); } \
    } while (0)
#define SEQ_VMWAIT(n_) asm volatile("s_waitcnt vmcnt(%0)" :: "n"(n_) : "memory")
        asm volatile("s_waitcnt lgkmcnt(0)" ::: "memory");
#pragma unroll
        for (int cc = 0; cc < RING; ++cc) SEQ_DMA(cc);
        SEQ_VMWAIT((RING - 1) * NDMA);
        SEQ_LOAD(0, qf, wf, kf, afb, aff, vfb, uf, df, dsc, c4, g4, b4, grow, g15, b15);
        for (int ch = 0; ch < NCH; ++ch) {
            const int chn = (ch + 1 < NCH) ? ch + 1 : ch;
            if (ch + RING - 1 < NCH) SEQ_VMWAIT((RING - 2) * NDMA); else SEQ_VMWAIT(0);
            asm volatile("s_waitcnt lgkmcnt(0)" ::: "memory");
            if (ch + RING < NCH) SEQ_DMA(ch + RING);
            SEQ_LOAD(chn, nqf, nwf, nkf, nafb, naff, nvfb, nuf, ndf, ndsc, nc4, ng4, nb4, ngrow, ng15, nb15);
            bf16x8 Bs[4];
#pragma unroll
            for (int m = 0; m < 4; ++m) {
                u32x4 w; w.x = cvt_pk_bf16(S[2 * m][0], S[2 * m][1]); w.y = cvt_pk_bf16(S[2 * m][2], S[2 * m][3]);
                w.z = cvt_pk_bf16(S[2 * m + 1][0], S[2 * m + 1][1]); w.w = cvt_pk_bf16(S[2 * m + 1][2], S[2 * m + 1][3]);
                Bs[m] = __builtin_bit_cast(bf16x8, w);
            }
            f32x4 o;
            const f32x4 zero4 = (f32x4){0.f, 0.f, 0.f, 0.f};
            if (LITE) {
                unsigned acc_ = 0;
#pragma unroll
                for (int m = 0; m < 4; ++m) { const u32x4 t_ = __builtin_bit_cast(u32x4, qf[m]); acc_ ^= t_.x ^ t_.y ^ t_.z ^ t_.w ^ kf[m].x ^ kf[m].y ^ kf[m].z ^ kf[m].w; }
                acc_ ^= afb.x ^ vfb.x ^ __float_as_uint(df[0][0]) ^ __float_as_uint(df[7][3]) ^ __float_as_uint(uf[0]) ^ __float_as_uint(aff[1]) ^ __float_as_uint(dsc) ^ __float_as_uint(grow);
                o = (f32x4){__uint_as_float(acc_ & 0x3fffffffu), 0.f, 0.f, 0.f};
            } else
            if (MIX == 0 || MIX == 3) {
                const bf16x4 vb = __builtin_bit_cast(bf16x4, vfb);
                o = mfma16(__builtin_bit_cast(bf16x4, afb), vb, zero4, 0, 0, 0);
#pragma unroll
                for (int m = 0; m < 4; ++m) o = __builtin_amdgcn_mfma_f32_16x16x32_bf16(qf[m], Bs[m], o, 0, 0, 0);
#pragma unroll
                for (int kt = 0; kt < 8; ++kt) {
                    u32x2 kw; kw.x = kf[kt >> 1][(kt & 1) * 2]; kw.y = kf[kt >> 1][(kt & 1) * 2 + 1];
                    S[kt] = mfma16(__builtin_bit_cast(bf16x4, kw), vb, S[kt] * df[kt], 0, 0, 0);
                }
            } else if (MIX == 1) {
                f32x4 wsum = zero4;
#pragma unroll
                for (int m = 0; m < 4; ++m) wsum = __builtin_amdgcn_mfma_f32_16x16x32_bf16(wf[m], Bs[m], wsum, 0, 0, 0);
                const f32x4 vp = uf - wsum;
                u32x2 vw; vw.x = cvt_pk_bf16(vp[0], vp[1]); vw.y = cvt_pk_bf16(vp[2], vp[3]);
                const bf16x4 vb = __builtin_bit_cast(bf16x4, vw);
                o = mfma16(__builtin_bit_cast(bf16x4, afb), vb, zero4, 0, 0, 0);
#pragma unroll
                for (int m = 0; m < 4; ++m) o = __builtin_amdgcn_mfma_f32_16x16x32_bf16(qf[m], Bs[m], o, 0, 0, 0);
#pragma unroll
                for (int kt = 0; kt < 8; ++kt) {
                    u32x2 kw; kw.x = kf[kt >> 1][(kt & 1) * 2]; kw.y = kf[kt >> 1][(kt & 1) * 2 + 1];
                    S[kt] = mfma16(__builtin_bit_cast(bf16x4, kw), vb, S[kt] * dsc, 0, 0, 0);
                }
            } else {
                const float mrow = fmaxf(mprev, grow);
                u32x2 aw; aw.x = cvt_pk_bf16(aff[0] * expf(fminf(c4[0] - mrow, 0.f)), aff[1] * expf(fminf(c4[1] - mrow, 0.f)));
                aw.y = cvt_pk_bf16(aff[2] * expf(fminf(c4[2] - mrow, 0.f)), aff[3] * expf(fminf(c4[3] - mrow, 0.f)));
                f32x4 mr, aint;
#pragma unroll
                for (int r = 0; r < 4; ++r) { mr[r] = fmaxf(mprev, g4[r]); aint[r] = expf(mprev - mr[r]); }
                const float m15 = fmaxf(mprev, g15), lam = expf(g15 - m15), aend = expf(mprev - m15);
                bf16x4 vb, vbl;
                if (ntile) {
                    const unsigned one = (c == 0) ? 0x3f803f80u : 0u;
                    u32x2 t1; t1.x = one; t1.y = one; vb = __builtin_bit_cast(bf16x4, t1);
                    const float lv = (c == 0) ? lam : 0.f;
                    u32x2 t2; t2.x = cvt_pk_bf16(lv, lv); t2.y = t2.x; vbl = __builtin_bit_cast(bf16x4, t2);
                } else {
                    vb = __builtin_bit_cast(bf16x4, vfb);
                    u32x2 t2; t2.x = cvt_pk_bf16(__uint_as_float(vfb.x << 16) * lam, __uint_as_float(vfb.x & 0xffff0000u) * lam);
                    t2.y = cvt_pk_bf16(__uint_as_float(vfb.y << 16) * lam, __uint_as_float(vfb.y & 0xffff0000u) * lam);
                    vbl = __builtin_bit_cast(bf16x4, t2);
                }
                const f32x4 o1 = mfma16(__builtin_bit_cast(bf16x4, aw), vb, zero4, 0, 0, 0);
                f32x4 o2 = zero4;
#pragma unroll
                for (int m = 0; m < 4; ++m) o2 = __builtin_amdgcn_mfma_f32_16x16x32_bf16(qf[m], Bs[m], o2, 0, 0, 0);
                o = o1 + aint * o2;
#pragma unroll
                for (int kt = 0; kt < 8; ++kt) {
                    u32x2 kw; kw.x = kf[kt >> 1][(kt & 1) * 2]; kw.y = kf[kt >> 1][(kt & 1) * 2 + 1];
                    S[kt] = mfma16(__builtin_bit_cast(bf16x4, kw), vbl, S[kt] * aend, 0, 0, 0);
                }
                if (ntile && c == 0) {
#pragma unroll
                    for (int r = 0; r < 4; ++r) { const int rr = (ch % OG) * 16 + 4 * q + r; ostage[rr * 2] = o[r]; ostage[rr * 2 + 1] = b4[r] + mr[r]; }
                }
                mprev = b15 + m15;
            }
            if (!ntile) {
#pragma unroll
                for (int r = 0; r < 4; ++r) ostage[((ch % OG) * 16 + 4 * q + r) * 16 + c] = o[r];
            }
            if ((ch % OG) == OG - 1 || ch == NCH - 1) {
                const int nst = (ch % OG) + 1, chb = ch - (ch % OG);
                asm volatile("s_waitcnt lgkmcnt(0)" ::: "memory");
                if (!ntile) {
                    for (int j = 0; j < nst; ++j) {
                        const f32x4 v = *(const f32x4*)(ostage + (j * 16 + (lane >> 2)) * 16 + (lane & 3) * 4);
                        u32x2 w; w.x = cvt_pk_bf16(v[0], v[1]); w.y = cvt_pk_bf16(v[2], v[3]);
                        *(u32x2*)((bf16_t*)O + (size_t)(row0 + (chb + j) * 16 + (lane >> 2)) * 1024 + h * DV + vt * 16 + (lane & 3) * 4) = w;
                    }
                } else {
                    float* DEN = (float*)(ws + OFF_DEN); float* MT = (float*)(ws + OFF_MT);
                    for (int rr = lane; rr < nst * 16; rr += 64) { const size_t row = (size_t)(row0 + chb * 16 + rr); DEN[row * 8 + h] = ostage[rr * 2]; MT[row * 8 + h] = ostage[rr * 2 + 1]; }
                }
            }
#pragma unroll
            for (int m = 0; m < 4; ++m) { qf[m] = nqf[m]; wf[m] = nwf[m]; kf[m] = nkf[m]; }
#pragma unroll
            for (int kt = 0; kt < 8; ++kt) df[kt] = ndf[kt];
            afb = nafb; aff = naff; vfb = nvfb; uf = nuf; dsc = ndsc; c4 = nc4; g4 = ng4; b4 = nb4; grow = ngrow; g15 = ng15; b15 = nb15;
        }
#undef SEQ_LOAD
#undef SEQ_DMA
#undef SEQ_VMWAIT
        asm volatile("s_waitcnt vmcnt(0) lgkmcnt(0)" ::: "memory");
        if (!ntile) {
            float* out_S = p.out + ((MIX == 0) ? OUT_P_HGRN : (MIX == 1) ? OUT_P_GDN : (MIX == 2) ? OUT_P_MC : OUT_P_GLA) + (size_t)bh * 128 * DV;
#pragma unroll
            for (int kt = 0; kt < 8; ++kt)
#pragma unroll
                for (int r = 0; r < 4; ++r) out_S[(size_t)(16 * kt + 4 * q + r) * DV + vt * 16 + c] = S[kt][r];
        } else if (c == 0) {
            float* on = p.out + OUT_P_MN + (size_t)bh * 128;
#pragma unroll
            for (int kt = 0; kt < 8; ++kt)
#pragma unroll
                for (int r = 0; r < 4; ++r) on[16 * kt + 4 * q + r] = S[kt][r];
            if (q == 0) p.out[OUT_P_MM + bh] = mprev;
        }
    }
}

template <int MIX>
__device__ __forceinline__ void normgate_phase(const Params& p) {
    const int TID = opaque_tid();
    unsigned char* ws = opaque_ptr(p.ws);
    const bf16_t* P = (const bf16_t*)(ws + OFF_P);
    const float* O = (const float*)(ws + OFF_O);
    bf16_t* A2 = (bf16_t*)(ws + OFF_A2);
    const int wave = TID >> 6, lane = TID & 63;
    const float* ng = (MIX == 0) ? p.in[12] : (MIX == 1) ? p.in[18] : (MIX == 2) ? p.in[23] : p.in[28];
    constexpr int GOFF = (MIX == 0) ? 3072 : (MIX == 1) ? 3088 : (MIX == 2) ? 3088 : 2048;
    constexpr int R = 3;
    const int stride = gridDim.x * 4;
    const int c0 = lane * 16;
    for (int row0 = blockIdx.x * 4 + wave; row0 < MTOK; row0 += stride * R) {
        f32x4 ov[R][4]; u32x2 gw[R][4]; float denv[R], mtv[R];
#pragma unroll
        for (int u = 0; u < R; ++u) {
            const int row = (row0 + u * stride < MTOK) ? row0 + u * stride : row0;
#pragma unroll
            for (int j = 0; j < 4; ++j) {
                ov[u][j] = ldbf4((const bf16_t*)O + (size_t)row * 1024 + c0 + j * 4);
                gw[u][j] = *(const u32x2*)(P + (size_t)row * PLD + GOFF + c0 + j * 4);
            }
            if (MIX == 2) { denv[u] = ((const float*)(ws + OFF_DEN))[(size_t)row * 8 + (lane >> 3)]; mtv[u] = ((const float*)(ws + OFF_MT))[(size_t)row * 8 + (lane >> 3)]; }
        }
#pragma unroll
        for (int u = 0; u < R; ++u) {
            const int row = row0 + u * stride;
            if (row < MTOK) {
                float x[16], gt[16];
#pragma unroll
                for (int j = 0; j < 4; ++j) {
                    const f32x4 gg = (f32x4){__uint_as_float(gw[u][j].x << 16), __uint_as_float(gw[u][j].x & 0xffff0000u), __uint_as_float(gw[u][j].y << 16), __uint_as_float(gw[u][j].y & 0xffff0000u)};
#pragma unroll
                    for (int q = 0; q < 4; ++q) { x[j * 4 + q] = ov[u][j][q]; gt[j * 4 + q] = gg[q]; }
                }
                if (MIX == 2) {
                    const float inv = 1.f / fmaxf(fabsf(denv[u]), expf(-mtv[u]));
#pragma unroll
                    for (int j = 0; j < 16; ++j) x[j] *= inv;
                }
                float s1 = 0.f, s2 = 0.f;
#pragma unroll
                for (int j = 0; j < 16; ++j) { s1 += x[j]; s2 += x[j] * x[j]; }
                s1 += __shfl_xor(s1, 1); s1 += __shfl_xor(s1, 2); s1 += __shfl_xor(s1, 4);
                s2 += __shfl_xor(s2, 1); s2 += __shfl_xor(s2, 2); s2 += __shfl_xor(s2, 4);
                if (MIX == 3) { s1 += __shfl_xor(s1, 8); s2 += __shfl_xor(s2, 8); }
                constexpr float invn = (MIX == 3) ? (1.f / 256.f) : (1.f / 128.f);
                float outv[16];
                if (MIX == 2) {
                    const float mean = s1 * invn;
                    float q2 = 0.f;
#pragma unroll
                    for (int j = 0; j < 16; ++j) { const float d = x[j] - mean; q2 += d * d; }
                    q2 += __shfl_xor(q2, 1); q2 += __shfl_xor(q2, 2); q2 += __shfl_xor(q2, 4);
                    const float rs = rsqrtf(q2 * invn + 1e-6f);
#pragma unroll
                    for (int j = 0; j < 16; ++j) outv[j] = sigmoidf_(gt[j]) * ((x[j] - mean) * rs * ng[c0 + j]);
                } else {
                    const float rs = rsqrtf(s2 * invn + 1e-6f);
#pragma unroll
                    for (int j = 0; j < 16; ++j) {
                        const int gi = (MIX == 3) ? ((c0 + j) & 255) : ((c0 + j) & 127);
                        outv[j] = x[j] * rs * ng[gi] * siluf_(gt[j]);
                    }
                }
                uint4 w0, w1;
                w0.x = pack2bf(outv[0], outv[1]); w0.y = pack2bf(outv[2], outv[3]); w0.z = pack2bf(outv[4], outv[5]); w0.w = pack2bf(outv[6], outv[7]);
                w1.x = pack2bf(outv[8], outv[9]); w1.y = pack2bf(outv[10], outv[11]); w1.z = pack2bf(outv[12], outv[13]); w1.w = pack2bf(outv[14], outv[15]);
                *(uint4*)(A2 + (size_t)row * 1024 + c0) = w0; *(uint4*)(A2 + (size_t)row * 1024 + c0 + 8) = w1;
            }
        }
    }
    if (MIX == 1) {
        const float* cbuf = p.in[4];
        const int total = NSEQ * 3 * 3072;
        for (int i = blockIdx.x * NTH + TID; i < total; i += gridDim.x * NTH) {
            const int seq = i / (3 * 3072), rem = i % (3 * 3072), j = rem / 3072, cc = rem % 3072;
            if (seq < NB_P) p.out[OUT_P_CONV + (size_t)i] = bf2f(P[(size_t)(seq * T_P + T_P - 3 + j) * PLD + cc]);
            else {
                const int ss = seq - NB_P;
                const float v = (j < 2) ? cbuf[((size_t)ss * 3 + j + 1) * 3072 + cc] : bf2f(P[(size_t)(ROWS_P + ss) * PLD + cc]);
                p.out[OUT_S_CONV + ((size_t)ss * 3 + j) * 3072 + cc] = v;
            }
        }
    }
}

__device__ __forceinline__ void ln_phase(const Params& p, int layer, int which, bool dry) {
    const int TID = opaque_tid();
    unsigned char* ws = opaque_ptr(p.ws);
    const bf16_t* Hin = (const bf16_t*)(ws + OFF_HB);
    bf16_t* Hb = dry ? (bf16_t*)(ws + OFF_DRY + (size_t)MTOK * 4096) : (bf16_t*)(ws + OFF_HB);
    const float* Y = (const float*)(ws + OFF_O);
    const bf16_t* Fb = (const bf16_t*)(ws + OFF_F);
    const float* lg = p.in[35] + (size_t)(layer * 2 + which) * 1024;
    const float* lbias = p.in[36] + (size_t)(layer * 2 + which) * 1024;
    const int wave = TID >> 6, lane = TID & 63;
    constexpr int R = 3;
    const int stride = gridDim.x * 4;
    f32x4 gv[4], bv[4];
#pragma unroll
    for (int j = 0; j < 4; ++j) { gv[j] = *(const f32x4*)(lg + j * 256 + lane * 4); bv[j] = *(const f32x4*)(lbias + j * 256 + lane * 4); }
    for (int row0 = blockIdx.x * 4 + wave; row0 < MTOK; row0 += stride * R) {
        u32x2 hw[R][4], fw[R][4]; f32x4 yv[R][4];
#pragma unroll
        for (int u = 0; u < R; ++u) {
            const int row = (row0 + u * stride < MTOK) ? row0 + u * stride : row0;
#pragma unroll
            for (int j = 0; j < 4; ++j) {
                hw[u][j] = *(const u32x2*)(Hin + (size_t)row * 1024 + j * 256 + lane * 4);
                if (which) fw[u][j] = *(const u32x2*)(Fb + (size_t)row * 1024 + j * 256 + lane * 4);
                else yv[u][j] = *(const f32x4*)(Y + (size_t)row * 1024 + j * 256 + lane * 4);
            }
        }
#pragma unroll
        for (int u = 0; u < R; ++u) {
            const int row = row0 + u * stride;
            if (row < MTOK) {
                float z[16];
                float s1 = 0.f;
#pragma unroll
                for (int j = 0; j < 4; ++j) {
                    const f32x4 hv = (f32x4){__uint_as_float(hw[u][j].x << 16), __uint_as_float(hw[u][j].x & 0xffff0000u), __uint_as_float(hw[u][j].y << 16), __uint_as_float(hw[u][j].y & 0xffff0000u)};
                    f32x4 y4;
                    if (which) y4 = (f32x4){__uint_as_float(fw[u][j].x << 16), __uint_as_float(fw[u][j].x & 0xffff0000u), __uint_as_float(fw[u][j].y << 16), __uint_as_float(fw[u][j].y & 0xffff0000u)};
                    else y4 = yv[u][j];
#pragma unroll
                    for (int q = 0; q < 4; ++q) { z[j * 4 + q] = DN_ALPHA * hv[q] + y4[q]; s1 += z[j * 4 + q]; }
                }
                const float mean = wave_sum(s1) * (1.f / 1024.f);
                float s2 = 0.f;
#pragma unroll
                for (int j = 0; j < 16; ++j) { const float d = z[j] - mean; s2 += d * d; }
                const float rs = rsqrtf(wave_sum(s2) * (1.f / 1024.f) + 1e-5f);
                float o[16];
#pragma unroll
                for (int j = 0; j < 16; ++j) o[j] = (z[j] - mean) * rs * gv[j >> 2][j & 3] + bv[j >> 2][j & 3];
#pragma unroll
                for (int j = 0; j < 4; ++j) { u32x2 w; w.x = pack2bf(o[4 * j], o[4 * j + 1]); w.y = pack2bf(o[4 * j + 2], o[4 * j + 3]); *(u32x2*)(Hb + (size_t)row * 1024 + j * 256 + lane * 4) = w; }
                if (which == 0 && !dry) {
#pragma unroll
                    for (int j = 0; j < 4; ++j)
                        *(unsigned*)(ws + OFF_HQ + (size_t)row * 1024 + j * 256 + lane * 4) = pack_i8x4(o[4 * j] * (1.f / XQ_SCALE), o[4 * j + 1] * (1.f / XQ_SCALE), o[4 * j + 2] * (1.f / XQ_SCALE), o[4 * j + 3] * (1.f / XQ_SCALE));
                }
                if (which == 1 && layer == 3 && !dry) {
                    float* dst = nullptr;
                    if (row < ROWS_P) { const int b = row / T_P, t = row % T_P; if (t >= 16) dst = p.out + OUT_YP + ((size_t)b * 2048 + (t - 16)) * 1024; }
                    else dst = p.out + OUT_YS + (size_t)(row - ROWS_P) * 1024;
                    if (dst) {
#pragma unroll
                        for (int j = 0; j < 4; ++j) *(f32x4*)(dst + j * 256 + lane * 4) = (f32x4){o[j * 4], o[j * 4 + 1], o[j * 4 + 2], o[j * 4 + 3]};
                    }
                }
            }
        }
    }
}

#define KINS16(V, x_) do { const float xk_ = (x_); \
    _Pragma("unroll") for (int q_ = 15; q_ >= 1; --q_) V[q_] = __builtin_amdgcn_fmed3f(V[q_ - 1], V[q_], xk_); \
    V[0] = fmaxf(V[0], xk_); } while (0)
__device__ __forceinline__ float key_pack(float v, unsigned mask, unsigned id) { return __uint_as_float((__float_as_uint(v) & ~mask) | id); }
__device__ __forceinline__ float key_val(float k, unsigned mask) { return __uint_as_float(__float_as_uint(k) & ~mask); }

__device__ __forceinline__ void topk_phase(const Params& p) {
    const int TID = opaque_tid();
    unsigned char* ws = opaque_ptr(p.ws);
    const float* S1 = (const float*)(ws + OFF_S1);
    const float* S2 = (const float*)(ws + OFF_S2);
    int* TI = (int*)(ws + OFF_TI);
    float* TW = (float*)(ws + OFF_TW);
    const int NR = MTOK * 8;
    for (int r = blockIdx.x * NTH + TID; r < NR; r += gridDim.x * NTH) {
        float k1[16], k2[16];
#pragma unroll
        for (int q = 0; q < 16; ++q) { k1[q] = -INFINITY; k2[q] = -INFINITY; }
        const float* s1p = S1 + (size_t)(r >> 7) * 16384 + (r & 127);
        const float* s2p = S2 + (size_t)(r >> 7) * 16384 + (r & 127);
#pragma unroll 1
        for (int jb = 0; jb < 128; jb += 16) {
            float xs[16], ys[16];
#pragma unroll
            for (int j = 0; j < 16; ++j) { xs[j] = s1p[(jb + j) * 128]; ys[j] = s2p[(jb + j) * 128]; }
#pragma unroll
            for (int j = 0; j < 16; ++j) { KINS16(k1, key_pack(xs[j], 127u, (unsigned)(jb + j))); KINS16(k2, key_pack(ys[j], 127u, (unsigned)(jb + j))); }
        }
        float kc[16];
#pragma unroll
        for (int q = 0; q < 16; ++q) kc[q] = -INFINITY;
        {
            int slot = 0;
#pragma unroll
            for (int a = 0; a < 16; ++a)
#pragma unroll
                for (int b = 0; b < 16; ++b)
                    if ((a + 1) * (b + 1) <= 16) { const float sv = key_val(k1[a], 127u) + key_val(k2[b], 127u); KINS16(kc, key_pack(sv, 63u, (unsigned)slot)); ++slot; }
        }
        const float tau = kc[15], vmax = key_val(k1[0], 127u) + key_val(k2[0], 127u);
        float sum = 0.f;
        {
            int slot = 0;
#pragma unroll
            for (int a = 0; a < 16; ++a)
#pragma unroll
                for (int b = 0; b < 16; ++b)
                    if ((a + 1) * (b + 1) <= 16) { const float sv = key_val(k1[a], 127u) + key_val(k2[b], 127u); const bool sel = key_pack(sv, 63u, (unsigned)slot) >= tau; sum += sel ? __expf(sv - vmax) : 0.f; ++slot; }
        }
        const float inv = 1.f / sum;
        {
            int slot = 0, cnt = 0;
#pragma unroll
            for (int a = 0; a < 16; ++a)
#pragma unroll
                for (int b = 0; b < 16; ++b)
                    if ((a + 1) * (b + 1) <= 16) {
                        const float sv = key_val(k1[a], 127u) + key_val(k2[b], 127u); const bool sel = key_pack(sv, 63u, (unsigned)slot) >= tau;
                        if (sel) { TI[(size_t)r * 16 + cnt] = (int)(((__float_as_uint(k1[a]) & 127u) << 7) | (__float_as_uint(k2[b]) & 127u)); TW[(size_t)r * 16 + cnt] = __expf(sv - vmax) * inv; ++cnt; }
                        ++slot;
                    }
        }
    }
}

constexpr int ST_RS = 68;
constexpr int ST_BYTES = 64 * ST_RS * 4;
static_assert(4 * ST_BYTES <= LDS_BYTES, "score tiles exceed the LDS budget");
__device__ __forceinline__ void scoretopk_phase(const Params& p, int layer, unsigned char* lds) {
    const int TID = opaque_tid();
    unsigned char* ws = opaque_ptr(p.ws);
    const int wave = TID >> 6, lane = TID & 63, q = lane >> 4, c = lane & 15;
    const bf16_t* Q = (const bf16_t*)(ws + OFF_Q);
    const bf16_t* keys = (const bf16_t*)(ws + OFF_KEYS) + (size_t)layer * 2 * 16384;
    unsigned short* TI = (unsigned short*)(ws + OFF_TI);
    float* TW = (float*)(ws + OFF_TW);
    float* st = (float*)(lds + wave * ST_BYTES);
    for (int item = blockIdx.x * 4 + wave; item < 2048; item += gridDim.x * 4) {
        const int r0 = item * 65;
        float k1[16], k2[16];
#pragma unroll
        for (int i = 0; i < 16; ++i) { k1[i] = -INFINITY; k2[i] = -INFINITY; }
        float xe[4];
#pragma unroll
        for (int ph = 0; ph < 2; ++ph) {
            bf16x8 a[5][4];
#pragma unroll
            for (int rt = 0; rt < 5; ++rt)
#pragma unroll
                for (int ks = 0; ks < 4; ++ks) a[rt][ks] = *(const bf16x8*)(Q + (size_t)(r0 + 16 * rt + c) * 256 + ph * 128 + ks * 32 + q * 8);
#pragma unroll
            for (int kh = 0; kh < 2; ++kh) {
#pragma unroll
                for (int kt = 0; kt < 4; ++kt) {
                    f32x4 acc[5];
#pragma unroll
                    for (int rt = 0; rt < 5; ++rt) acc[rt] = (f32x4){0.f, 0.f, 0.f, 0.f};
#pragma unroll
                    for (int ks = 0; ks < 4; ++ks) {
                        const bf16x8 b = *(const bf16x8*)(keys + ph * 16384 + (size_t)(kh * 64 + kt * 16 + c) * 128 + ks * 32 + q * 8);
#pragma unroll
                        for (int rt = 0; rt < 5; ++rt) acc[rt] = __builtin_amdgcn_mfma_f32_16x16x32_bf16(a[rt][ks], b, acc[rt], 0, 0, 0);
                    }
#pragma unroll
                    for (int rt = 0; rt < 4; ++rt) *(f32x4*)(st + (kt * 16 + c) * ST_RS + 16 * rt + 4 * q) = acc[rt];
                    if (q == 0) st[(kt * 16 + c) * ST_RS + 64] = acc[4][0];
                }
#pragma unroll 1
                for (int jb = 0; jb < 64; jb += 16) {
                    float xs[16];
#pragma unroll
                    for (int j = 0; j < 16; ++j) xs[j] = st[(jb + j) * ST_RS + lane];
#pragma unroll
                    for (int j = 0; j < 16; ++j) {
                        const float kx = key_pack(xs[j], 127u, (unsigned)(kh * 64 + jb + j));
                        if (ph == 0) KINS16(k1, kx); else KINS16(k2, kx);
                    }
                }
                xe[ph * 2 + kh] = key_pack(st[lane * ST_RS + 64], 127u, (unsigned)(kh * 64 + lane));
            }
        }
        {
            const int r = r0 + lane;
            float kc[16];
#pragma unroll
            for (int i = 0; i < 16; ++i) kc[i] = -INFINITY;
            unsigned ia_[16], ib_[16];
#pragma unroll
            for (int i = 0; i < 16; ++i) { ia_[i] = (__float_as_uint(k1[i]) & 127u) << 7; ib_[i] = __float_as_uint(k2[i]) & 127u; }
#pragma unroll
            for (int a_ = 0; a_ < 16; ++a_)
#pragma unroll
                for (int b_ = 0; b_ < 16; ++b_)
                    if ((a_ + 1) * (b_ + 1) <= 16) { const float sv = key_val(k1[a_], 127u) + key_val(k2[b_], 127u); KINS16(kc, key_pack(sv, 0x3fffu, ia_[a_] | ib_[b_])); }
            const float vmax = key_val(kc[0], 0x3fffu);
            float ew[16], sum = 0.f;
#pragma unroll
            for (int i = 0; i < 16; ++i) { ew[i] = __expf(key_val(kc[i], 0x3fffu) - vmax); sum += ew[i]; }
            const float inv = 1.f / sum;
            u32x4 t0, t1;
#pragma unroll
            for (int i = 0; i < 4; ++i) {
                t0[i] = (__float_as_uint(kc[2 * i]) & 0x3fffu) | ((__float_as_uint(kc[2 * i + 1]) & 0x3fffu) << 16);
                t1[i] = (__float_as_uint(kc[8 + 2 * i]) & 0x3fffu) | ((__float_as_uint(kc[8 + 2 * i + 1]) & 0x3fffu) << 16);
            }
            *(u32x4*)(TI + (size_t)r * 16) = t0; *(u32x4*)(TI + (size_t)r * 16 + 8) = t1;
#pragma unroll
            for (int i = 0; i < 4; ++i) *(f32x4*)(TW + (size_t)r * 16 + 4 * i) = (f32x4){ew[4 * i] * inv, ew[4 * i + 1] * inv, ew[4 * i + 2] * inv, ew[4 * i + 3] * inv};
        }
        {
            const int r = r0 + 64;
            float l1[16], l2[16];
            float xa = xe[0], xb = xe[1], ya = xe[2], yb = xe[3];
#pragma unroll
            for (int i = 0; i < 16; ++i) {
                const float m1 = wave_max_u(fmaxf(xa, xb)), m2 = wave_max_u(fmaxf(ya, yb));
                l1[i] = m1; l2[i] = m2;
                xa = (xa == m1) ? -INFINITY : xa; xb = (xb == m1) ? -INFINITY : xb;
                ya = (ya == m2) ? -INFINITY : ya; yb = (yb == m2) ? -INFINITY : yb;
            }
            const int s = lane;
            int ca, cb;
            if (s < 16) { ca = 0; cb = s; } else if (s < 24) { ca = 1; cb = s - 16; } else if (s < 29) { ca = 2; cb = s - 24; } else if (s < 33) { ca = 3; cb = s - 29; }
            else if (s < 36) { ca = 4; cb = s - 33; } else if (s < 42) { ca = 5 + ((s - 36) >> 1); cb = (s - 36) & 1; } else { ca = 8 + (s - 42); cb = 0; }
            float ka = l1[0], kb = l2[0];
#pragma unroll
            for (int i = 1; i < 16; ++i) { ka = (ca == i) ? l1[i] : ka; kb = (cb == i) ? l2[i] : kb; }
            const float sv = key_val(ka, 127u) + key_val(kb, 127u);
            const float ck = (s < 50) ? key_pack(sv, 0x3fffu, ((__float_as_uint(ka) & 127u) << 7) | (__float_as_uint(kb) & 127u)) : -INFINITY;
            float cx = ck, mine = 0.f, vmax = 0.f, sum = 0.f;
#pragma unroll
            for (int i = 0; i < 16; ++i) {
                const float mx = wave_max_u(cx);
                cx = (cx == mx) ? -INFINITY : cx;
                if (i == 0) vmax = key_val(mx, 0x3fffu);
                sum += __expf(key_val(mx, 0x3fffu) - vmax);
                mine = (lane == i) ? mx : mine;
            }
            if (lane < 16) { TI[(size_t)r * 16 + lane] = (unsigned short)(__float_as_uint(mine) & 0x3fffu); TW[(size_t)r * 16 + lane] = __expf(key_val(mine, 0x3fffu) - vmax) / sum; }
        }
    }
}

__device__ __forceinline__ float gelu_erf(float d) { return 0.5f * d * (1.f + erff(d * 0.70710678118654752f)); }
#define XCD_BAR_WORDS 3456
constexpr int GQ_TW = 16;
constexpr int GQ_PER_SLICE = MTOK / (4 * GQ_TW);
__device__ __forceinline__ unsigned gq_xcc_id() { return (unsigned)__builtin_amdgcn_s_getreg((3 << 11) | 20) & 0xFu; }
__device__ __forceinline__ int queue_take(unsigned* cnt, int own, volatile LDSP int* bc, int tid) {
    if (tid == 0) {
        int it = -1;
        for (int k = 0; k < 8 && it < 0; ++k) {
            const int s_ = (own + k) & 7; unsigned* c = cnt + s_ * 16;
            if (__hip_atomic_load(c, __ATOMIC_RELAXED, __HIP_MEMORY_SCOPE_AGENT) < (unsigned)GQ_PER_SLICE) {
                const unsigned v = __hip_atomic_fetch_add(c, 1u, __ATOMIC_RELAXED, __HIP_MEMORY_SCOPE_AGENT);
                if (v < (unsigned)GQ_PER_SLICE) it = s_ * GQ_PER_SLICE + (int)v;
            }
        }
        bc[0] = it;
    }
    __syncthreads();
    const int it = bc[0];
    __syncthreads();
    return it;
}
__device__ __forceinline__ float dpp_add(float v, int ctrl_sel) {
    const int x = __builtin_bit_cast(int, v);
    int y;
    if (ctrl_sel == 0) y = __builtin_amdgcn_update_dpp(0, x, 0xB1, 0xF, 0xF, true);
    else if (ctrl_sel == 1) y = __builtin_amdgcn_update_dpp(0, x, 0x4E, 0xF, 0xF, true);
    else y = __builtin_amdgcn_update_dpp(0, x, 0x141, 0xF, 0xF, true);
    return v + __builtin_bit_cast(float, y);
}
__device__ __forceinline__ float sum8(float v) { v = dpp_add(v, 0); v = dpp_add(v, 1); v = dpp_add(v, 2); return v; }
#define CVT8(w_, lo_, hi_) const f32x2 lo_ = __builtin_amdgcn_cvt_pk_f32_fp8((int)(w_), false), hi_ = __builtin_amdgcn_cvt_pk_f32_fp8((int)(w_), true)

__device__ __forceinline__ void gatherU_phase(const Params& p, int layer, unsigned char* lds, int rep) {
    const int TID = opaque_tid();
    unsigned char* ws = opaque_ptr(p.ws);
    const unsigned char* Hq = ws + OFF_HQ;
    const unsigned short* TI = (const unsigned short*)(ws + OFF_TI);
    unsigned* cnt = (unsigned*)(ws + OFF_BAR) + XCD_BAR_WORDS + (layer * 4 + 0 + rep) * 128;
    const int wave = TID >> 6, lane = TID & 63, e = lane >> 3, c = lane & 7;
    const int own = (int)(gq_xcc_id() & 7u);
    auto process = [&](const int sl, const int tbase, const int ntok) {
        const unsigned char* Us = ws + OFF_UB + ((size_t)(layer * 8 + sl) * NEXP) * 128;
        bf16_t* PD = (bf16_t*)(ws + OFF_PD) + (size_t)sl * MTOK * 128;
        int i0 = TI[(size_t)tbase * 128 + lane], i1 = TI[(size_t)tbase * 128 + 64 + lane];
        u32x4 ub[16]; u32x4 xq, nxq;
        xq = *(const u32x4*)(Hq + (size_t)tbase * 1024 + sl * 128 + c * 16);
#pragma unroll
        for (int ii = 0; ii < 16; ++ii) { const int ej = __shfl((ii < 8) ? i0 : i1, (ii & 7) * 8 + e); ub[ii] = *(const u32x4*)(Us + (unsigned)(ej * 128 + c * 16)); }
        int n0 = TI[(size_t)(tbase + 1) * 128 + lane], n1 = TI[(size_t)(tbase + 1) * 128 + 64 + lane];
#pragma unroll 1
        for (int i = 0; i < ntok; ++i) {
            const int t = tbase + i, tn = tbase + ((i + 1 < ntok) ? i + 1 : ntok - 1), tnn = tbase + ((i + 2 < ntok) ? i + 2 : ntok - 1);
            nxq = *(const u32x4*)(Hq + (size_t)tn * 1024 + sl * 128 + c * 16);
            const int nn0 = TI[(size_t)tnn * 128 + lane], nn1 = TI[(size_t)tnn * 128 + 64 + lane];
            float k0 = 0.f, k1 = 0.f;
#pragma unroll
            for (int ii = 0; ii < 16; ++ii) {
                int di = __builtin_amdgcn_sdot4((int)ub[ii][0], (int)xq[0], 0, false);
                di = __builtin_amdgcn_sdot4((int)ub[ii][1], (int)xq[1], di, false);
                int dj = __builtin_amdgcn_sdot4((int)ub[ii][2], (int)xq[2], 0, false);
                dj = __builtin_amdgcn_sdot4((int)ub[ii][3], (int)xq[3], dj, false);
                float d = (float)(di + dj);
                { const int ej = __shfl((ii < 8) ? n0 : n1, (ii & 7) * 8 + e); ub[ii] = *(const u32x4*)(Us + (unsigned)(ej * 128 + c * 16)); }
                d = sum8(d);
                if (ii < 8) k0 = (ii == c) ? d : k0; else k1 = ((ii - 8) == c) ? d : k1;
            }
            PD[(size_t)t * 128 + c * 8 + e] = f2bf(k0);
            PD[(size_t)t * 128 + 64 + c * 8 + e] = f2bf(k1);
            xq = nxq; n0 = nn0; n1 = nn1;
        }
    };
    volatile LDSP unsigned* st_ = (volatile LDSP unsigned*)(lds + LDS_BYTES);
    if (st_[3] != 0u) {
        process(own, 65 * ((int)st_[2] * 4 + wave), 65);
    } else for (;;) {
        const int item = __builtin_amdgcn_readfirstlane(queue_take(cnt, own, (volatile LDSP int*)lds, TID));
        if (item < 0) break;
        process(item / GQ_PER_SLICE, (item % GQ_PER_SLICE) * (4 * GQ_TW) + wave * GQ_TW, GQ_TW);
    }
}

__device__ __forceinline__ void gatherW_phase(const Params& p, int layer) {
    const int TID = opaque_tid();
    unsigned char* ws = opaque_ptr(p.ws);
    const unsigned short* TI = (const unsigned short*)(ws + OFF_TI);
    const float* TW = (const float*)(ws + OFF_TW);
    bf16_t* TWb = (bf16_t*)(ws + OFF_TI + (size_t)MTOK * 128 * 2);
    const float* SU = (const float*)(ws + OFF_SU) + (size_t)layer * NEXP;
    const float* SV = (const float*)(ws + OFF_SV) + (size_t)layer * NEXP;
    const bf16_t* PD = (const bf16_t*)(ws + OFF_PD);
    const int n = MTOK * 128;
    for (int i = blockIdx.x * NTH + TID; i < n; i += gridDim.x * NTH) {
        float d = 0.f;
#pragma unroll
        for (int s_ = 0; s_ < 8; ++s_) d += bf2f(PD[(size_t)s_ * n + i]);
        const int e = TI[i];
        TWb[i] = f2bf(TW[i] * SV[e] * gelu_erf(d * (SU[e] * XQ_SCALE)));
    }
}

__device__ __forceinline__ void gatherV_phase(const Params& p, int layer, unsigned char* lds, int rep) {
    const int TID = opaque_tid();
    unsigned char* ws = opaque_ptr(p.ws);
    const unsigned short* TI = (const unsigned short*)(ws + OFF_TI);
    const bf16_t* TW = (const bf16_t*)(ws + OFF_TI + (size_t)MTOK * 128 * 2);
    bf16_t* F = (bf16_t*)(ws + OFF_F);
    unsigned* cnt = (unsigned*)(ws + OFF_BAR) + XCD_BAR_WORDS + (layer * 4 + 2 + rep) * 128;
    const int wave = TID >> 6, lane = TID & 63, e = lane >> 3, c = lane & 7;
    const int own = (int)(gq_xcc_id() & 7u);
    auto process = [&](const int sl, const int tbase, const int ntok) {
        const unsigned char* Vs = ws + OFF_VB + ((size_t)(layer * 8 + sl) * NEXP) * 128;
        int i0 = TI[(size_t)tbase * 128 + lane], i1 = TI[(size_t)tbase * 128 + 64 + lane];
        float w0 = bf2f(TW[(size_t)tbase * 128 + lane]), w1 = bf2f(TW[(size_t)tbase * 128 + 64 + lane]);
        u32x4 vbA[8], vbB[8];
#pragma unroll
        for (int ii = 0; ii < 8; ++ii) { const int ej = __shfl(i0, ii * 8 + e); vbA[ii] = *(const u32x4*)(Vs + (unsigned)(ej * 128 + c * 16)); }
#pragma unroll 1
        for (int i = 0; i < ntok; ++i) {
            const int t = tbase + i, tn = tbase + ((i + 1 < ntok) ? i + 1 : ntok - 1);
#pragma unroll
            for (int ii = 0; ii < 8; ++ii) { const int ej = __shfl(i1, ii * 8 + e); vbB[ii] = *(const u32x4*)(Vs + (unsigned)(ej * 128 + c * 16)); }
            const int n0 = TI[(size_t)tn * 128 + lane], n1 = TI[(size_t)tn * 128 + 64 + lane];
            const float nw0 = bf2f(TW[(size_t)tn * 128 + lane]), nw1 = bf2f(TW[(size_t)tn * 128 + 64 + lane]);
            float acc[16];
#pragma unroll
            for (int j = 0; j < 16; ++j) acc[j] = 0.f;
#pragma unroll
            for (int ii = 0; ii < 8; ++ii) {
                const float wj = __shfl(w0, ii * 8 + e);
#pragma unroll
                for (int q = 0; q < 4; ++q) { CVT8(vbA[ii][q], lo, hi); acc[4 * q] += wj * lo[0]; acc[4 * q + 1] += wj * lo[1]; acc[4 * q + 2] += wj * hi[0]; acc[4 * q + 3] += wj * hi[1]; }
            }
            asm volatile("" ::: "memory");
#pragma unroll
            for (int ii = 0; ii < 8; ++ii) { const int ej = __shfl(n0, ii * 8 + e); vbA[ii] = *(const u32x4*)(Vs + (unsigned)(ej * 128 + c * 16)); }
#pragma unroll
            for (int ii = 0; ii < 8; ++ii) {
                const float wj = __shfl(w1, ii * 8 + e);
#pragma unroll
                for (int q = 0; q < 4; ++q) { CVT8(vbB[ii][q], lo, hi); acc[4 * q] += wj * lo[0]; acc[4 * q + 1] += wj * lo[1]; acc[4 * q + 2] += wj * hi[0]; acc[4 * q + 3] += wj * hi[1]; }
            }
            float r8[8], r4[4], r2[2];
#pragma unroll
            for (int j = 0; j < 8; ++j) { const bool up = lane >= 32; const float snd = up ? acc[j] : acc[j + 8], keep = up ? acc[j + 8] : acc[j]; r8[j] = keep + __shfl_xor(snd, 32); }
#pragma unroll
            for (int j = 0; j < 4; ++j) { const bool up = (lane & 16) != 0; const float snd = up ? r8[j] : r8[j + 4], keep = up ? r8[j + 4] : r8[j]; r4[j] = keep + __shfl_xor(snd, 16); }
#pragma unroll
            for (int j = 0; j < 2; ++j) { const bool up = (lane & 8) != 0; const float snd = up ? r4[j] : r4[j + 2], keep = up ? r4[j + 2] : r4[j]; r2[j] = keep + __shfl_xor(snd, 8); }
            const int col = sl * 128 + c * 16 + ((lane >> 5) & 1) * 8 + ((lane >> 4) & 1) * 4 + ((lane >> 3) & 1) * 2;
            *(unsigned*)(F + (size_t)t * 1024 + col) = cvt_pk_bf16(r2[0], r2[1]);
            w0 = nw0; w1 = nw1; i0 = n0; i1 = n1;
        }
    };
    volatile LDSP unsigned* st_ = (volatile LDSP unsigned*)(lds + LDS_BYTES);
    if (st_[3] != 0u) {
        process(own, 65 * ((int)st_[2] * 4 + wave), 65);
    } else for (;;) {
        const int item = __builtin_amdgcn_readfirstlane(queue_take(cnt, own, (volatile LDSP int*)lds, TID));
        if (item < 0) break;
        process(item / GQ_PER_SLICE, (item % GQ_PER_SLICE) * (4 * GQ_TW) + wave * GQ_TW, GQ_TW);
    }
}

#define XB_TMO      128
#define XB_XCNT(j)  (256  + 64 * (j))
#define XB_XSUB(j)  (1280 + 64 * (j))
#define XB_XGEN(j)  (2304 + 64 * (j))
#define XB_TOP      3328
#define XB_TOPGEN   3392
#define XB_SPIN_CAP (1u << 22)
__device__ __forceinline__ unsigned xb_ld(unsigned* p)              { return __hip_atomic_load(p, __ATOMIC_RELAXED, __HIP_MEMORY_SCOPE_AGENT); }
__device__ __forceinline__ unsigned xb_add(unsigned* p, unsigned v) { return __hip_atomic_fetch_add(p, v, __ATOMIC_RELAXED, __HIP_MEMORY_SCOPE_AGENT); }
__device__ __forceinline__ unsigned xb_xcc_id() { return (unsigned)__builtin_amdgcn_s_getreg((3 << 11) | 20) & 0xFu; }
#define XB_SPIN(cond, bar) do { unsigned _sp = 0; while (cond) { __builtin_amdgcn_s_sleep(1); \
    if ((++_sp & 255u) == 0u) { if (xb_ld(&(bar)[XB_TMO])) break; if (_sp > XB_SPIN_CAP) { atomicAdd(&(bar)[XB_TMO], 1u); break; } } } } while (0)
struct XcdBarrier { unsigned* bar; unsigned x; volatile LDSP unsigned* st; };
__device__ __forceinline__ XcdBarrier xcd_barrier_post(unsigned* bar, volatile LDSP unsigned* st) {
    XcdBarrier b; b.bar = bar; b.x = xb_xcc_id(); b.st = st;
    if (threadIdx.x == 0) st[2] = xb_add(&bar[XB_XCNT(b.x)], 1u);
    return b;
}
__device__ __forceinline__ void xcd_barrier_complete(unsigned* bar, unsigned x, unsigned& nloc, unsigned& nx, unsigned& balanced) {
    const unsigned G = gridDim.x * gridDim.y * gridDim.z;
    unsigned sum, cnt, mine, sp = 0u;
    for (;;) {
        sum = 0u; cnt = 0u; mine = 0u;
#pragma unroll
        for (unsigned j = 0; j < 16; ++j) { const unsigned c = xb_ld(&bar[XB_XCNT(j)]); sum += c; cnt += (c > 0u) ? 1u : 0u; mine = (j == x) ? c : mine; }
        if (sum == G) break;
        __builtin_amdgcn_s_sleep(1);
        if ((++sp & 255u) == 0u) { if (xb_ld(&bar[XB_TMO])) break; if (sp > XB_SPIN_CAP) { atomicAdd(&bar[XB_TMO], 1u); break; } }
    }
    nloc = mine > 0u ? mine : 1u; nx = cnt > 0u ? cnt : 1u;
    unsigned ok = 1u;
#pragma unroll
    for (unsigned j = 0; j < 8; ++j) ok &= (xb_ld(&bar[XB_XCNT(j)]) == 64u) ? 1u : 0u;
    balanced = (ok && G == 512u) ? 1u : 0u;
}
__device__ __forceinline__ void xcd_barrier(const XcdBarrier& b) {
    asm volatile("s_waitcnt vmcnt(0)" ::: "memory");
    __syncthreads();
    if (threadIdx.x == 0) {
        unsigned* bar = b.bar;
        __builtin_amdgcn_s_waitcnt(0);
        unsigned nloc = b.st[0], nx = b.st[1];
        if (nloc == 0u) { unsigned bal; xcd_barrier_complete(bar, b.x, nloc, nx, bal); b.st[0] = nloc; b.st[1] = nx; b.st[3] = bal; }
        const unsigned old = xb_add(&bar[XB_XSUB(b.x)], 1u);
        const unsigned gen = old / nloc;
        if (old + 1u == (gen + 1u) * nloc) {
            __builtin_amdgcn_fence(__ATOMIC_RELEASE, "agent");
            asm volatile("s_waitcnt vmcnt(0)" ::: "memory");
            const unsigned og = xb_add(&bar[XB_TOP], 1u);
            const unsigned tg = og / nx;
            if (og + 1u == (tg + 1u) * nx) xb_add(&bar[XB_TOPGEN], 1u);
            else XB_SPIN(xb_ld(&bar[XB_TOPGEN]) == tg, bar);
            __builtin_amdgcn_fence(__ATOMIC_ACQUIRE, "agent");
            xb_add(&bar[XB_XGEN(b.x)], 1u);
            asm volatile("s_waitcnt vmcnt(0)" ::: "memory");
        } else {
            XB_SPIN(xb_ld(&bar[XB_XGEN(b.x)]) == gen, bar);
            __builtin_amdgcn_fence(__ATOMIC_ACQUIRE, "agent");
            asm volatile("s_waitcnt vmcnt(0)" ::: "memory");
        }
    }
    __syncthreads();
}

constexpr int NSUB = 13;
constexpr int NPHASE = 1 + 4 * NSUB;
static_assert(OFF_DF + (size_t)NCHUNK_MAX * 128 * 4 <= OFF_KF, "chunk record overlay overflow");
static_assert(WS_NEED <= (size_t)940 * 1024 * 1024, "workspace map exceeds the guaranteed workspace (sum of inputs = 946 MiB)");

__device__ __forceinline__ void run_phase(const Params& p, int ph, unsigned char* lds, bool dry) {
    unsigned char* ws = opaque_ptr(p.ws);
    if (ph == 0) { phase_prologue(p, (float*)lds); return; }
    const int layer = (ph - 1) / NSUB, pos = (ph - 1) % NSUB;
    const int sub = (pos < 2) ? pos : (pos == 2) ? 9 : (pos < 10) ? pos - 1 : pos;
    const bf16_t* Hb = (const bf16_t*)(ws + OFF_HB);
    switch (sub) {
    case 0: {
        const int wrow = (layer == 0) ? WIN_ROWS0 : (layer == 1) ? WIN_ROWS1 : (layer == 2) ? WIN_ROWS2 : WIN_ROWS3;
        const int nmain = (layer == 3) ? 3072 : 4096;
        if (layer > 0) skinny16_phase((const bf16_t*)(ws + OFF_WIN) + (size_t)(wrow + 3072) * 1024, Hb, (float*)(ws + OFF_PG), 16);
        gemm130_phase<true>((const bf16_t*)(ws + OFF_WIN) + (size_t)wrow * 1024, Hb, ws + OFF_P, PLD, nmain, 1024, lds, LnEpi{}, (layer == 1 || layer == 2) ? 3072 : (1 << 30));
    } break;
    case 1:
        if (layer == 0) scanA_phase<0>(p, (float*)lds); else if (layer == 1) scanA_phase<1>(p, (float*)lds);
        else if (layer == 2) scanA_phase<2>(p, (float*)lds); else scanA_phase<3>(p, (float*)lds);
        break;
    case 9:
#if PROBE_LITE
        if (dry) { if (layer == 0) seq_phase<0, true>(p, lds); else if (layer == 3) seq_phase<3, true>(p, lds); break; }
#endif
        if (layer == 0) seq_phase<0>(p, lds); else if (layer == 1) seq_phase<1>(p, lds);
        else if (layer == 2) seq_phase<2>(p, lds); else seq_phase<3>(p, lds);
        break;
    case 2:
        if (layer == 0) normgate_phase<0>(p); else if (layer == 1) normgate_phase<1>(p);
        else if (layer == 2) normgate_phase<2>(p); else normgate_phase<3>(p);
        break;
    case 3:
        if (gridDim.x >= 512 && !dry) {
            LnEpi le; le.H = (float*)(ws + OFF_H); le.Hb = (bf16_t*)(ws + OFF_HB); le.Hq = ws + OFF_HQ; le.g = p.in[35] + (size_t)(layer * 2) * 1024; le.b = p.in[36] + (size_t)(layer * 2) * 1024;
            le.xch = (unsigned long long*)(ws + OFF_XCH) + (size_t)layer * 128 * 4 * 144; le.cnt = (unsigned*)(ws + OFF_BAR) + XCD_BAR_WORDS + 2048 + layer * 128;
            gemm130_phase<false, true>((const bf16_t*)(ws + OFF_WOUT) + (size_t)layer * 1024 * 1024, (const bf16_t*)(ws + OFF_A2), nullptr, 1024, 1024, 1024, lds, le);
        } else gemm130_phase<false>((const bf16_t*)(ws + OFF_WOUT) + (size_t)layer * 1024 * 1024, (const bf16_t*)(ws + OFF_A2), ws + OFF_O, 1024, 1024, 1024, lds);
        break;
    case 4: if (gridDim.x < 512) ln_phase(p, layer, 0, dry); break;
    case 5:
        gemm130_phase<true>((const bf16_t*)(ws + OFF_WQ) + (size_t)layer * 2048 * 1024, Hb, ws + OFF_Q, 2048, 2048, 1024, lds);
        break;
    case 6: break;
    case 7: scoretopk_phase(p, layer, lds); break;
    case 8: gatherU_phase(p, layer, lds, dry ? 1 : 0); break;
    case 10: if (!dry) gatherW_phase(p, layer); break;
    case 11: gatherV_phase(p, layer, lds, dry ? 1 : 0); break;
    case 12: ln_phase(p, layer, 1, dry); break;
    }
}

__global__ void __launch_bounds__(NTH, 2) mega_kernel(Params p, int ph_lo, int ph_hi) {
    __shared__ __attribute__((aligned(16))) unsigned char lds[LDS_BYTES + 16];
    cg::grid_group grid = cg::this_grid();
    volatile LDSP unsigned* st = (volatile LDSP unsigned*)(lds + LDS_BYTES);
    if (threadIdx.x < 4) st[threadIdx.x] = 0u;
    __syncthreads();
    XcdBarrier xb = xcd_barrier_post((unsigned*)(p.ws + OFF_BAR), st);
    for (int ph = ph_lo; ph < ph_hi; ++ph) {
        if (ph > 0 && (ph - 1) % NSUB == 5 && gridDim.x >= 512) continue;
        if (ph > 0 && (ph - 1) % NSUB == 7) continue;
        int reps = 1;
#if PROBE_MASK
        if (ph > 0 && ((PROBE_MASK >> ((ph - 1) % NSUB)) & 1)) reps = 2;
        if (ph == 0 && (PROBE_MASK & 8192)) reps = 2;
#endif
        for (int rep = 0; rep < reps; ++rep) {
            if (rep) xcd_barrier(xb);
            run_phase(p, ph, lds, rep > 0);
        }
        if (ph + 1 < ph_hi) { if (ph == ph_lo) grid.sync(); else xcd_barrier(xb); }
#if PROBE_BARRIERS
        if (ph == 7) { for (int k_ = 0; k_ < PROBE_BARRIERS; ++k_) xcd_barrier(xb); }
#endif
    }
}

extern "C" void kernel_launch(void* const* d_in, const int* in_sizes, int n_in, void* d_out, int out_size, void* d_ws, size_t ws_size, hipStream_t stream) {
    static int grid_blocks = 0;
    if (!grid_blocks) {
        int dev = 0, cus = 0, per_cu = 0;
        hipGetDevice(&dev);
        hipDeviceGetAttribute(&cus, hipDeviceAttributeMultiprocessorCount, dev);
        hipOccupancyMaxActiveBlocksPerMultiprocessor(&per_cu, mega_kernel, NTH, 0);
        if (per_cu > 2) per_cu = 2;
        if (per_cu < 1) per_cu = 1;
        grid_blocks = cus * per_cu;
    }
    if (ws_size < WS_NEED) { fprintf(stderr, "workspace too small: %zu < %zu\n", ws_size, (size_t)WS_NEED); return; }
    if ((size_t)out_size != OUT_TOTAL) fprintf(stderr, "unexpected out_size %d vs %zu\n", out_size, (size_t)OUT_TOTAL);
    Params p{};
    for (int i = 0; i < 37; ++i) p.in[i] = (const float*)d_in[i];
    p.out = (float*)d_out;
    p.ws = (unsigned char*)d_ws;
#if SINGLE_LAUNCH
    hipMemsetAsync((unsigned char*)d_ws + OFF_BAR, 0, (XCD_BAR_WORDS + 2048 + 512) * 4, stream);
    int lo = 0, hi = NPHASE;
    void* args[] = {&p, &lo, &hi};
    hipError_t e = hipLaunchCooperativeKernel((void*)mega_kernel, dim3(grid_blocks), dim3(NTH), args, 0, stream);
    if (e != hipSuccess) fprintf(stderr, "cooperative launch failed: %s (grid %d)\n", hipGetErrorString(e), grid_blocks);
#else
    for (int ph = 0; ph < NPHASE; ++ph) mega_kernel<<<grid_blocks, NTH, 0, stream>>>(p, ph, ph + 1);
#endif
}
```

```cpp
#include <hip/hip_runtime.h>
#include <hip/hip_cooperative_groups.h>
#include <cstdio>
#include <cstdint>
namespace cg = cooperative_groups;

#ifndef OLD_PREPASS_MASK
#define OLD_PREPASS_MASK 0
#endif
#ifndef PROBE_BARRIERS
#define PROBE_BARRIERS 0
#endif
#ifndef PROBE_LITE
#define PROBE_LITE 0
#endif
#ifndef PROBE_MASK
#define PROBE_MASK 0
#endif
#ifndef SAMPLE_IN_SEQ
#define SAMPLE_IN_SEQ 1
#endif
#ifndef SINGLE_LAUNCH
#define SINGLE_LAUNCH 1
#endif

typedef unsigned short bf16_t;
typedef short bf16x8 __attribute__((ext_vector_type(8)));
typedef float f32x4 __attribute__((ext_vector_type(4)));
typedef __bf16 bf16x2 __attribute__((ext_vector_type(2)));
typedef short bf16x4 __attribute__((ext_vector_type(4)));
typedef unsigned u32x4 __attribute__((ext_vector_type(4)));
typedef unsigned u32x2 __attribute__((ext_vector_type(2)));
#define LDSP __attribute__((address_space(3)))

constexpr int D = 1024;
constexpr int NB_P = 8, T_P = 2064, NB_S = 128;
constexpr int ROWS_P = NB_P * T_P;
constexpr int MTOK = ROWS_P + NB_S;
constexpr int NSEQ = NB_P + NB_S;
constexpr int PLD = 4352;
constexpr int NEXP = 16384;
constexpr float DN_ALPHA = 1.6817928305074292f;
constexpr int NTH = 256;
constexpr int LDS_BYTES = 79872;

constexpr size_t al256(size_t x) { return (x + 255) & ~(size_t)255; }
constexpr int WIN_ROWS0 = 0, WIN_ROWS1 = 4096, WIN_ROWS2 = 4096 + 4352, WIN_ROWS3 = 4096 + 2 * 4352, WIN_ROWS = 4096 + 2 * 4352 + 3328;
constexpr size_t OFF_WIN = 0;
constexpr size_t OFF_WOUT = OFF_WIN + al256((size_t)WIN_ROWS * 1024 * 2);
constexpr size_t OFF_WQ = OFF_WOUT + al256((size_t)4 * 1024 * 1024 * 2);
constexpr size_t OFF_KEYS = OFF_WQ + al256((size_t)4 * 2048 * 1024 * 2);
constexpr size_t OFF_UB = OFF_KEYS + al256((size_t)4 * 2 * 128 * 128 * 2);
constexpr size_t OFF_VB = OFF_UB + al256((size_t)4 * NEXP * 1024);
constexpr size_t OFF_SU = OFF_VB + al256((size_t)4 * NEXP * 1024);
constexpr size_t OFF_SV = OFF_SU + al256((size_t)4 * NEXP * 4);
constexpr size_t OFF_LB = OFF_SV + al256((size_t)4 * NEXP * 4);
constexpr size_t OFF_H = OFF_LB + al256(1024 * 4);
constexpr size_t OFF_PG = OFF_H;
constexpr size_t OFF_HB = OFF_H + al256((size_t)MTOK * 1024 * 4);
constexpr size_t OFF_P = OFF_HB + al256((size_t)MTOK * 1024 * 2);
constexpr size_t OFF_Q = OFF_P;
constexpr size_t OFF_S1 = OFF_P + al256((size_t)MTOK * 2048 * 2);
constexpr size_t OFF_S2 = OFF_S1 + al256((size_t)128 * MTOK * 8 * 4);
constexpr size_t OFF_PD = OFF_P;
constexpr size_t OFF_F = OFF_P + al256((size_t)8 * MTOK * 128 * 4);
constexpr size_t OFF_DRY = OFF_F + al256((size_t)MTOK * 1024 * 4);
constexpr size_t OFF_O = OFF_P + al256((size_t)MTOK * PLD * 4);
constexpr size_t OFF_A2 = OFF_O + al256((size_t)MTOK * 1024 * 4);
constexpr size_t OFF_TI = OFF_A2 + al256((size_t)MTOK * 1024 * 2);
constexpr size_t OFF_TW = OFF_TI + al256((size_t)MTOK * 128 * 4);
constexpr int NCHUNK_MAX = 8 * 8 * 129;
constexpr size_t OFF_QF = OFF_A2;
constexpr size_t OFF_AF = OFF_QF + al256((size_t)NCHUNK_MAX * 2048 * 2);
constexpr size_t OFF_DF = OFF_AF + al256((size_t)NCHUNK_MAX * 256 * 4);
constexpr size_t OFF_KF = OFF_TW + al256((size_t)MTOK * 128 * 4);
constexpr size_t OFF_WF = OFF_KF + al256((size_t)NCHUNK_MAX * 2048 * 2);
constexpr size_t OFF_VF = OFF_WF + al256((size_t)NCHUNK_MAX * 2048 * 2);
constexpr size_t OFF_DEN = OFF_VF + al256((size_t)NCHUNK_MAX * 2048 * 4);
constexpr size_t OFF_MT = OFF_DEN + al256((size_t)MTOK * 8 * 4);
constexpr size_t OFF_BAR = OFF_MT + al256((size_t)MTOK * 8 * 4);
constexpr size_t OFF_XCH = OFF_BAR + al256((3456 + 2048 + 512) * 4);
constexpr size_t OFF_HQ = OFF_XCH + al256((size_t)4 * 128 * 4 * 144 * 8);
constexpr size_t WS_NEED = OFF_HQ + al256((size_t)MTOK * 1024);
static_assert(OFF_S2 + (size_t)128 * MTOK * 8 * 4 <= OFF_O, "alias overflow");
static_assert(OFF_DRY + (size_t)MTOK * 1024 * 6 <= OFF_O, "alias overflow");

constexpr size_t OUT_YP = 0;
constexpr size_t OUT_YS = OUT_YP + (size_t)8 * 2048 * 1024;
constexpr size_t OUT_P_HGRN = OUT_YS + (size_t)128 * 1024;
constexpr size_t OUT_P_GDN = OUT_P_HGRN + (size_t)8 * 8 * 128 * 128;
constexpr size_t OUT_P_CONV = OUT_P_GDN + (size_t)8 * 8 * 128 * 128;
constexpr size_t OUT_P_MC = OUT_P_CONV + (size_t)8 * 3 * 3072;
constexpr size_t OUT_P_MN = OUT_P_MC + (size_t)8 * 8 * 128 * 128;
constexpr size_t OUT_P_MM = OUT_P_MN + (size_t)8 * 8 * 128;
constexpr size_t OUT_P_GLA = OUT_P_MM + (size_t)8 * 8;
constexpr size_t OUT_S_HGRN = OUT_P_GLA + (size_t)8 * 4 * 128 * 256;
constexpr size_t OUT_S_GDN = OUT_S_HGRN + (size_t)128 * 8 * 128 * 128;
constexpr size_t OUT_S_CONV = OUT_S_GDN + (size_t)128 * 8 * 128 * 128;
constexpr size_t OUT_S_MC = OUT_S_CONV + (size_t)128 * 3 * 3072;
constexpr size_t OUT_S_MN = OUT_S_MC + (size_t)128 * 8 * 128 * 128;
constexpr size_t OUT_S_MM = OUT_S_MN + (size_t)128 * 8 * 128;
constexpr size_t OUT_S_GLA = OUT_S_MM + (size_t)128 * 8;
constexpr size_t OUT_TOTAL = OUT_S_GLA + (size_t)128 * 4 * 128 * 256;

struct Params {
    const float* in[37];
    float* out;
    unsigned char* ws;
};

typedef float f32x2 __attribute__((ext_vector_type(2)));
__device__ __forceinline__ unsigned cvt_pk_bf16(float lo, float hi) { const f32x2 v = {lo, hi}; return __builtin_bit_cast(unsigned, __builtin_convertvector(v, bf16x2)); }
__device__ __forceinline__ bf16_t f2bf(float f) { return (bf16_t)(cvt_pk_bf16(f, f) & 0xffffu); }
__device__ __forceinline__ float bf2f(bf16_t h) { return __uint_as_float(((unsigned)h) << 16); }
__device__ __forceinline__ unsigned pack2bf(float lo, float hi) { return cvt_pk_bf16(lo, hi); }
__device__ __forceinline__ float sigmoidf_(float x) { return __builtin_amdgcn_rcpf(1.0f + __expf(-x)); }
__device__ __forceinline__ float siluf_(float x) { return x * __builtin_amdgcn_rcpf(1.0f + __expf(-x)); }
__device__ __forceinline__ float softplusf_(float x) { return fmaxf(x, 0.f) + __logf(1.f + __expf(-fabsf(x))); }
__device__ __forceinline__ float logsigmoidf_(float x) { return -softplusf_(-x); }
__device__ __forceinline__ float wave_sum(float v) {
    v += __shfl_xor(v, 32); v += __shfl_xor(v, 16); v += __shfl_xor(v, 8); v += __shfl_xor(v, 4); v += __shfl_xor(v, 2); v += __shfl_xor(v, 1); return v;
}

__device__ __forceinline__ float dpp_max(float v, int ctrl_sel) {
    const int x = __builtin_bit_cast(int, v);
    int y;
    if (ctrl_sel == 0) y = __builtin_amdgcn_update_dpp(0, x, 0xB1, 0xF, 0xF, true);
    else if (ctrl_sel == 1) y = __builtin_amdgcn_update_dpp(0, x, 0x4E, 0xF, 0xF, true);
    else if (ctrl_sel == 2) y = __builtin_amdgcn_update_dpp(0, x, 0x141, 0xF, 0xF, true);
    else y = __builtin_amdgcn_update_dpp(0, x, 0x140, 0xF, 0xF, true);
    return fmaxf(v, __builtin_bit_cast(float, y));
}
__device__ __forceinline__ float wave_max_u(float v) {
    v = dpp_max(v, 0); v = dpp_max(v, 1); v = dpp_max(v, 2); v = dpp_max(v, 3);
    const int x = __builtin_bit_cast(int, v);
    const float a = __builtin_bit_cast(float, __builtin_amdgcn_readlane(x, 0)), b = __builtin_bit_cast(float, __builtin_amdgcn_readlane(x, 16));
    const float c = __builtin_bit_cast(float, __builtin_amdgcn_readlane(x, 32)), d = __builtin_bit_cast(float, __builtin_amdgcn_readlane(x, 48));
    return fmaxf(fmaxf(a, b), fmaxf(c, d));
}
__device__ __forceinline__ f32x2 ldbf2(const bf16_t* a) { const unsigned w = *(const unsigned*)a; return (f32x2){__uint_as_float(w << 16), __uint_as_float(w & 0xffff0000u)}; }
__device__ __forceinline__ f32x4 ldbf4(const bf16_t* a) { const u32x2 w = *(const u32x2*)a; return (f32x4){__uint_as_float(w.x << 16), __uint_as_float(w.x & 0xffff0000u), __uint_as_float(w.y << 16), __uint_as_float(w.y & 0xffff0000u)}; }
constexpr float XQ_SCALE = 8.0f / 127.0f;
__device__ __forceinline__ unsigned pack_i8x4(float a, float b, float c, float d) {
    const int ia = (int)rintf(fminf(fmaxf(a, -127.f), 127.f)), ib = (int)rintf(fminf(fmaxf(b, -127.f), 127.f));
    const int ic = (int)rintf(fminf(fmaxf(c, -127.f), 127.f)), id = (int)rintf(fminf(fmaxf(d, -127.f), 127.f));
    return (unsigned)(ia & 255) | ((unsigned)(ib & 255) << 8) | ((unsigned)(ic & 255) << 16) | ((unsigned)(id & 255) << 24);
}
__device__ __forceinline__ int opaque_tid() { int t = threadIdx.x; asm volatile("" : "+v"(t)); return t; }
__device__ __forceinline__ unsigned char* opaque_ptr(unsigned char* q) {
    unsigned lo = __builtin_amdgcn_readfirstlane((unsigned)(uintptr_t)q), hi = __builtin_amdgcn_readfirstlane((unsigned)((uintptr_t)q >> 32));
    asm volatile("" : "+s"(lo), "+s"(hi));
    typedef __attribute__((address_space(1))) unsigned char* gptr_t;
    return (unsigned char*)(gptr_t)(((uintptr_t)hi << 32) | (uintptr_t)lo);
}

__device__ __forceinline__ void transpose_convert(const float* __restrict__ W, int nraw, int npad, bf16_t* __restrict__ Wt, float* lds, int base) {
    const int TID = opaque_tid();
    const int tiles_n = npad / 64, tiles = tiles_n * 16, G = gridDim.x;
    const int tx = TID & 63, ty = TID >> 6;
    int tile = ((int)blockIdx.x - base % G + G) % G, buf = 0;
    float v[16];
    if (tile < tiles) {
        const int n = (tile % tiles_n) * 64 + tx, k0 = (tile / tiles_n) * 64;
#pragma unroll
        for (int i = 0; i < 16; ++i) v[i] = (n < nraw) ? W[(size_t)(k0 + ty + 4 * i) * nraw + n] : 0.f;
    }
    for (; tile < tiles; tile += G) {
        float* L = lds + buf * (64 * 65);
#pragma unroll
        for (int i = 0; i < 16; ++i) L[(ty + 4 * i) * 65 + tx] = v[i];
        __syncthreads();
        if (tile + G < tiles) {
            const int n = ((tile + G) % tiles_n) * 64 + tx, k0 = ((tile + G) / tiles_n) * 64;
#pragma unroll
            for (int i = 0; i < 16; ++i) v[i] = (n < nraw) ? W[(size_t)(k0 + ty + 4 * i) * nraw + n] : 0.f;
        }
        bf16_t* dst = Wt + (size_t)((tile % tiles_n) * 64) * 1024 + (tile / tiles_n) * 64;
#pragma unroll
        for (int i = 0; i < 16; ++i) { const int r = ty + 4 * i; dst[(size_t)r * 1024 + tx] = f2bf(L[tx * 65 + r]); }
        buf ^= 1;
    }
    __syncthreads();
}

__device__ __forceinline__ void convert_bf16(const float* __restrict__ src, bf16_t* __restrict__ dst, size_t n) {
    const int TID = opaque_tid();
    const size_t n8 = n / 8;
    for (size_t i = (size_t)blockIdx.x * NTH + TID; i < n8; i += (size_t)gridDim.x * NTH) {
        const f32x4 a = *(const f32x4*)(src + i * 8), b = *(const f32x4*)(src + i * 8 + 4);
        uint4 w; w.x = pack2bf(a[0], a[1]); w.y = pack2bf(a[2], a[3]); w.z = pack2bf(b[0], b[1]); w.w = pack2bf(b[2], b[3]);
        *(uint4*)(dst + i * 8) = w;
    }
}

template <bool AS_INT8>
__device__ __forceinline__ void convert_fp8_rows(const float* __restrict__ src, unsigned char* __restrict__ dst, float* __restrict__ scales, int row_lo, int row_hi, int wrank, int nwaves, int lane) {
    for (int row = row_lo + wrank; row < row_hi; row += 4 * nwaves) {
        f32x4 v[4][4];
#pragma unroll
        for (int u = 0; u < 4; ++u) {
            const int rr = (row + u * nwaves < row_hi) ? row + u * nwaves : row;
            const float* r = src + (size_t)rr * 1024 + lane * 16;
#pragma unroll
            for (int j = 0; j < 4; ++j) v[u][j] = *(const f32x4*)(r + j * 4);
        }
#pragma unroll
        for (int u = 0; u < 4; ++u) {
            const int rr = row + u * nwaves;
            float m = 0.f;
#pragma unroll
            for (int j = 0; j < 4; ++j) m = fmaxf(m, fmaxf(fmaxf(fabsf(v[u][j][0]), fabsf(v[u][j][1])), fmaxf(fabsf(v[u][j][2]), fabsf(v[u][j][3]))));
            m = wave_max_u(m);
            const float sc = (m > 0.f) ? m * (AS_INT8 ? (1.f / 127.f) : (1.f / 448.f)) : 1.f, inv = 1.f / sc;
            u32x4 w;
#pragma unroll
            for (int j = 0; j < 4; ++j) {
                if (AS_INT8) w[j] = pack_i8x4(v[u][j][0] * inv, v[u][j][1] * inv, v[u][j][2] * inv, v[u][j][3] * inv);
                else { int t = 0; t = __builtin_amdgcn_cvt_pk_fp8_f32(v[u][j][0] * inv, v[u][j][1] * inv, t, false); t = __builtin_amdgcn_cvt_pk_fp8_f32(v[u][j][2] * inv, v[u][j][3] * inv, t, true); w[j] = (unsigned)t; }
            }
            if (rr < row_hi) {
                *(u32x4*)(dst + ((size_t)((rr / NEXP) * 8 + (lane >> 3)) * NEXP + (rr % NEXP)) * 128 + (lane & 7) * 16) = w;
                if (lane == 0) scales[rr] = sc;
            }
        }
    }
}

__device__ __forceinline__ void phase_prologue(const Params& p, float* lds) {
    const int TID = opaque_tid();
    unsigned char* ws = opaque_ptr(p.ws);
    bf16_t* win = (bf16_t*)(ws + OFF_WIN);
    transpose_convert(p.in[10], 4096, 4096, win + (size_t)WIN_ROWS0 * 1024, lds, 0);
    transpose_convert(p.in[14], 4112, 4352, win + (size_t)WIN_ROWS1 * 1024, lds, 1024);
    transpose_convert(p.in[20], 4112, 4352, win + (size_t)WIN_ROWS2 * 1024, lds, 2112);
    transpose_convert(p.in[25], 3088, 3328, win + (size_t)WIN_ROWS3 * 1024, lds, 3200);
    bf16_t* wout = (bf16_t*)(ws + OFF_WOUT);
    transpose_convert(p.in[13], 1024, 1024, wout + (size_t)0 * 1024 * 1024, lds, 4032);
    transpose_convert(p.in[19], 1024, 1024, wout + (size_t)1 * 1024 * 1024, lds, 4288);
    transpose_convert(p.in[24], 1024, 1024, wout + (size_t)2 * 1024 * 1024, lds, 4544);
    transpose_convert(p.in[29], 1024, 1024, wout + (size_t)3 * 1024 * 1024, lds, 4800);
    bf16_t* wq = (bf16_t*)(ws + OFF_WQ);
    for (int l = 0; l < 4; ++l) transpose_convert(p.in[30] + (size_t)l * 1024 * 2048, 2048, 2048, wq + (size_t)l * 2048 * 1024, lds, 5056 + l * 512);
    bf16_t* keys = (bf16_t*)(ws + OFF_KEYS);
    for (int l = 0; l < 4; ++l) {
        convert_bf16(p.in[31] + (size_t)l * 16384, keys + (size_t)(l * 2 + 0) * 16384, 16384);
        convert_bf16(p.in[32] + (size_t)l * 16384, keys + (size_t)(l * 2 + 1) * 16384, 16384);
    }
    float* lb = (float*)(ws + OFF_LB);
    for (int c = blockIdx.x * NTH + TID; c < 1024; c += gridDim.x * NTH) {
        const float* L = p.in[11];
        float mx = L[c];
        for (int j = 1; j < 5; ++j) mx = fmaxf(mx, L[j * 1024 + c]);
        float s = 0.f;
        for (int j = 0; j < 5; ++j) s += expf(L[j * 1024 + c] - mx);
        lb[c] = expf(L[c] - mx) / s;
    }
    bf16_t* Hb = (bf16_t*)(ws + OFF_HB);
    const size_t nvec = (size_t)MTOK * 256;
    for (size_t i = (size_t)blockIdx.x * NTH + TID; i < nvec; i += (size_t)gridDim.x * NTH) {
        const int row = (int)(i >> 8), c4 = (int)(i & 255) * 4;
        const float* src;
        if (row < ROWS_P) { const int b = row / T_P, t = row % T_P; src = (t < 16) ? p.in[9] + (size_t)t * 1024 : p.in[0] + ((size_t)b * 2048 + (t - 16)) * 1024; }
        else src = p.in[1] + (size_t)(row - ROWS_P) * 1024;
        const f32x4 v = *(const f32x4*)(src + c4);
        uint2 w; w.x = pack2bf(v[0], v[1]); w.y = pack2bf(v[2], v[3]);
        *(uint2*)(Hb + (size_t)row * 1024 + c4) = w;
    }
}

#define GEMM_WAIT(n) asm volatile("s_waitcnt vmcnt(" #n ")" ::: "memory")
template <bool OUT_BF16, bool TILED = false, bool DUAL = false>
__device__ __forceinline__ void gemm_phase(const bf16_t* __restrict__ A, int lda, const bf16_t* __restrict__ Bt, int ldb, void* __restrict__ Cv0, int ldc,
                           int M, int N, int K, unsigned char* lds, size_t a2 = 0, size_t b2 = 0, size_t c2 = 0) {
    const int TID = opaque_tid();
    constexpr int BMA = 256, BNB = 128, BK = 32, STG = 24576;
    const int tid = TID, wid = tid >> 6, lane = tid & 63, wr = wid >> 1, wc = wid & 1, fr = lane & 15, fq = lane >> 4;
    const int tn = N / BNB, tiles = (M / BMA) * tn * (DUAL ? 2 : 1), nk = K / BK;
    const int sr = tid >> 2, scc = (((tid & 3) ^ ((0 - (tid >> 4)) & 3)) * 8);
    const int rsw = (0 - (fr >> 2)) & 3;
    const int aoff = (wr * 128 + fr) * 64 + ((fq ^ rsw) * 16), boff = 16384 + (wc * 64 + fr) * 64 + ((fq ^ rsw) * 16);
    for (int tile_ = blockIdx.x; tile_ < tiles; tile_ += gridDim.x) {
        const int half = DUAL ? (tile_ & 1) : 0, tile = DUAL ? (tile_ >> 1) : tile_;
        void* Cv = (unsigned char*)Cv0 + (size_t)half * c2;
        const int brow = (tile / tn) * BMA, bcol = (tile % tn) * BNB;
        f32x4 acc[8][4];
#pragma unroll
        for (int m = 0; m < 8; ++m)
#pragma unroll
            for (int n = 0; n < 4; ++n) acc[m][n] = (f32x4){0.f, 0.f, 0.f, 0.f};
        const bf16_t* ga = A + (size_t)half * a2 + (size_t)(brow + sr) * lda + scc;
        const bf16_t* gb = Bt + (size_t)half * b2 + (size_t)(bcol + sr) * ldb + scc;
#define GEMM_STAGE(kt_) do { unsigned char* sb_ = lds + ((kt_) % 3) * STG + tid * 16; \
            __builtin_amdgcn_global_load_lds((const unsigned*)(ga + (kt_) * BK), (LDSP unsigned*)(sb_), 16, 0, 0); \
            __builtin_amdgcn_global_load_lds((const unsigned*)(ga + (size_t)64 * lda + (kt_) * BK), (LDSP unsigned*)(sb_ + 4096), 16, 0, 0); \
            __builtin_amdgcn_global_load_lds((const unsigned*)(ga + (size_t)128 * lda + (kt_) * BK), (LDSP unsigned*)(sb_ + 8192), 16, 0, 0); \
            __builtin_amdgcn_global_load_lds((const unsigned*)(ga + (size_t)192 * lda + (kt_) * BK), (LDSP unsigned*)(sb_ + 12288), 16, 0, 0); \
            __builtin_amdgcn_global_load_lds((const unsigned*)(gb + (kt_) * BK), (LDSP unsigned*)(sb_ + 16384), 16, 0, 0); \
            __builtin_amdgcn_global_load_lds((const unsigned*)(gb + (size_t)64 * ldb + (kt_) * BK), (LDSP unsigned*)(sb_ + 20480), 16, 0, 0); } while (0)
        asm volatile("s_waitcnt lgkmcnt(0)" ::: "memory"); __builtin_amdgcn_s_barrier();
        GEMM_STAGE(0);
        if (nk > 1) GEMM_STAGE(1);
        for (int kt = 0; kt < nk; ++kt) {
            if (kt + 1 < nk) GEMM_WAIT(6); else GEMM_WAIT(0);
            asm volatile("s_waitcnt lgkmcnt(0)" ::: "memory"); __builtin_amdgcn_s_barrier();
            if (kt + 2 < nk) GEMM_STAGE(kt + 2);
            const unsigned char* st = lds + (kt % 3) * STG;
            bf16x8 At[8], Bl[4];
#pragma unroll
            for (int n = 0; n < 4; ++n) Bl[n] = *(const bf16x8*)(st + boff + n * 1024);
#pragma unroll
            for (int m = 0; m < 8; ++m) At[m] = *(const bf16x8*)(st + aoff + m * 1024);
#pragma unroll
            for (int m = 0; m < 8; ++m)
#pragma unroll
                for (int n = 0; n < 4; ++n) acc[m][n] = __builtin_amdgcn_mfma_f32_16x16x32_bf16(At[m], Bl[n], acc[m][n], 0, 0, 0);
        }
#undef GEMM_STAGE
#pragma unroll
        for (int n = 0; n < 4; ++n) {
            const size_t base = TILED ? (size_t)(brow + wr * 128) * N + (size_t)(bcol + wc * 64 + n * 16 + fr) * 128 + fq * 4
                                      : (size_t)(bcol + wc * 64 + n * 16 + fr) * ldc + brow + wr * 128 + fq * 4;
#pragma unroll
            for (int m = 0; m < 8; ++m) {
                if (OUT_BF16) { uint2 w; w.x = pack2bf(acc[m][n][0], acc[m][n][1]); w.y = pack2bf(acc[m][n][2], acc[m][n][3]); *(uint2*)((bf16_t*)Cv + base + m * 16) = w; }
                else *(f32x4*)((float*)Cv + base + m * 16) = acc[m][n];
            }
        }
    }
    asm volatile("s_waitcnt vmcnt(0) lgkmcnt(0)" ::: "memory");
    __syncthreads();
}

struct LnEpi { float* H; bf16_t* Hb; unsigned char* Hq; const float* g; const float* b; unsigned long long* xch; unsigned* cnt; };
template <bool OUT_BF16, bool EPI_LN = false>
__device__ __forceinline__ void gemm130_phase(const bf16_t* __restrict__ W, const bf16_t* __restrict__ X, void* __restrict__ Cv, int ldc, int NF, int K, unsigned char* lds, LnEpi le = LnEpi{}, int gap_at = 1 << 30) {
    const int TID = opaque_tid();
    constexpr int BK = 32, STG = 25600;
    const int tid = TID, wid = __builtin_amdgcn_readfirstlane(tid >> 6), lane = tid & 63, fr = lane & 15, fq = lane >> 4;
    const int tiles = (NF / 256) * 128, nk = K / BK;
    const int sr = tid >> 2, scc = (((tid & 3) ^ ((0 - (tid >> 4)) & 3)) * 8);
    const int rsw = (0 - (fr >> 2)) & 3;
    const int aoff = (wid * 64 + fr) * 64 + ((fq ^ rsw) * 16), boff = 16384 + fr * 64 + ((fq ^ rsw) * 16);
    for (int tile = blockIdx.x; tile < tiles; tile += gridDim.x) {
        const int brow0 = (tile >> 7) * 256, brow = brow0 + ((brow0 >= gap_at) ? 16 : 0), tok0 = (tile & 127) * 130;
        f32x4 acc[4][9];
#pragma unroll
        for (int m = 0; m < 4; ++m)
#pragma unroll
            for (int n = 0; n < 9; ++n) acc[m][n] = (f32x4){0.f, 0.f, 0.f, 0.f};
        const bf16_t* ga = W + (size_t)(brow + sr) * K + scc;
        const bf16_t* gb0 = X + (size_t)(tok0 + sr) * K + scc;
        const bf16_t* gb1 = X + (size_t)(tok0 + 64 + sr) * K + scc;
        const int r2 = 128 + sr; const bf16_t* gb2 = X + (size_t)(tok0 + (r2 < 130 ? r2 : 129)) * K + scc;
#define G130_STAGE(kt_) do { unsigned char* sb_ = lds + ((kt_) % 3) * STG + tid * 16; \
            __builtin_amdgcn_global_load_lds((const unsigned*)(ga + (kt_) * BK), (LDSP unsigned*)(sb_), 16, 0, 0); \
            __builtin_amdgcn_global_load_lds((const unsigned*)(ga + (size_t)64 * K + (kt_) * BK), (LDSP unsigned*)(sb_ + 4096), 16, 0, 0); \
            __builtin_amdgcn_global_load_lds((const unsigned*)(ga + (size_t)128 * K + (kt_) * BK), (LDSP unsigned*)(sb_ + 8192), 16, 0, 0); \
            __builtin_amdgcn_global_load_lds((const unsigned*)(ga + (size_t)192 * K + (kt_) * BK), (LDSP unsigned*)(sb_ + 12288), 16, 0, 0); \
            __builtin_amdgcn_global_load_lds((const unsigned*)(gb0 + (kt_) * BK), (LDSP unsigned*)(sb_ + 16384), 16, 0, 0); \
            __builtin_amdgcn_global_load_lds((const unsigned*)(gb1 + (kt_) * BK), (LDSP unsigned*)(sb_ + 20480), 16, 0, 0); \
            if (wid == 0) __builtin_amdgcn_global_load_lds((const unsigned*)(gb2 + (kt_) * BK), (LDSP unsigned*)(sb_ + 24576), 16, 0, 0); } while (0)
        asm volatile("s_waitcnt lgkmcnt(0)" ::: "memory"); __builtin_amdgcn_s_barrier();
        G130_STAGE(0);
        if (nk > 1) G130_STAGE(1);
#pragma unroll 1
        for (int kt = 0; kt < nk; ++kt) {
            if (kt + 1 < nk) { if (wid == 0) GEMM_WAIT(7); else GEMM_WAIT(6); } else GEMM_WAIT(0);
            asm volatile("s_waitcnt lgkmcnt(0)" ::: "memory"); __builtin_amdgcn_s_barrier();
            if (kt + 2 < nk) G130_STAGE(kt + 2);
            const unsigned char* st = lds + (kt % 3) * STG;
            bf16x8 At[4];
#pragma unroll
            for (int m = 0; m < 4; ++m) At[m] = *(const bf16x8*)(st + aoff + m * 1024);
            __builtin_amdgcn_s_setprio(1);
#pragma unroll
            for (int n = 0; n < 9; ++n) {
                const bf16x8 Bl = *(const bf16x8*)(st + boff + n * 1024);
#pragma unroll
                for (int m = 0; m < 4; ++m) acc[m][n] = __builtin_amdgcn_mfma_f32_16x16x32_bf16(At[m], Bl, acc[m][n], 0, 0, 0);
            }
            __builtin_amdgcn_s_setprio(0);
        }
#undef G130_STAGE
        if (EPI_LN) {
            const int tt = tile & 127, ft = tile >> 7;
            float* stat = (float*)lds;
            __syncthreads();
#pragma unroll
            for (int n = 0; n < 9; ++n) {
                const bool ok = (n < 8) || (fr < 2);
                const size_t base = (size_t)(tok0 + (ok ? n * 16 + fr : 0)) * 1024 + brow + wid * 64 + fq * 4;
                float a1 = 0.f, a2 = 0.f;
#pragma unroll
                for (int m = 0; m < 4; ++m) {
                    const u32x2 hw_ = *(const u32x2*)(le.Hb + base + m * 16);
                    const f32x4 hv = (f32x4){__uint_as_float(hw_.x << 16), __uint_as_float(hw_.x & 0xffff0000u), __uint_as_float(hw_.y << 16), __uint_as_float(hw_.y & 0xffff0000u)};
                    acc[m][n] = acc[m][n] + hv * DN_ALPHA;
                    a1 += (acc[m][n][0] + acc[m][n][1]) + (acc[m][n][2] + acc[m][n][3]);
                    a2 += (acc[m][n][0] * acc[m][n][0] + acc[m][n][1] * acc[m][n][1]) + (acc[m][n][2] * acc[m][n][2] + acc[m][n][3] * acc[m][n][3]);
                }
                a1 += __shfl_xor(a1, 16); a1 += __shfl_xor(a1, 32); a2 += __shfl_xor(a2, 16); a2 += __shfl_xor(a2, 32);
                if (fq == 0) { stat[(wid * 144 + n * 16 + fr) * 2] = a1; stat[(wid * 144 + n * 16 + fr) * 2 + 1] = a2; }
                asm volatile("" ::: "memory");
            }
            __syncthreads();
            unsigned long long* slot = le.xch + ((size_t)tt * 4) * 144;
            if (tid < 144) {
                const float p1 = (stat[tid * 2] + stat[(144 + tid) * 2]) + (stat[(288 + tid) * 2] + stat[(432 + tid) * 2]);
                const float p2 = (stat[tid * 2 + 1] + stat[(144 + tid) * 2 + 1]) + (stat[(288 + tid) * 2 + 1] + stat[(432 + tid) * 2 + 1]);
                __hip_atomic_store(slot + (size_t)ft * 144 + tid, ((unsigned long long)__float_as_uint(p2) << 32) | __float_as_uint(p1), __ATOMIC_RELAXED, __HIP_MEMORY_SCOPE_AGENT);
            }
            asm volatile("s_waitcnt vmcnt(0)" ::: "memory");
            __syncthreads();
            if (tid == 0) {
                __hip_atomic_fetch_add(le.cnt + tt, 1u, __ATOMIC_RELAXED, __HIP_MEMORY_SCOPE_AGENT);
                unsigned sp = 0;
                while (__hip_atomic_load(le.cnt + tt, __ATOMIC_RELAXED, __HIP_MEMORY_SCOPE_AGENT) < 4u) { __builtin_amdgcn_s_sleep(1); if (++sp > (1u << 22)) break; }
                __builtin_amdgcn_fence(__ATOMIC_ACQUIRE, "agent");
                asm volatile("s_waitcnt vmcnt(0)" ::: "memory");
            }
            __syncthreads();
            float* mr = stat + 1152;
            if (tid < 144) {
                float t1 = 0.f, t2 = 0.f;
#pragma unroll
                for (int f = 0; f < 4; ++f) { const unsigned long long w = __hip_atomic_load(slot + (size_t)f * 144 + tid, __ATOMIC_RELAXED, __HIP_MEMORY_SCOPE_AGENT); t1 += __uint_as_float((unsigned)w); t2 += __uint_as_float((unsigned)(w >> 32)); }
                const float mean = t1 * (1.f / 1024.f), var = t2 * (1.f / 1024.f) - mean * mean;
                mr[tid * 2] = mean; mr[tid * 2 + 1] = rsqrtf(fmaxf(var, 0.f) + 1e-5f);
            }
            __syncthreads();
#pragma unroll
            for (int n = 0; n < 9; ++n) {
                const bool ok = (n < 8) || (fr < 2);
                const size_t base = (size_t)(tok0 + (ok ? n * 16 + fr : 0)) * 1024 + brow + wid * 64 + fq * 4;
                const float mean = mr[(n * 16 + fr) * 2], rs = mr[(n * 16 + fr) * 2 + 1];
#pragma unroll
                for (int m = 0; m < 4; ++m) {
                    const f32x4 gvm = *(const f32x4*)(le.g + brow + wid * 64 + m * 16 + fq * 4), bvm = *(const f32x4*)(le.b + brow + wid * 64 + m * 16 + fq * 4);
                    const f32x4 o = (acc[m][n] - mean) * rs * gvm + bvm;
                    if (ok) { u32x2 w; w.x = cvt_pk_bf16(o[0], o[1]); w.y = cvt_pk_bf16(o[2], o[3]); *(u32x2*)(le.Hb + base + m * 16) = w;
                              *(unsigned*)(le.Hq + base + m * 16) = pack_i8x4(o[0] * (1.f / XQ_SCALE), o[1] * (1.f / XQ_SCALE), o[2] * (1.f / XQ_SCALE), o[3] * (1.f / XQ_SCALE)); }
                }
                asm volatile("" ::: "memory");
            }
        } else
#pragma unroll
        for (int n = 0; n < 9; ++n) {
            const bool ok = (n < 8) || (fr < 2);
            const size_t base = (size_t)(tok0 + (ok ? n * 16 + fr : 0)) * ldc + brow + wid * 64 + fq * 4;
#pragma unroll
            for (int m = 0; m < 4; ++m) {
                const f32x4 v = acc[m][n];
                if (OUT_BF16) { u32x2 w; w.x = cvt_pk_bf16(v[0], v[1]); w.y = cvt_pk_bf16(v[2], v[3]); if (ok) *(u32x2*)((bf16_t*)Cv + base + m * 16) = w; }
                else { if (ok) *(f32x4*)((float*)Cv + base + m * 16) = v; }
            }
            asm volatile("" ::: "memory");
        }
    }
    asm volatile("s_waitcnt vmcnt(0) lgkmcnt(0)" ::: "memory");
    __syncthreads();
}

__device__ __forceinline__ void skinny16_phase(const bf16_t* __restrict__ W16, const bf16_t* __restrict__ X, float* __restrict__ C, int ldc) {
    const int TID = opaque_tid();
    const int wave = TID >> 6, lane = TID & 63, q = lane >> 4, c = lane & 15;
    for (int t = blockIdx.x + wave * gridDim.x; t < MTOK / 16; t += gridDim.x * 4) {
        const bf16_t* wa = W16 + (size_t)c * 1024 + q * 8;
        const bf16_t* xb = X + (size_t)(t * 16 + c) * 1024 + q * 8;
        f32x4 acc0 = (f32x4){0.f, 0.f, 0.f, 0.f}, acc1 = (f32x4){0.f, 0.f, 0.f, 0.f};
#pragma unroll 1
        for (int k0 = 0; k0 < 1024; k0 += 512) {
            bf16x8 a[16], b[16];
#pragma unroll
            for (int j = 0; j < 16; ++j) { a[j] = *(const bf16x8*)(wa + k0 + j * 32); b[j] = *(const bf16x8*)(xb + k0 + j * 32); }
#pragma unroll
            for (int j = 0; j < 16; j += 2) {
                acc0 = __builtin_amdgcn_mfma_f32_16x16x32_bf16(a[j], b[j], acc0, 0, 0, 0);
                acc1 = __builtin_amdgcn_mfma_f32_16x16x32_bf16(a[j + 1], b[j + 1], acc1, 0, 0, 0);
            }
        }
        *(f32x4*)(C + (size_t)(t * 16 + c) * ldc + 4 * q) = acc0 + acc1;
    }
}

constexpr int NCH = 129;
constexpr int QS = 132;
__device__ __forceinline__ f32x4 mfma16(bf16x4 a, bf16x4 b, f32x4 c, int, int, int) {
    const bf16x8 a8 = {a[0], a[1], a[2], a[3], 0, 0, 0, 0}, b8 = {b[0], b[1], b[2], b[3], 0, 0, 0, 0};
    return __builtin_amdgcn_mfma_f32_16x16x32_bf16(a8, b8, c, 0, 0, 0);
}
__device__ __forceinline__ int qf_index(int t, int k) { const int m = k >> 5, kk = k & 31, half = kk >> 4, rem = kk & 15, q = rem >> 2, j = (rem & 3) + 4 * half; return (m * 64 + q * 16 + t) * 8 + j; }
__device__ __forceinline__ int kf_index(int t, int k) { return (((t >> 2) * 16 + (k & 15)) * 8 + (k >> 4)) * 4 + (t & 3); }
__device__ __forceinline__ int af_index(int t, int s_) { return ((s_ >> 2) * 16 + t) * 4 + (s_ & 3); }
__device__ __forceinline__ int vf_index(int t, int v) { return ((v >> 4) * 64 + (t >> 2) * 16 + (v & 15)) * 4 + (t & 3); }

template <int MIX>
__device__ __forceinline__ void stage_qk(const Params& p, const float* __restrict__ P, const float* __restrict__ lbv, float* qs, float* ks, float* fs, float* sc,
                                         int tid, int h, int row0, int t0, int nt, bool has_init, int sseq) {
    const int tt = tid >> 4, d0 = (tid & 15) * 8;
    if (tt < nt) {
        const int t = t0 + tt; const float* Pr = P + (size_t)(row0 + t) * PLD;
        if (MIX == 0) {
#pragma unroll
            for (int j = 0; j < 8; ++j) {
                const int d = d0 + j, cc = h * 128 + d;
                const float qr = Pr[cc], fr_ = Pr[1024 + cc], lb = lbv[cc];
                const float fg = lb + (1.f - lb) * sigmoidf_(fr_);
                qs[tt * QS + d] = siluf_(qr); ks[tt * QS + d] = 1.f - fg; fs[tt * QS + d] = logf(fg);
            }
        } else if (MIX == 1) {
            const float* cw = p.in[15]; const float* cbuf = p.in[4];
            float sq = 0.f, sk = 0.f;
#pragma unroll 1
            for (int j = 0; j < 8; ++j) {
                const int cq = h * 128 + d0 + j, ck = 1024 + cq;
                float yq = 0.f, yk = 0.f;
#pragma unroll
                for (int w = 0; w < 4; ++w) {
                    const int tp = t - 3 + w; float xq, xk;
                    if (tp >= 0) { xq = P[(size_t)(row0 + tp) * PLD + cq]; xk = P[(size_t)(row0 + tp) * PLD + ck]; }
                    else if (has_init) { xq = cbuf[((size_t)sseq * 3 + (3 + tp)) * 3072 + cq]; xk = cbuf[((size_t)sseq * 3 + (3 + tp)) * 3072 + ck]; }
                    else { xq = 0.f; xk = 0.f; }
                    yq += cw[w * 3072 + cq] * xq; yk += cw[w * 3072 + ck] * xk;
                }
                const float qv = siluf_(yq), kv = siluf_(yk);
                sq += qv * qv; sk += kv * kv;
                qs[tt * QS + d0 + j] = qv; ks[tt * QS + d0 + j] = kv;
            }
            sq += __shfl_xor(sq, 1); sq += __shfl_xor(sq, 2); sq += __shfl_xor(sq, 4); sq += __shfl_xor(sq, 8);
            sk += __shfl_xor(sk, 1); sk += __shfl_xor(sk, 2); sk += __shfl_xor(sk, 4); sk += __shfl_xor(sk, 8);
            const float rq = rsqrtf(sq + 1e-6f) * 0.08838834764831845f, rk = rsqrtf(sk + 1e-6f);
#pragma unroll 1
            for (int j = 0; j < 8; ++j) { qs[tt * QS + d0 + j] *= rq; ks[tt * QS + d0 + j] *= rk; }
            if ((tid & 15) == 0) {
                const float ar = Pr[3072 + h], br = Pr[3080 + h];
                sc[tt * 2] = -expf(p.in[16][h]) * softplusf_(ar + p.in[17][h]);
                sc[tt * 2 + 1] = sigmoidf_(br);
            }
        } else if (MIX == 2) {
#pragma unroll
            for (int j = 0; j < 8; ++j) {
                const int d = d0 + j, cc = h * 128 + d;
                qs[tt * QS + d] = Pr[cc]; ks[tt * QS + d] = Pr[1024 + cc] * 0.08838834764831845f;
            }
            if ((tid & 15) == 0) {
                sc[tt * 2] = Pr[3072 + h] + p.in[21][h];
                sc[tt * 2 + 1] = logsigmoidf_(Pr[3080 + h] + p.in[22][h]);
            }
        } else {
            const float* wg = p.in[26]; const float* bg = p.in[27];
            float rr[16];
#pragma unroll
            for (int j = 0; j < 16; ++j) rr[j] = Pr[3072 + j];
#pragma unroll
            for (int j = 0; j < 8; ++j) {
                const int d = d0 + j, cc = h * 128 + d;
                float pre = bg[cc];
#pragma unroll
                for (int q = 0; q < 16; ++q) pre += rr[q] * wg[q * 512 + cc];
                qs[tt * QS + d] = Pr[cc] * 0.08838834764831845f; ks[tt * QS + d] = Pr[512 + cc];
                fs[tt * QS + d] = logsigmoidf_(pre) * 0.0625f;
            }
        }
    }
}

template <int MIX>
__device__ __forceinline__ float load_v(const Params& p, const float* __restrict__ P, int row0, int t, int cv, bool has_init, int sseq) {
    if (MIX == 1) {
        const float* cw = p.in[15]; const float* cbuf = p.in[4];
        float y = 0.f;
#pragma unroll
        for (int w = 0; w < 4; ++w) {
            const int tp = t - 3 + w; float x;
            if (tp >= 0) x = P[(size_t)(row0 + tp) * PLD + cv];
            else if (has_init) x = cbuf[((size_t)sseq * 3 + (3 + tp)) * 3072 + cv];
            else x = 0.f;
            y += cw[w * 3072 + cv] * x;
        }
        return siluf_(y);
    }
    return P[(size_t)(row0 + t) * PLD + cv];
}

template <int MIX>
__device__ __forceinline__ void scan_sample_item(const Params& p, float* lds, int tid, int item) {
    unsigned char* ws = opaque_ptr(p.ws);
    const float* P = (const float*)(ws + OFF_P);
    float* O = (float*)(ws + OFF_O);
    const float* lbv = (const float*)(ws + OFF_LB);
    float* qs = lds; float* ks = lds + 16 * QS; float* fs = lds + 32 * QS; float* vs = lds + 48 * QS; float* sc = lds + 64 * QS;
    const int wave = tid >> 6, lane = tid & 63, g = lane >> 4, c = lane & 15;
    constexpr int DV = (MIX == 3) ? 256 : 128;
    constexpr int NH = (MIX == 3) ? 4 : 8;
    constexpr int VG = DV / 64;
    constexpr int VBASE = (MIX == 3) ? 1024 : 2048;
    const int sseq = item >> 4, sub = item & 15, h = sub / VG, vg = sub % VG;
    const int row0 = ROWS_P + sseq;
    const int vcol = vg * 64 + wave * 16 + c;
    float s[32];
    const float* init_S = (MIX == 0) ? p.in[2] : (MIX == 1) ? p.in[3] : (MIX == 2) ? p.in[5] : p.in[8];
    float* out_S = p.out + ((MIX == 0) ? OUT_S_HGRN : (MIX == 1) ? OUT_S_GDN : (MIX == 2) ? OUT_S_MC : OUT_S_GLA);
    const size_t st_off = ((size_t)sseq * NH + h) * 128 * DV;
#pragma unroll
    for (int i = 0; i < 32; ++i) s[i] = init_S[st_off + (size_t)(g * 32 + i) * DV + vcol];
    float nn0 = 0.f, nn1 = 0.f, mrun = 0.f;
    if (MIX == 2) {
        nn0 = p.in[6][((size_t)sseq * 8 + h) * 128 + 2 * lane]; nn1 = p.in[6][((size_t)sseq * 8 + h) * 128 + 2 * lane + 1];
        mrun = p.in[7][(size_t)sseq * 8 + h];
    }
    __syncthreads();
    stage_qk<MIX>(p, P, lbv, qs, ks, fs, sc, tid, h, row0, 0, 1, true, sseq);
    if (tid < 64) vs[tid] = load_v<MIX>(p, P, row0, 0, VBASE + h * DV + vg * 64 + tid, true, sseq);
    __syncthreads();
    {
        const float vv = vs[wave * 16 + c];
        const f32x4* q4 = (const f32x4*)(qs + g * 32);
        const f32x4* k4 = (const f32x4*)(ks + g * 32);
        const f32x4* f4 = (const f32x4*)(fs + g * 32);
        float o = 0.f;
        if (MIX == 0 || MIX == 3) {
#pragma unroll
            for (int i4 = 0; i4 < 8; ++i4) {
                const f32x4 qq = q4[i4], kk = k4[i4], ff = f4[i4];
#pragma unroll
                for (int j = 0; j < 4; ++j) { const int i = i4 * 4 + j; s[i] = expf(ff[j]) * s[i] + kk[j] * vv; o += qq[j] * s[i]; }
            }
            o += __shfl_xor(o, 16); o += __shfl_xor(o, 32);
        } else if (MIX == 1) {
            const float a = expf(sc[0]), beta = sc[1];
            float r = 0.f;
#pragma unroll
            for (int i4 = 0; i4 < 8; ++i4) {
                const f32x4 kk = k4[i4];
#pragma unroll
                for (int j = 0; j < 4; ++j) { const int i = i4 * 4 + j; s[i] *= a; r += kk[j] * s[i]; }
            }
            r += __shfl_xor(r, 16); r += __shfl_xor(r, 32);
            const float vn = beta * (vv - r);
#pragma unroll
            for (int i4 = 0; i4 < 8; ++i4) {
                const f32x4 qq = q4[i4], kk = k4[i4];
#pragma unroll
                for (int j = 0; j < 4; ++j) { const int i = i4 * 4 + j; s[i] += kk[j] * vn; o += qq[j] * s[i]; }
            }
            o += __shfl_xor(o, 16); o += __shfl_xor(o, 32);
        } else {
            const float li = sc[0], lf = sc[1];
            const float mn = fmaxf(lf + mrun, li);
            const float a = expf(lf + mrun - mn), w = expf(li - mn);
            mrun = mn;
            const float wv = w * vv;
#pragma unroll
            for (int i4 = 0; i4 < 8; ++i4) {
                const f32x4 qq = q4[i4], kk = k4[i4];
#pragma unroll
                for (int j = 0; j < 4; ++j) { const int i = i4 * 4 + j; s[i] = a * s[i] + kk[j] * wv; o += qq[j] * s[i]; }
            }
            o += __shfl_xor(o, 16); o += __shfl_xor(o, 32);
            const float k0 = ks[2 * lane], k1 = ks[2 * lane + 1];
            const float q0 = qs[2 * lane], q1 = qs[2 * lane + 1];
            nn0 = a * nn0 + w * k0; nn1 = a * nn1 + w * k1;
            const float den = wave_sum(q0 * nn0 + q1 * nn1);
            o = o / fmaxf(fabsf(den), expf(-mn));
        }
        if (g == 0) O[(size_t)row0 * 1024 + sub * 64 + wave * 16 + c] = o;
    }
#pragma unroll
    for (int i = 0; i < 32; ++i) out_S[st_off + (size_t)(g * 32 + i) * DV + vcol] = s[i];
    if (MIX == 2 && vg == 0 && wave == 0) {
        float* on = p.out + OUT_S_MN + ((size_t)sseq * 8 + h) * 128;
        on[2 * lane] = nn0; on[2 * lane + 1] = nn1;
        if (lane == 0) {
            p.out[OUT_S_MM + (size_t)sseq * 8 + h] = mrun;
            ((float*)(ws + OFF_DEN))[(size_t)row0 * 8 + h] = 1.f;
            ((float*)(ws + OFF_MT))[(size_t)row0 * 8 + h] = 100.f;
        }
    }
}

template <int MIX>
__device__ __forceinline__ void prepass_chunk(const Params& p, float* lds, int tid, int item) {
    unsigned char* ws = opaque_ptr(p.ws);
    const float* P = (const float*)(ws + OFF_P);
    const float* lbv = (const float*)(ws + OFF_LB);
    float* qs = lds; float* ks = lds + 16 * QS; float* fs = lds + 32 * QS; float* vs = lds + 48 * QS; float* sc = lds + 64 * QS;
    float* nm = sc + 32;
    constexpr int DV = (MIX == 3) ? 256 : 128;
    constexpr int NH = (MIX == 3) ? 4 : 8;
    constexpr int VBASE = (MIX == 3) ? 1024 : 2048;
    const int ci = item, ch = item % NCH, bh = item / NCH, h = bh % NH, b = bh / NH;
    const int row0 = b * T_P, t0 = ch * 16;
    bf16_t* QF = (bf16_t*)(ws + OFF_QF) + (size_t)ci * 2048;
    bf16_t* KF = (bf16_t*)(ws + OFF_KF) + (size_t)ci * 2048;
    bf16_t* WF = (bf16_t*)(ws + OFF_WF) + (size_t)ci * 2048;
    float* DF = (float*)(ws + OFF_DF) + (size_t)ci * 128;
    __syncthreads();
    stage_qk<MIX>(p, P, lbv, qs, ks, fs, sc, tid, h, row0, t0, 16, false, 0);
    if (MIX == 1) {
        for (int e = tid; e < 16 * 128; e += NTH) { const int tt = e >> 7, col = e & 127; vs[tt * QS + col] = load_v<1>(p, P, row0, t0 + tt, VBASE + h * 128 + col, false, 0); }
    }
    __syncthreads();
    if (MIX == 0 || MIX == 3) {
        if (tid < 128) { float bb = 0.f;
#pragma unroll
            for (int t = 0; t < 16; ++t) { bb += fs[t * QS + tid]; fs[t * QS + tid] = bb; } }
        __syncthreads();
        for (int e = tid; e < 512; e += NTH) {
            const int t = e >> 5, k0 = (e & 31) * 4;
            float qv[4];
#pragma unroll
            for (int j = 0; j < 4; ++j) { const float bb = fs[t * QS + k0 + j]; qv[j] = qs[t * QS + k0 + j] * expf(bb); }
            u32x2 w; w.x = cvt_pk_bf16(qv[0], qv[1]); w.y = cvt_pk_bf16(qv[2], qv[3]);
            *(u32x2*)(QF + qf_index(t, k0)) = w;
#pragma unroll
            for (int j = 0; j < 4; ++j) qs[t * QS + k0 + j] = qv[j];
        }
        for (int e = tid; e < 512; e += NTH) {
            const int k = e & 127, tq = e >> 7;
            const float be = fs[15 * QS + k];
            float kv[4];
#pragma unroll
            for (int j = 0; j < 4; ++j) { const int t = tq * 4 + j; kv[j] = ks[t * QS + k] * expf(be - fs[t * QS + k]); }
            u32x2 w; w.x = cvt_pk_bf16(kv[0], kv[1]); w.y = cvt_pk_bf16(kv[2], kv[3]);
            *(u32x2*)(KF + kf_index(tq * 4, k)) = w;
        }
        if (tid < 128) { const int k = tid; DF[((k >> 2) & 3) * 32 + (k >> 4) * 4 + (k & 3)] = expf(fs[15 * QS + k]); }
        __syncthreads();
        for (int e = tid; e < 2048; e += NTH) { const int t = e >> 7, k = e & 127; ks[t * QS + k] *= expf(-fs[t * QS + k]); }
        __syncthreads();
        {
            const int t = tid >> 4, s_ = tid & 15;
            const f32x4* a4 = (const f32x4*)(qs + t * QS); const f32x4* b4 = (const f32x4*)(ks + s_ * QS);
            float acc = 0.f;
#pragma unroll 8
            for (int i = 0; i < 32; ++i) { const f32x4 x = a4[i], y = b4[i]; acc += x[0] * y[0] + x[1] * y[1] + x[2] * y[2] + x[3] * y[3]; }
            ((bf16_t*)(ws + OFF_AF))[(size_t)ci * 512 + af_index(t, s_)] = f2bf(s_ <= t ? acc : 0.f);
        }
    } else if (MIX == 1) {
        float bc[16];
        { float bb = 0.f;
#pragma unroll
          for (int t = 0; t < 16; ++t) { bb += sc[t * 2]; bc[t] = bb; } }
        {
            const int t = tid >> 4, s_ = tid & 15;
            const f32x4* a4 = (const f32x4*)(ks + t * QS); const f32x4* q4 = (const f32x4*)(qs + t * QS); const f32x4* b4 = (const f32x4*)(ks + s_ * QS);
            float kk = 0.f, qk = 0.f;
#pragma unroll 8
            for (int i = 0; i < 32; ++i) { const f32x4 x = a4[i], z = q4[i], y = b4[i]; kk += x[0] * y[0] + x[1] * y[1] + x[2] * y[2] + x[3] * y[3]; qk += z[0] * y[0] + z[1] * y[1] + z[2] * y[2] + z[3] * y[3]; }
            float bt = 0.f, bs_ = 0.f;
#pragma unroll
            for (int i = 0; i < 16; ++i) { bt = (i == t) ? bc[i] : bt; bs_ = (i == s_) ? bc[i] : bs_; }
            const float e = (s_ <= t) ? expf(bt - bs_) : 0.f;
            nm[t * 17 + s_] = (s_ < t) ? sc[t * 2 + 1] * kk * e : 0.f;
            ((bf16_t*)(ws + OFF_AF))[(size_t)ci * 512 + af_index(t, s_)] = f2bf(qk * e);
        }
        for (int e = tid; e < 512; e += NTH) {
            const int t = e >> 5, k0 = (e & 31) * 4;
            float bt = 0.f;
#pragma unroll
            for (int i = 0; i < 16; ++i) bt = (i == t) ? bc[i] : bt;
            const float eb = expf(bt);
            u32x2 w; w.x = cvt_pk_bf16(qs[t * QS + k0] * eb, qs[t * QS + k0 + 1] * eb); w.y = cvt_pk_bf16(qs[t * QS + k0 + 2] * eb, qs[t * QS + k0 + 3] * eb);
            *(u32x2*)(QF + qf_index(t, k0)) = w;
        }
        for (int e = tid; e < 512; e += NTH) {
            const int k = e & 127, tq = e >> 7;
            float kv[4];
#pragma unroll
            for (int j = 0; j < 4; ++j) { float bt = 0.f;
#pragma unroll
                for (int i = 0; i < 16; ++i) bt = (i == tq * 4 + j) ? bc[i] : bt;
                kv[j] = ks[(tq * 4 + j) * QS + k] * expf(bc[15] - bt); }
            u32x2 w; w.x = cvt_pk_bf16(kv[0], kv[1]); w.y = cvt_pk_bf16(kv[2], kv[3]);
            *(u32x2*)(KF + kf_index(tq * 4, k)) = w;
        }
        if (tid == 0) DF[0] = expf(bc[15]);
        __syncthreads();
        {
            float x[16];
            const bool isv = tid < 128; const int col = tid & 127;
#pragma unroll
            for (int t = 0; t < 16; ++t) { const float beta = sc[t * 2 + 1]; x[t] = isv ? beta * vs[t * QS + col] : beta * expf(bc[t]) * ks[t * QS + col]; }
#pragma unroll
            for (int t = 1; t < 16; ++t)
#pragma unroll
                for (int s_ = 0; s_ < t; ++s_) x[t] -= nm[t * 17 + s_] * x[s_];
            if (isv) {
                float* UF = (float*)(ws + OFF_VF) + (size_t)ci * 2048;
#pragma unroll
                for (int tq = 0; tq < 4; ++tq) *(f32x4*)(UF + vf_index(tq * 4, col)) = (f32x4){x[tq * 4], x[tq * 4 + 1], x[tq * 4 + 2], x[tq * 4 + 3]};
            } else {
#pragma unroll
                for (int t = 0; t < 16; ++t) WF[qf_index(t, col)] = f2bf(x[t]);
            }
        }
    } else {
        float cc[16], gg[16], bc[16];
        { float bb = 0.f, gm = -INFINITY;
#pragma unroll
          for (int t = 0; t < 16; ++t) { bb += sc[t * 2 + 1]; bc[t] = bb; cc[t] = sc[t * 2] - bb; gm = fmaxf(gm, cc[t]); gg[t] = gm; } }
        {
            const int t = tid >> 4, s_ = tid & 15;
            const f32x4* a4 = (const f32x4*)(qs + t * QS); const f32x4* b4 = (const f32x4*)(ks + s_ * QS);
            float acc = 0.f;
#pragma unroll 8
            for (int i = 0; i < 32; ++i) { const f32x4 x = a4[i], y = b4[i]; acc += x[0] * y[0] + x[1] * y[1] + x[2] * y[2] + x[3] * y[3]; }
            ((float*)(ws + OFF_AF))[(size_t)ci * 256 + af_index(t, s_)] = (s_ <= t) ? acc : 0.f;
        }
        for (int e = tid; e < 512; e += NTH) {
            const int t = e >> 5, k0 = (e & 31) * 4;
            u32x2 w; w.x = cvt_pk_bf16(qs[t * QS + k0], qs[t * QS + k0 + 1]); w.y = cvt_pk_bf16(qs[t * QS + k0 + 2], qs[t * QS + k0 + 3]);
            *(u32x2*)(QF + qf_index(t, k0)) = w;
        }
        for (int e = tid; e < 512; e += NTH) {
            const int k = e & 127, tq = e >> 7;
            float kv[4];
#pragma unroll
            for (int j = 0; j < 4; ++j) { float ct = 0.f;
#pragma unroll
                for (int i = 0; i < 16; ++i) ct = (i == tq * 4 + j) ? cc[i] : ct;
                kv[j] = ks[(tq * 4 + j) * QS + k] * expf(ct - gg[15]); }
            u32x2 w; w.x = cvt_pk_bf16(kv[0], kv[1]); w.y = cvt_pk_bf16(kv[2], kv[3]);
            *(u32x2*)(KF + kf_index(tq * 4, k)) = w;
        }
        if (tid < 16) {
            float cv = 0.f, gv = 0.f, bv = 0.f;
#pragma unroll
            for (int i = 0; i < 16; ++i) { cv = (i == tid) ? cc[i] : cv; gv = (i == tid) ? gg[i] : gv; bv = (i == tid) ? bc[i] : bv; }
            DF[tid] = cv; DF[16 + tid] = gv; DF[32 + tid] = bv;
        }
    }
    if (MIX != 1) {
        bf16_t* VF = (bf16_t*)(ws + OFF_VF) + (size_t)ci * (16 * DV);
        for (int e = tid; e < DV * 4; e += NTH) {
            const int v = e % DV, tq = e / DV;
            float x[4];
#pragma unroll
            for (int j = 0; j < 4; ++j) x[j] = P[(size_t)(row0 + t0 + tq * 4 + j) * PLD + VBASE + h * DV + v];
            u32x2 w; w.x = cvt_pk_bf16(x[0], x[1]); w.y = cvt_pk_bf16(x[2], x[3]);
            *(u32x2*)(VF + vf_index(tq * 4, v)) = w;
        }
    }
}

constexpr int PW_IMG = 272;
constexpr int PW_BYTES = 14336;
#define PW_FENCE() asm volatile("s_waitcnt lgkmcnt(0)" ::: "memory")
__device__ __forceinline__ float exp_fast(float x) { return __expf(x); }
__device__ __forceinline__ f32x4 img_mfma(const unsigned char* X, const unsigned char* Y, int lane) {
    f32x4 d = (f32x4){0.f, 0.f, 0.f, 0.f};
    const int r = lane & 15, q = lane >> 4;
#pragma unroll
    for (int m = 0; m < 4; ++m) {
        const bf16x8 a = *(const bf16x8*)(X + r * PW_IMG + m * 64 + q * 16), b = *(const bf16x8*)(Y + r * PW_IMG + m * 64 + q * 16);
        d = __builtin_amdgcn_mfma_f32_16x16x32_bf16(a, b, d, 0, 0, 0);
    }
    return d;
}
__device__ __forceinline__ void emit_qf(const unsigned char* img, bf16_t* rec, int lane, float rowscale, bool scaled) {
    const int t = lane & 15, q = lane >> 4;
#pragma unroll
    for (int m = 0; m < 4; ++m) {
        u32x2 lo = *(const u32x2*)(img + t * PW_IMG + (32 * m + 4 * q) * 2), hi = *(const u32x2*)(img + t * PW_IMG + (32 * m + 16 + 4 * q) * 2);
        if (scaled) {
            lo.x = cvt_pk_bf16(__uint_as_float(lo.x << 16) * rowscale, __uint_as_float(lo.x & 0xffff0000u) * rowscale); lo.y = cvt_pk_bf16(__uint_as_float(lo.y << 16) * rowscale, __uint_as_float(lo.y & 0xffff0000u) * rowscale);
            hi.x = cvt_pk_bf16(__uint_as_float(hi.x << 16) * rowscale, __uint_as_float(hi.x & 0xffff0000u) * rowscale); hi.y = cvt_pk_bf16(__uint_as_float(hi.y << 16) * rowscale, __uint_as_float(hi.y & 0xffff0000u) * rowscale);
        }
        *(u32x4*)(rec + (m * 64 + lane) * 8) = (u32x4){lo.x, lo.y, hi.x, hi.y};
    }
}
__device__ __forceinline__ void emit_kf(const unsigned char* kt_img, bf16_t* rec, int lane) {
    const int i = lane & 15, q = lane >> 4;
#pragma unroll
    for (int g = 0; g < 4; ++g) {
        const u32x2 a = *(const u32x2*)(kt_img + (16 * (2 * g) + i) * 32 + q * 8), b = *(const u32x2*)(kt_img + (16 * (2 * g + 1) + i) * 32 + q * 8);
        *(u32x4*)(rec + lane * 32 + g * 8) = (u32x4){a.x, a.y, b.x, b.y};
    }
}
__device__ __forceinline__ void store_kt(unsigned char* kt_img, int lane, const float (&v0)[16], const float (&v1)[16]) {
#pragma unroll
    for (int hh = 0; hh < 2; ++hh) {
        u32x4 w0, w1;
#pragma unroll
        for (int j = 0; j < 4; ++j) { w0[j] = cvt_pk_bf16(v0[hh * 8 + 2 * j], v0[hh * 8 + 2 * j + 1]); w1[j] = cvt_pk_bf16(v1[hh * 8 + 2 * j], v1[hh * 8 + 2 * j + 1]); }
        *(u32x4*)(kt_img + (2 * lane) * 32 + hh * 16) = w0; *(u32x4*)(kt_img + (2 * lane + 1) * 32 + hh * 16) = w1;
    }
}
__device__ __forceinline__ void wave_sum16(float (&v)[16], int lane) {
    float a[8], b[4], c[2], d;
#pragma unroll
    for (int i = 0; i < 8; ++i) { const bool up = lane >= 32; const float snd = up ? v[i] : v[i + 8], keep = up ? v[i + 8] : v[i]; a[i] = keep + __shfl_xor(snd, 32); }
#pragma unroll
    for (int i = 0; i < 4; ++i) { const bool up = (lane & 16) != 0; const float snd = up ? a[i] : a[i + 4], keep = up ? a[i + 4] : a[i]; b[i] = keep + __shfl_xor(snd, 16); }
#pragma unroll
    for (int i = 0; i < 2; ++i) { const bool up = (lane & 8) != 0; const float snd = up ? b[i] : b[i + 2], keep = up ? b[i + 2] : b[i]; c[i] = keep + __shfl_xor(snd, 8); }
    { const bool up = (lane & 4) != 0; const float snd = up ? c[0] : c[1], keep = up ? c[1] : c[0]; d = keep + __shfl_xor(snd, 4); }
    d += __shfl_xor(d, 2); d += __shfl_xor(d, 1);
#pragma unroll
    for (int i = 0; i < 16; ++i) {
        const int src = ((i >> 3) & 1) * 32 + ((i >> 2) & 1) * 16 + ((i >> 1) & 1) * 8 + (i & 1) * 4;
        v[i] = __builtin_bit_cast(float, __builtin_amdgcn_readlane(__builtin_bit_cast(int, d), src));
    }
}

template <int MIX, int VARIANT = 0>
__device__ __forceinline__ void prepass_wave(const Params& p, unsigned char* wl, int lane, int item) {
    unsigned char* ws = opaque_ptr(p.ws);
    const bf16_t* P = (const bf16_t*)(ws + OFF_P);
    constexpr int DV = (MIX == 3) ? 256 : 128;
    constexpr int NH = (MIX == 3) ? 4 : 8;
    constexpr int VBASE = (MIX == 3) ? 1024 : 2048;
    const int ci = item, ch = item % NCH, bh = item / NCH, h = bh % NH, b = bh / NH;
    const int row0 = b * T_P, t0 = ch * 16;
    const int q = lane >> 4, c = lane & 15, kc = h * 128 + 2 * lane;
    bf16_t* QF = (bf16_t*)(ws + OFF_QF) + (size_t)ci * 2048;
    bf16_t* KF = (bf16_t*)(ws + OFF_KF) + (size_t)ci * 2048;
    float* DF = (float*)(ws + OFF_DF) + (size_t)ci * 128;
    unsigned char* imgA = wl; unsigned char* imgB = wl + 16 * PW_IMG; unsigned char* ktI = wl + 32 * PW_IMG; float* nm = (float*)(wl + 32 * PW_IMG + 4096);
    const bf16_t* Prow = P + (size_t)(row0 + t0) * PLD;
    const float* PGrow = (const float*)(ws + OFF_PG) + (size_t)(row0 + t0) * 16;
    unsigned x[DV / 16][4];
    if (MIX != 1) {
#pragma unroll
        for (int vt = 0; vt < DV / 16; ++vt)
#pragma unroll
            for (int j = 0; j < 4; ++j) x[vt][j] = Prow[(size_t)(4 * q + j) * PLD + VBASE + h * DV + vt * 16 + c];
    }
    auto vf_store = [&]() {
        if (MIX != 1) {
            bf16_t* VF = (bf16_t*)(ws + OFF_VF) + (size_t)ci * (16 * DV);
#pragma unroll
            for (int vt = 0; vt < DV / 16; ++vt) {
                u32x2 w; w.x = x[vt][0] | (x[vt][1] << 16); w.y = x[vt][2] | (x[vt][3] << 16);
                *(u32x2*)(VF + (vt * 64 + lane) * 4) = w;
            }
        }
    };
    if (MIX == 0 || MIX == 3) {
        float qv0[16], qv1[16], kv0[16], kv1[16], b0[16], b1[16];
        if (MIX == 0) {
            const float* lbv = (const float*)(ws + OFF_LB);
            const f32x2 lb = *(const f32x2*)(lbv + kc);
#pragma unroll
            for (int t = 0; t < 16; ++t) {
                const f32x2 qr = ldbf2(Prow + (size_t)t * PLD + kc), fr_ = ldbf2(Prow + (size_t)t * PLD + 1024 + kc);
                const float fg0 = lb[0] + (1.f - lb[0]) * sigmoidf_(fr_[0]), fg1 = lb[1] + (1.f - lb[1]) * sigmoidf_(fr_[1]);
                qv0[t] = siluf_(qr[0]); qv1[t] = siluf_(qr[1]); kv0[t] = 1.f - fg0; kv1[t] = 1.f - fg1; b0[t] = __logf(fg0); b1[t] = __logf(fg1);
            }
        } else {
            const float* wg = p.in[26]; const float* bg = p.in[27];
            f32x2 wgt[16];
#pragma unroll
            for (int j = 0; j < 16; ++j) wgt[j] = *(const f32x2*)(wg + j * 512 + kc);
            const f32x2 bgv = *(const f32x2*)(bg + kc);
#pragma unroll
            for (int t = 0; t < 16; ++t) {
                const bf16_t* Pr = Prow + (size_t)t * PLD;
                const f32x2 qr = ldbf2(Pr + kc), kr = ldbf2(Pr + 512 + kc);
                float p0 = bgv[0], p1 = bgv[1];
#pragma unroll
                for (int j4 = 0; j4 < 4; ++j4) { const f32x4 rr = *(const f32x4*)(PGrow + t * 16 + j4 * 4);
#pragma unroll
                    for (int j = 0; j < 4; ++j) { p0 += rr[j] * wgt[j4 * 4 + j][0]; p1 += rr[j] * wgt[j4 * 4 + j][1]; } }
                qv0[t] = qr[0] * 0.08838834764831845f; qv1[t] = qr[1] * 0.08838834764831845f; kv0[t] = kr[0]; kv1[t] = kr[1];
                b0[t] = logsigmoidf_(p0) * 0.0625f; b1[t] = logsigmoidf_(p1) * 0.0625f;
            }
        }
        vf_store();
#pragma unroll
        for (int t = 1; t < 16; ++t) { b0[t] += b0[t - 1]; b1[t] += b1[t - 1]; }
        float kh0[16], kh1[16];
#pragma unroll
        for (int t = 0; t < 16; ++t) {
            const float e0 = exp_fast(b0[t]), e1 = exp_fast(b1[t]);
            *(unsigned*)(imgA + t * PW_IMG + 4 * lane) = cvt_pk_bf16(qv0[t] * e0, qv1[t] * e1);
            *(unsigned*)(imgB + t * PW_IMG + 4 * lane) = cvt_pk_bf16(kv0[t] * exp_fast(-b0[t]), kv1[t] * exp_fast(-b1[t]));
            kh0[t] = kv0[t] * exp_fast(b0[15] - b0[t]); kh1[t] = kv1[t] * exp_fast(b1[15] - b1[t]);
        }
        store_kt(ktI, lane, kh0, kh1);
        { const int k = 2 * lane; *(f32x2*)(DF + ((k >> 2) & 3) * 32 + (k >> 4) * 4 + (k & 3)) = (f32x2){exp_fast(b0[15]), exp_fast(b1[15])}; }
        PW_FENCE();
        f32x4 d = img_mfma(imgB, imgA, lane);
        u32x2 aw; aw.x = cvt_pk_bf16((4 * q + 0 <= c) ? d[0] : 0.f, (4 * q + 1 <= c) ? d[1] : 0.f); aw.y = cvt_pk_bf16((4 * q + 2 <= c) ? d[2] : 0.f, (4 * q + 3 <= c) ? d[3] : 0.f);
        *(u32x2*)((bf16_t*)(ws + OFF_AF) + (size_t)ci * 512 + lane * 4) = aw;
        emit_qf(imgA, QF, lane, 1.f, false);
        emit_kf(ktI, KF, lane);
    } else if (MIX == 2) {
        float qv0[16], qv1[16], kv0[16], kv1[16];
#pragma unroll
        for (int t = 0; t < 16; ++t) {
            const f32x2 qr = ldbf2(Prow + (size_t)t * PLD + kc), kr = ldbf2(Prow + (size_t)t * PLD + 1024 + kc);
            qv0[t] = qr[0]; qv1[t] = qr[1]; kv0[t] = kr[0] * 0.08838834764831845f; kv1[t] = kr[1] * 0.08838834764831845f;
        }
        float cc[16], gg[16], bc[16];
        { float bb = 0.f, gm = -INFINITY; const float bi = p.in[21][h], bf_ = p.in[22][h];
#pragma unroll
          for (int t = 0; t < 16; ++t) { const float li = PGrow[t * 16 + h] + bi, lf = logsigmoidf_(PGrow[t * 16 + 8 + h] + bf_);
              bb += lf; bc[t] = bb; cc[t] = li - bb; gm = fmaxf(gm, cc[t]); gg[t] = gm; } }
        vf_store();
        float kh0[16], kh1[16];
#pragma unroll
        for (int t = 0; t < 16; ++t) {
            *(unsigned*)(imgA + t * PW_IMG + 4 * lane) = cvt_pk_bf16(qv0[t], qv1[t]);
            *(unsigned*)(imgB + t * PW_IMG + 4 * lane) = cvt_pk_bf16(kv0[t], kv1[t]);
            const float e = exp_fast(cc[t] - gg[15]); kh0[t] = kv0[t] * e; kh1[t] = kv1[t] * e;
        }
        store_kt(ktI, lane, kh0, kh1);
        if (lane < 16) {
            float cv = 0.f, gv = 0.f, bv = 0.f;
#pragma unroll
            for (int i = 0; i < 16; ++i) { cv = (i == lane) ? cc[i] : cv; gv = (i == lane) ? gg[i] : gv; bv = (i == lane) ? bc[i] : bv; }
            DF[lane] = cv; DF[16 + lane] = gv; DF[32 + lane] = bv;
        }
        PW_FENCE();
        f32x4 d = img_mfma(imgB, imgA, lane);
#pragma unroll
        for (int r = 0; r < 4; ++r) d[r] = (4 * q + r <= c) ? d[r] : 0.f;
        *(f32x4*)((float*)(ws + OFF_AF) + (size_t)ci * 256 + lane * 4) = d;
        emit_qf(imgA, QF, lane, 1.f, false);
        emit_kf(ktI, KF, lane);
    } else {
        const float* cw = p.in[15];
        bf16_t* WF = (bf16_t*)(ws + OFF_WF) + (size_t)ci * 2048;
        float qv0[16], qv1[16], kv0[16], kv1[16], vv0[16], vv1[16];
        unsigned rq_[19], rk_[19], rv_[19];
#pragma unroll
        for (int i = 0; i < 19; ++i) {
            const int t = t0 - 3 + i; const bf16_t* pr_ = P + (size_t)(row0 + (t >= 0 ? t : 0)) * PLD + kc;
            rq_[i] = (t >= 0) ? *(const unsigned*)(pr_) : 0u; rk_[i] = (t >= 0) ? *(const unsigned*)(pr_ + 1024) : 0u; rv_[i] = (t >= 0) ? *(const unsigned*)(pr_ + 2048) : 0u;
        }
#define PW_CONV(col_, raw_, o0, o1) do { const int cc_ = (col_); f32x2 w_[4]; \
            _Pragma("unroll") for (int w = 0; w < 4; ++w) w_[w] = *(const f32x2*)(cw + w * 3072 + cc_); \
            _Pragma("unroll") for (int t = 0; t < 16; ++t) { f32x2 y_ = {0.f, 0.f}; \
                _Pragma("unroll") for (int w = 0; w < 4; ++w) y_ += w_[w] * (f32x2){__uint_as_float(raw_[t + w] << 16), __uint_as_float(raw_[t + w] & 0xffff0000u)}; \
                o0[t] = siluf_(y_[0]); o1[t] = siluf_(y_[1]); } \
            } while (0)
        PW_CONV(kc, rq_, qv0, qv1);
        PW_CONV(1024 + kc, rk_, kv0, kv1);
        PW_CONV(2048 + kc, rv_, vv0, vv1);
#undef PW_CONV
        float sq[16], sk[16];
#pragma unroll
        for (int t = 0; t < 16; ++t) { sq[t] = qv0[t] * qv0[t] + qv1[t] * qv1[t]; sk[t] = kv0[t] * kv0[t] + kv1[t] * kv1[t]; }
        wave_sum16(sq, lane); wave_sum16(sk, lane);
        float bc[16], beta[16];
        { float bb = 0.f; const float ea = expf(p.in[16][h]), dtb = p.in[17][h];
#pragma unroll
          for (int t = 0; t < 16; ++t) { bb += -ea * softplusf_(PGrow[t * 16 + h] + dtb); bc[t] = bb; beta[t] = sigmoidf_(PGrow[t * 16 + 8 + h]); } }
#pragma unroll
        for (int t = 0; t < 16; ++t) {
            const float rq_ = rsqrtf(sq[t] + 1e-6f) * 0.08838834764831845f, rk_ = rsqrtf(sk[t] + 1e-6f);
            kv0[t] *= rk_; kv1[t] *= rk_;
            *(unsigned*)(imgA + t * PW_IMG + 4 * lane) = cvt_pk_bf16(qv0[t] * rq_, qv1[t] * rq_);
            *(unsigned*)(imgB + t * PW_IMG + 4 * lane) = cvt_pk_bf16(kv0[t], kv1[t]);
        }
#pragma unroll
        for (int hh = 0; hh < 2; ++hh) {
            u32x4 w0, w1;
#pragma unroll
            for (int j = 0; j < 4; ++j) {
                const int ta = hh * 8 + 2 * j; const float ea = exp_fast(bc[15] - bc[ta]), eb = exp_fast(bc[15] - bc[ta + 1]);
                w0[j] = cvt_pk_bf16(kv0[ta] * ea, kv0[ta + 1] * eb); w1[j] = cvt_pk_bf16(kv1[ta] * ea, kv1[ta + 1] * eb);
            }
            *(u32x4*)(ktI + (2 * lane) * 32 + hh * 16) = w0; *(u32x4*)(ktI + (2 * lane + 1) * 32 + hh * 16) = w1;
        }
        if (lane == 0) DF[0] = exp_fast(bc[15]);
        PW_FENCE();
        const unsigned char* imgB2 = imgB; asm volatile("" : "+v"(imgB2));
        const f32x4 dkk = img_mfma(imgB, imgB2, lane);
        const f32x4 dqk = img_mfma(imgB, imgA, lane);
        float bcol = 0.f, betac = 0.f;
#pragma unroll
        for (int i = 0; i < 16; ++i) { bcol = (i == c) ? bc[i] : bcol; betac = (i == c) ? beta[i] : betac; }
        u32x2 aw; float av[4];
#pragma unroll
        for (int r = 0; r < 4; ++r) {
            const int s_ = 4 * q + r; float bs_ = 0.f;
#pragma unroll
            for (int i = 0; i < 16; ++i) bs_ = (i == s_) ? bc[i] : bs_;
            const float e = (s_ <= c) ? exp_fast(bcol - bs_) : 0.f;
            nm[c * 17 + s_] = (s_ < c) ? betac * dkk[r] * e : 0.f;
            av[r] = dqk[r] * e;
        }
        aw.x = cvt_pk_bf16(av[0], av[1]); aw.y = cvt_pk_bf16(av[2], av[3]);
        *(u32x2*)((bf16_t*)(ws + OFF_AF) + (size_t)ci * 512 + lane * 4) = aw;
        { float bt = 0.f;
#pragma unroll
          for (int i = 0; i < 16; ++i) bt = (i == c) ? bc[i] : bt;
          emit_qf(imgA, QF, lane, exp_fast(bt), true); }
        emit_kf(ktI, KF, lane);
        PW_FENCE();
#pragma unroll
        for (int t = 0; t < 16; ++t) { const float bb = beta[t], be = bb * exp_fast(bc[t]); vv0[t] *= bb; vv1[t] *= bb; kv0[t] *= be; kv1[t] *= be; }
#pragma unroll
        for (int t = 1; t < 16; ++t)
#pragma unroll
            for (int s_ = 0; s_ < t; ++s_) { const float n_ = nm[t * 17 + s_]; vv0[t] -= n_ * vv0[s_]; vv1[t] -= n_ * vv1[s_]; kv0[t] -= n_ * kv0[s_]; kv1[t] -= n_ * kv1[s_]; }
        {
            bf16_t* UF = (bf16_t*)(ws + OFF_VF) + (size_t)ci * 2048;
#pragma unroll
            for (int tq = 0; tq < 4; ++tq) {
                u32x2 a_, b_;
                a_.x = cvt_pk_bf16(vv0[tq * 4], vv0[tq * 4 + 1]); a_.y = cvt_pk_bf16(vv0[tq * 4 + 2], vv0[tq * 4 + 3]);
                b_.x = cvt_pk_bf16(vv1[tq * 4], vv1[tq * 4 + 1]); b_.y = cvt_pk_bf16(vv1[tq * 4 + 2], vv1[tq * 4 + 3]);
                *(u32x2*)(UF + vf_index(tq * 4, 2 * lane)) = a_;
                *(u32x2*)(UF + vf_index(tq * 4, 2 * lane + 1)) = b_;
            }
        }
        PW_FENCE();
#pragma unroll
        for (int t = 0; t < 16; ++t) *(unsigned*)(imgA + t * PW_IMG + 4 * lane) = cvt_pk_bf16(kv0[t], kv1[t]);
        PW_FENCE();
        emit_qf(imgA, WF, lane, 1.f, false);
    }
    PW_FENCE();
}

template <int MIX>
__device__ __forceinline__ void scanA_phase(const Params& p, float* lds) {
    const int TID = opaque_tid();
    constexpr int NH = (MIX == 3) ? 4 : 8;
    const int nchunk = NB_P * NH * NCH;
    const int wave = TID >> 6, lane = TID & 63;
    if (OLD_PREPASS_MASK & (1 << MIX)) { for (int item = blockIdx.x; item < nchunk; item += gridDim.x) prepass_chunk<MIX>(p, lds, TID, item); }
    else { for (int item = blockIdx.x * 4 + wave; item < nchunk; item += gridDim.x * 4) prepass_wave<MIX>(p, (unsigned char*)lds + wave * PW_BYTES, lane, item); }
#if SAMPLE_IN_SEQ
    return;
#endif
    const int NW = (int)gridDim.x * 4, wr = ((int)gridDim.x - 1 - (int)blockIdx.x) * 4 + (3 - wave);
    if (NB_S * 32 == 2 * NW && nchunk % NW != 0 && 4 * (nchunk % NW) <= NW) {
        const int extra = nchunk % NW;
        const int nmine = (wr >= NW - extra) ? 0 : (wr < 2 * extra) ? 3 : 2;
#pragma unroll 1
        for (int k = 0; k < nmine; ++k) {
            const int it = (k < 2) ? wr + k * NW : ((wr < extra) ? NW - extra + wr : 2 * NW - extra + (wr - extra));
            sample_wave<MIX>(p, (unsigned char*)lds + wave * PW_BYTES, lane, it);
        }
    } else
    for (int it = wr; it < NB_S * 32; it += NW) sample_wave<MIX>(p, (unsigned char*)lds + wave * PW_BYTES, lane, it);
}

template <int MIX>
__device__ __forceinline__ void sample_wave(const Params& p, unsigned char* wl, int lane, int item) {
    unsigned char* ws = opaque_ptr(p.ws);
    const bf16_t* P = (const bf16_t*)(ws + OFF_P);
    float* O = (float*)(ws + OFF_O);
    constexpr int DV = (MIX == 3) ? 256 : 128;
    constexpr int NH = (MIX == 3) ? 4 : 8;
    constexpr int VBASE = (MIX == 3) ? 1024 : 2048;
    const int sseq = item >> 5, tile = item & 31, col0 = tile * 32;
    const int h = col0 / DV, vc0 = col0 % DV;
    const int row = ROWS_P + sseq;
    const int g = lane >> 5, c = lane & 31, kc = h * 128 + 2 * lane;
    const bf16_t* Pr = P + (size_t)row * PLD;
    const float* PGr = (const float*)(ws + OFF_PG) + (size_t)row * 16;
    float* qL = (float*)wl; float* kL = qL + 128; float* fL = kL + 128;
    float sc0 = 0.f, sc1 = 0.f;
    float q0, q1, k0, k1, f0 = 0.f, f1 = 0.f, vv;
    if (MIX == 0) {
        const float* lbv = (const float*)(ws + OFF_LB);
        const f32x2 qr = ldbf2(Pr + kc), fr_ = ldbf2(Pr + 1024 + kc), lb = *(const f32x2*)(lbv + kc);
        const float fg0 = lb[0] + (1.f - lb[0]) * sigmoidf_(fr_[0]), fg1 = lb[1] + (1.f - lb[1]) * sigmoidf_(fr_[1]);
        q0 = siluf_(qr[0]); q1 = siluf_(qr[1]); k0 = 1.f - fg0; k1 = 1.f - fg1; f0 = fg0; f1 = fg1;
        vv = bf2f(Pr[VBASE + col0 + c]);
    } else if (MIX == 3) {
        const float* wg = p.in[26]; const float* bg = p.in[27];
        const f32x2 qr = ldbf2(Pr + kc), kr = ldbf2(Pr + 512 + kc), bgv = *(const f32x2*)(bg + kc);
        float p0 = bgv[0], p1 = bgv[1];
#pragma unroll
        for (int j = 0; j < 16; ++j) { const float rr = PGr[j]; const f32x2 w = *(const f32x2*)(wg + j * 512 + kc); p0 += rr * w[0]; p1 += rr * w[1]; }
        q0 = qr[0] * 0.08838834764831845f; q1 = qr[1] * 0.08838834764831845f; k0 = kr[0]; k1 = kr[1];
        f0 = expf(logsigmoidf_(p0) * 0.0625f); f1 = expf(logsigmoidf_(p1) * 0.0625f);
        vv = bf2f(Pr[VBASE + col0 + c]);
    } else if (MIX == 2) {
        const f32x2 qr = ldbf2(Pr + kc), kr = ldbf2(Pr + 1024 + kc);
        q0 = qr[0]; q1 = qr[1]; k0 = kr[0] * 0.08838834764831845f; k1 = kr[1] * 0.08838834764831845f;
        sc0 = PGr[h] + p.in[21][h]; sc1 = logsigmoidf_(PGr[8 + h] + p.in[22][h]);
        vv = bf2f(Pr[VBASE + col0 + c]);
    } else {
        const float* cw = p.in[15]; const float* cbuf = p.in[4] + (size_t)sseq * 3 * 3072;
        f32x2 yq = {0.f, 0.f}, yk = {0.f, 0.f}; float yv = 0.f;
        const int cv = VBASE + col0 + c;
#pragma unroll
        for (int w = 0; w < 4; ++w) {
            const float* src = cbuf + (w < 3 ? w : 0) * 3072;
            yq += *(const f32x2*)(cw + w * 3072 + kc) * ((w < 3) ? *(const f32x2*)(src + kc) : ldbf2(Pr + kc));
            yk += *(const f32x2*)(cw + w * 3072 + 1024 + kc) * ((w < 3) ? *(const f32x2*)(src + 1024 + kc) : ldbf2(Pr + 1024 + kc));
            yv += cw[w * 3072 + cv] * ((w < 3) ? src[cv] : bf2f(Pr[cv]));
        }
        q0 = siluf_(yq[0]); q1 = siluf_(yq[1]); k0 = siluf_(yk[0]); k1 = siluf_(yk[1]); vv = siluf_(yv);
        const float rq = rsqrtf(wave_sum(q0 * q0 + q1 * q1) + 1e-6f) * 0.08838834764831845f, rk = rsqrtf(wave_sum(k0 * k0 + k1 * k1) + 1e-6f);
        q0 *= rq; q1 *= rq; k0 *= rk; k1 *= rk;
        sc0 = expf(-expf(p.in[16][h]) * softplusf_(PGr[h] + p.in[17][h])); sc1 = sigmoidf_(PGr[8 + h]);
    }
    *(f32x2*)(qL + 2 * lane) = (f32x2){q0, q1}; *(f32x2*)(kL + 2 * lane) = (f32x2){k0, k1};
    if (MIX == 0 || MIX == 3) *(f32x2*)(fL + 2 * lane) = (f32x2){f0, f1};
    const float* init_S = (MIX == 0) ? p.in[2] : (MIX == 1) ? p.in[3] : (MIX == 2) ? p.in[5] : p.in[8];
    float* out_S = p.out + ((MIX == 0) ? OUT_S_HGRN : (MIX == 1) ? OUT_S_GDN : (MIX == 2) ? OUT_S_MC : OUT_S_GLA);
    const size_t st_off = ((size_t)sseq * NH + h) * 128 * DV + (size_t)(64 * g) * DV + vc0 + c;
    float s[64];
#pragma unroll
    for (int i = 0; i < 64; ++i) s[i] = init_S[st_off + (size_t)i * DV];
    float nn0 = 0.f, nn1 = 0.f, mrun = 0.f;
    if (MIX == 2) { nn0 = p.in[6][((size_t)sseq * 8 + h) * 128 + 2 * lane]; nn1 = p.in[6][((size_t)sseq * 8 + h) * 128 + 2 * lane + 1]; mrun = p.in[7][(size_t)sseq * 8 + h]; }
    PW_FENCE();
    const f32x4* q4 = (const f32x4*)(qL + 64 * g); const f32x4* k4 = (const f32x4*)(kL + 64 * g); const f32x4* f4 = (const f32x4*)(fL + 64 * g);
    float o = 0.f;
    if (MIX == 0 || MIX == 3) {
#pragma unroll
        for (int i4 = 0; i4 < 16; ++i4) { const f32x4 qq = q4[i4], kk = k4[i4], ff = f4[i4];
#pragma unroll
            for (int j = 0; j < 4; ++j) { const int i = i4 * 4 + j; s[i] = ff[j] * s[i] + kk[j] * vv; o += qq[j] * s[i]; } }
        o += __shfl_xor(o, 32);
    } else if (MIX == 1) {
        float r = 0.f;
#pragma unroll
        for (int i4 = 0; i4 < 16; ++i4) { const f32x4 kk = k4[i4];
#pragma unroll
            for (int j = 0; j < 4; ++j) { const int i = i4 * 4 + j; s[i] *= sc0; r += kk[j] * s[i]; } }
        r += __shfl_xor(r, 32);
        const float vn = sc1 * (vv - r);
#pragma unroll
        for (int i4 = 0; i4 < 16; ++i4) { const f32x4 qq = q4[i4], kk = k4[i4];
#pragma unroll
            for (int j = 0; j < 4; ++j) { const int i = i4 * 4 + j; s[i] += kk[j] * vn; o += qq[j] * s[i]; } }
        o += __shfl_xor(o, 32);
    } else {
        const float mn = fmaxf(sc1 + mrun, sc0);
        const float a = expf(sc1 + mrun - mn), w = expf(sc0 - mn);
        mrun = mn;
        const float wv = w * vv;
#pragma unroll
        for (int i4 = 0; i4 < 16; ++i4) { const f32x4 qq = q4[i4], kk = k4[i4];
#pragma unroll
            for (int j = 0; j < 4; ++j) { const int i = i4 * 4 + j; s[i] = a * s[i] + kk[j] * wv; o += qq[j] * s[i]; } }
        o += __shfl_xor(o, 32);
        nn0 = a * nn0 + w * k0; nn1 = a * nn1 + w * k1;
        const float den = wave_sum(q0 * nn0 + q1 * nn1);
        o = o / fmaxf(fabsf(den), expf(-mn));
    }
    if (g == 0) ((bf16_t*)O)[(size_t)row * 1024 + col0 + c] = f2bf(o);
#pragma unroll
    for (int i = 0; i < 64; ++i) out_S[st_off + (size_t)i * DV] = s[i];
    if (MIX == 2 && vc0 == 0) {
        float* on = p.out + OUT_S_MN + ((size_t)sseq * 8 + h) * 128;
        *(f32x2*)(on + 2 * lane) = (f32x2){nn0, nn1};
        if (lane == 0) {
            p.out[OUT_S_MM + (size_t)sseq * 8 + h] = mrun;
            ((float*)(ws + OFF_DEN))[(size_t)row * 8 + h] = 1.f;
            ((float*)(ws + OFF_MT))[(size_t)row * 8 + h] = 100.f;
        }
    }
    PW_FENCE();
}

#define RING_BYTES_OF(M_) (((M_) == 2) ? 3 * 11264 : ((M_) == 1) ? 4 * 15360 : 5 * 11264)
template <int MIX, bool LITE = false>
__device__ __forceinline__ void seq_phase(const Params& p, unsigned char* lds, bool do_seq = true, bool do_sample = true) {
    const int TID = opaque_tid();
    unsigned char* ws = opaque_ptr(p.ws);
    constexpr int DV = (MIX == 3) ? 256 : 128;
    constexpr int NH = (MIX == 3) ? 4 : 8;
    constexpr int NVT = DV / 16;
    constexpr int NT = NVT + ((MIX == 2) ? 1 : 0);
    const int wave = TID >> 6, lane = TID & 63, q = lane >> 4, c = lane & 15;
    float* O = (float*)(ws + OFF_O);
    const int nitems = NB_P * NH * NT;
    if (wave >= 2 && !LITE) {
        const int layer_ = (MIX == 0) ? 0 : (MIX == 1) ? 1 : (MIX == 2) ? 2 : 3;
        const int wr_ = blockIdx.x * 2 + (wave - 2), nw_ = gridDim.x * 2;
        convert_fp8_rows<true>(p.in[33], ws + OFF_UB, (float*)(ws + OFF_SU), layer_ * NEXP, (layer_ + 1) * NEXP, wr_, nw_, lane);
        convert_fp8_rows<false>(p.in[34], ws + OFF_VB, (float*)(ws + OFF_SV), layer_ * NEXP, (layer_ + 1) * NEXP, wr_, nw_, lane);
#if SAMPLE_IN_SEQ
        for (int it = wr_; it < NB_S * 32; it += nw_) sample_wave<MIX>(p, lds + LDS_BYTES - 4096 + (wave - 2) * 2048, lane, it);
#endif
    }
    constexpr int NSW = (MIX == 2) ? 2 : 1;
    for (int lap = wave; do_seq && wave < NSW && lap * (int)gridDim.x + (int)blockIdx.x < 8 * NT * ((NB_P * NH + 7) / 8); lap += NSW) {
        const int slot = lap * (int)gridDim.x + (int)blockIdx.x;
        const int bh = ((slot >> 3) / NT) * 8 + (slot & 7), vt = (slot >> 3) % NT, b = bh / NH, h = bh % NH;
        if (bh >= NB_P * NH) continue;
        const bool ntile = (MIX == 2) && (vt == NVT);
        const int row0 = b * T_P;
        f32x4 S[8];
#pragma unroll
        for (int kt = 0; kt < 8; ++kt) S[kt] = (f32x4){0.f, 0.f, 0.f, 0.f};
        float mprev = 0.f;
        const size_t ci0 = (size_t)bh * NCH;
        bf16x8 qf[4], wf[4]; u32x4 kf[4]; u32x2 afb; f32x4 aff; u32x2 vfb; f32x4 uf; f32x4 df[8]; float dsc = 1.f;
        f32x4 c4, g4, b4; float grow = 0.f, g15 = 0.f, b15 = 0.f;
        bf16x8 nqf[4], nwf[4]; u32x4 nkf[4]; u32x2 nafb; f32x4 naff; u32x2 nvfb; f32x4 nuf; f32x4 ndf[8]; float ndsc = 1.f;
        f32x4 nc4, ng4, nb4; float ngrow = 0.f, ng15 = 0.f, nb15 = 0.f;
        constexpr int RING = (MIX == 2) ? 3 : (MIX == 1) ? 4 : 5;
        constexpr int NDMA = (MIX == 1) ? 15 : 11;
        constexpr int AOFF = (MIX == 1) ? 12288 : 8192, VOFF = AOFF + 1024, DOFF = AOFF + 2048, SLOT = AOFF + 3072;
        constexpr int OG = (MIX == 2) ? 4 : 8;
        constexpr int WAVE_LDS = RING_BYTES_OF(MIX) + OG * 1024;
        static_assert(((MIX == 2) ? 2 : 1) * WAVE_LDS <= LDS_BYTES - 4096, "chunk-walk rings overlap the sample-step scratch");
        unsigned char* ring = lds + ((MIX == 2) ? wave * WAVE_LDS : 0);
        float* ostage = (float*)(ring + RING_BYTES_OF(MIX));
        const int vsel = ntile ? 0 : vt;
#define SEQ_DMA(cc_) do { const size_t ci = ci0 + (cc_); unsigned char* sl_ = ring + ((cc_) % RING) * SLOT; \
        { const unsigned char* g_ = ws + OFF_QF + ci * 4096 + lane * 16; _Pragma("unroll") for (int m = 0; m < 4; ++m) __builtin_amdgcn_global_load_lds((const unsigned*)(g_ + m * 1024), (LDSP unsigned*)(sl_ + m * 1024), 16, 0, 0); } \
        { const unsigned char* g_ = ws + OFF_KF + ci * 4096 + lane * 16; _Pragma("unroll") for (int m = 0; m < 4; ++m) __builtin_amdgcn_global_load_lds((const unsigned*)(g_ + m * 1024), (LDSP unsigned*)(sl_ + 4096 + m * 1024), 16, 0, 0); } \
        if (MIX == 1) { const unsigned char* g_ = ws + OFF_WF + ci * 4096 + lane * 16; _Pragma("unroll") for (int m = 0; m < 4; ++m) __builtin_amdgcn_global_load_lds((const unsigned*)(g_ + m * 1024), (LDSP unsigned*)(sl_ + 8192 + m * 1024), 16, 0, 0); } \
        __builtin_amdgcn_global_load_lds((const unsigned*)(ws + OFF_AF + ci * 1024 + lane * 16), (LDSP unsigned*)(sl_ + AOFF), 16, 0, 0); \
        __builtin_amdgcn_global_load_lds((const unsigned*)(ws + OFF_VF + ci * (32 * DV) + (vsel >> 1) * 1024 + lane * 16), (LDSP unsigned*)(sl_ + VOFF), 16, 0, 0); \
        __builtin_amdgcn_global_load_lds((const unsigned*)(ws + OFF_DF + ci * 512 + lane * 16), (LDSP unsigned*)(sl_ + DOFF), 16, 0, 0); } while (0)
#define SEQ_LOAD(cc_, Q_, W_, K_, AB_, AFF_, VB_, U_, D_, DS_, C4_, G4_, B4_, GR_, G15_, B15_) do { const unsigned char* sl_ = ring + ((cc_) % RING) * SLOT; \
        _Pragma("unroll") for (int m = 0; m < 4; ++m) Q_[m] = *(const bf16x8*)(sl_ + m * 1024 + lane * 16); \
        _Pragma("unroll") for (int i = 0; i < 4; ++i) K_[i] = *(const u32x4*)(sl_ + 4096 + lane * 64 + i * 16); \
        if (MIX == 1) { _Pragma("unroll") for (int m = 0; m < 4; ++m) W_[m] = *(const bf16x8*)(sl_ + 8192 + m * 1024 + lane * 16); \
                        { const u32x2 uw_ = *(const u32x2*)(sl_ + VOFF + (vt & 1) * 512 + lane * 8); U_ = (f32x4){__uint_as_float(uw_.x << 16), __uint_as_float(uw_.x & 0xffff0000u), __uint_as_float(uw_.y << 16), __uint_as_float(uw_.y & 0xffff0000u)}; } DS_ = *(const float*)(sl_ + DOFF); } \
        if (MIX == 2) { AFF_ = *(const f32x4*)(sl_ + AOFF + lane * 16); const float* CG = (const float*)(sl_ + DOFF); \
                        C4_ = *(const f32x4*)(CG + 4 * q); G4_ = *(const f32x4*)(CG + 16 + 4 * q); B4_ = *(const f32x4*)(CG + 32 + 4 * q); GR_ = CG[16 + c]; G15_ = CG[31]; B15_ = CG[47]; } \
        else AB_ = *(const u32x2*)(sl_ + AOFF + lane * 8); \
        if (MIX != 1 && !ntile) VB_ = *(const u32x2*)(sl_ + VOFF + (vt & 1) * 512 + lane * 8); \
        if (MIX == 0 || MIX == 3) { _Pragma("unroll") for (int kt = 0; kt < 8; ++kt) D_[kt] = *(const f32x4*)(sl_ + DOFF + q * 128 + kt * 16); } \
    } while (0)
#define SEQ_VMWAIT(n_) asm volatile("s_waitcnt vmcnt(%0)" :: "n"(n_) : "memory")
        asm volatile("s_waitcnt lgkmcnt(0)" ::: "memory");
#pragma unroll
        for (int cc = 0; cc < RING; ++cc) SEQ_DMA(cc);
        SEQ_VMWAIT((RING - 1) * NDMA);
        SEQ_LOAD(0, qf, wf, kf, afb, aff, vfb, uf, df, dsc, c4, g4, b4, grow, g15, b15);
        for (int ch = 0; ch < NCH; ++ch) {
            const int chn = (ch + 1 < NCH) ? ch + 1 : ch;
            if (ch + RING - 1 < NCH) SEQ_VMWAIT((RING - 2) * NDMA); else SEQ_VMWAIT(0);
            asm volatile("s_waitcnt lgkmcnt(0)" ::: "memory");
            if (ch + RING < NCH) SEQ_DMA(ch + RING);
            SEQ_LOAD(chn, nqf, nwf, nkf, nafb, naff, nvfb, nuf, ndf, ndsc, nc4, ng4, nb4, ngrow, ng15, nb15);
            bf16x8 Bs[4];
#pragma unroll
            for (int m = 0; m < 4; ++m) {
                u32x4 w; w.x = cvt_pk_bf16(S[2 * m][0], S[2 * m][1]); w.y = cvt_pk_bf16(S[2 * m][2], S[2 * m][3]);
                w.z = cvt_pk_bf16(S[2 * m + 1][0], S[2 * m + 1][1]); w.w = cvt_pk_bf16(S[2 * m + 1][2], S[2 * m + 1][3]);
                Bs[m] = __builtin_bit_cast(bf16x8, w);
            }
            f32x4 o;
            const f32x4 zero4 = (f32x4){0.f, 0.f, 0.f, 0.f};
            if (LITE) {
                unsigned acc_ = 0;
#pragma unroll
                for (int m = 0; m < 4; ++m) { const u32x4 t_ = __builtin_bit_cast(u32x4, qf[m]); acc_ ^= t_.x ^ t_.y ^ t_.z ^ t_.w ^ kf[m].x ^ kf[m].y ^ kf[m].z ^ kf[m].w; }
                acc_ ^= afb.x ^ vfb.x ^ __float_as_uint(df[0][0]) ^ __float_as_uint(df[7][3]) ^ __float_as_uint(uf[0]) ^ __float_as_uint(aff[1]) ^ __float_as_uint(dsc) ^ __float_as_uint(grow);
                o = (f32x4){__uint_as_float(acc_ & 0x3fffffffu), 0.f, 0.f, 0.f};
            } else
            if (MIX == 0 || MIX == 3) {
                const bf16x4 vb = __builtin_bit_cast(bf16x4, vfb);
                o = mfma16(__builtin_bit_cast(bf16x4, afb), vb, zero4, 0, 0, 0);
#pragma unroll
                for (int m = 0; m < 4; ++m) o = __builtin_amdgcn_mfma_f32_16x16x32_bf16(qf[m], Bs[m], o, 0, 0, 0);
#pragma unroll
                for (int kt = 0; kt < 8; ++kt) {
                    u32x2 kw; kw.x = kf[kt >> 1][(kt & 1) * 2]; kw.y = kf[kt >> 1][(kt & 1) * 2 + 1];
                    S[kt] = mfma16(__builtin_bit_cast(bf16x4, kw), vb, S[kt] * df[kt], 0, 0, 0);
                }
            } else if (MIX == 1) {
                f32x4 wsum = zero4;
#pragma unroll
                for (int m = 0; m < 4; ++m) wsum = __builtin_amdgcn_mfma_f32_16x16x32_bf16(wf[m], Bs[m], wsum, 0, 0, 0);
                const f32x4 vp = uf - wsum;
                u32x2 vw; vw.x = cvt_pk_bf16(vp[0], vp[1]); vw.y = cvt_pk_bf16(vp[2], vp[3]);
                const bf16x4 vb = __builtin_bit_cast(bf16x4, vw);
                o = mfma16(__builtin_bit_cast(bf16x4, afb), vb, zero4, 0, 0, 0);
#pragma unroll
                for (int m = 0; m < 4; ++m) o = __builtin_amdgcn_mfma_f32_16x16x32_bf16(qf[m], Bs[m], o, 0, 0, 0);
#pragma unroll
                for (int kt = 0; kt < 8; ++kt) {
                    u32x2 kw; kw.x = kf[kt >> 1][(kt & 1) * 2]; kw.y = kf[kt >> 1][(kt & 1) * 2 + 1];
                    S[kt] = mfma16(__builtin_bit_cast(bf16x4, kw), vb, S[kt] * dsc, 0, 0, 0);
                }
            } else {
                const float mrow = fmaxf(mprev, grow);
                u32x2 aw; aw.x = cvt_pk_bf16(aff[0] * expf(fminf(c4[0] - mrow, 0.f)), aff[1] * expf(fminf(c4[1] - mrow, 0.f)));
                aw.y = cvt_pk_bf16(aff[2] * expf(fminf(c4[2] - mrow, 0.f)), aff[3] * expf(fminf(c4[3] - mrow, 0.f)));
                f32x4 mr, aint;
#pragma unroll
                for (int r = 0; r < 4; ++r) { mr[r] = fmaxf(mprev, g4[r]); aint[r] = expf(mprev - mr[r]); }
                const float m15 = fmaxf(mprev, g15), lam = expf(g15 - m15), aend = expf(mprev - m15);
                bf16x4 vb, vbl;
                if (ntile) {
                    const unsigned one = (c == 0) ? 0x3f803f80u : 0u;
                    u32x2 t1; t1.x = one; t1.y = one; vb = __builtin_bit_cast(bf16x4, t1);
                    const float lv = (c == 0) ? lam : 0.f;
                    u32x2 t2; t2.x = cvt_pk_bf16(lv, lv); t2.y = t2.x; vbl = __builtin_bit_cast(bf16x4, t2);
                } else {
                    vb = __builtin_bit_cast(bf16x4, vfb);
                    u32x2 t2; t2.x = cvt_pk_bf16(__uint_as_float(vfb.x << 16) * lam, __uint_as_float(vfb.x & 0xffff0000u) * lam);
                    t2.y = cvt_pk_bf16(__uint_as_float(vfb.y << 16) * lam, __uint_as_float(vfb.y & 0xffff0000u) * lam);
                    vbl = __builtin_bit_cast(bf16x4, t2);
                }
                const f32x4 o1 = mfma16(__builtin_bit_cast(bf16x4, aw), vb, zero4, 0, 0, 0);
                f32x4 o2 = zero4;
#pragma unroll
                for (int m = 0; m < 4; ++m) o2 = __builtin_amdgcn_mfma_f32_16x16x32_bf16(qf[m], Bs[m], o2, 0, 0, 0);
                o = o1 + aint * o2;
#pragma unroll
                for (int kt = 0; kt < 8; ++kt) {
                    u32x2 kw; kw.x = kf[kt >> 1][(kt & 1) * 2]; kw.y = kf[kt >> 1][(kt & 1) * 2 + 1];
                    S[kt] = mfma16(__builtin_bit_cast(bf16x4, kw), vbl, S[kt] * aend, 0, 0, 0);
                }
                if (ntile && c == 0) {
#pragma unroll
                    for (int r = 0; r < 4; ++r) { const int rr = (ch % OG) * 16 + 4 * q + r; ostage[rr * 2] = o[r]; ostage[rr * 2 + 1] = b4[r] + mr[r]; }
                }
                mprev = b15 + m15;
            }
            if (!ntile) {
#pragma unroll
                for (int r = 0; r < 4; ++r) ostage[((ch % OG) * 16 + 4 * q + r) * 16 + c] = o[r];
            }
            if ((ch % OG) == OG - 1 || ch == NCH - 1) {
                const int nst = (ch % OG) + 1, chb = ch - (ch % OG);
                asm volatile("s_waitcnt lgkmcnt(0)" ::: "memory");
                if (!ntile) {
                    for (int j = 0; j < nst; ++j) {
                        const f32x4 v = *(const f32x4*)(ostage + (j * 16 + (lane >> 2)) * 16 + (lane & 3) * 4);
                        u32x2 w; w.x = cvt_pk_bf16(v[0], v[1]); w.y = cvt_pk_bf16(v[2], v[3]);
                        *(u32x2*)((bf16_t*)O + (size_t)(row0 + (chb + j) * 16 + (lane >> 2)) * 1024 + h * DV + vt * 16 + (lane & 3) * 4) = w;
                    }
                } else {
                    float* DEN = (float*)(ws + OFF_DEN); float* MT = (float*)(ws + OFF_MT);
                    for (int rr = lane; rr < nst * 16; rr += 64) { const size_t row = (size_t)(row0 + chb * 16 + rr); DEN[row * 8 + h] = ostage[rr * 2]; MT[row * 8 + h] = ostage[rr * 2 + 1]; }
                }
            }
#pragma unroll
            for (int m = 0; m < 4; ++m) { qf[m] = nqf[m]; wf[m] = nwf[m]; kf[m] = nkf[m]; }
#pragma unroll
            for (int kt = 0; kt < 8; ++kt) df[kt] = ndf[kt];
            afb = nafb; aff = naff; vfb = nvfb; uf = nuf; dsc = ndsc; c4 = nc4; g4 = ng4; b4 = nb4; grow = ngrow; g15 = ng15; b15 = nb15;
        }
#undef SEQ_LOAD
#undef SEQ_DMA
#undef SEQ_VMWAIT
        asm volatile("s_waitcnt vmcnt(0) lgkmcnt(0)" ::: "memory");
        if (!ntile) {
            float* out_S = p.out + ((MIX == 0) ? OUT_P_HGRN : (MIX == 1) ? OUT_P_GDN : (MIX == 2) ? OUT_P_MC : OUT_P_GLA) + (size_t)bh * 128 * DV;
#pragma unroll
            for (int kt = 0; kt < 8; ++kt)
#pragma unroll
                for (int r = 0; r < 4; ++r) out_S[(size_t)(16 * kt + 4 * q + r) * DV + vt * 16 + c] = S[kt][r];
        } else if (c == 0) {
            float* on = p.out + OUT_P_MN + (size_t)bh * 128;
#pragma unroll
            for (int kt = 0; kt < 8; ++kt)
#pragma unroll
                for (int r = 0; r < 4; ++r) on[16 * kt + 4 * q + r] = S[kt][r];
            if (q == 0) p.out[OUT_P_MM + bh] = mprev;
        }
    }
}

template <int MIX>
__device__ __forceinline__ void normgate_phase(const Params& p) {
    const int TID = opaque_tid();
    unsigned char* ws = opaque_ptr(p.ws);
    const bf16_t* P = (const bf16_t*)(ws + OFF_P);
    const float* O = (const float*)(ws + OFF_O);
    bf16_t* A2 = (bf16_t*)(ws + OFF_A2);
    const int wave = TID >> 6, lane = TID & 63;
    const float* ng = (MIX == 0) ? p.in[12] : (MIX == 1) ? p.in[18] : (MIX == 2) ? p.in[23] : p.in[28];
    constexpr int GOFF = (MIX == 0) ? 3072 : (MIX == 1) ? 3088 : (MIX == 2) ? 3088 : 2048;
    constexpr int R = 3;
    const int stride = gridDim.x * 4;
    const int c0 = lane * 16;
    for (int row0 = blockIdx.x * 4 + wave; row0 < MTOK; row0 += stride * R) {
        f32x4 ov[R][4]; u32x2 gw[R][4]; float denv[R], mtv[R];
#pragma unroll
        for (int u = 0; u < R; ++u) {
            const int row = (row0 + u * stride < MTOK) ? row0 + u * stride : row0;
#pragma unroll
            for (int j = 0; j < 4; ++j) {
                ov[u][j] = ldbf4((const bf16_t*)O + (size_t)row * 1024 + c0 + j * 4);
                gw[u][j] = *(const u32x2*)(P + (size_t)row * PLD + GOFF + c0 + j * 4);
            }
            if (MIX == 2) { denv[u] = ((const float*)(ws + OFF_DEN))[(size_t)row * 8 + (lane >> 3)]; mtv[u] = ((const float*)(ws + OFF_MT))[(size_t)row * 8 + (lane >> 3)]; }
        }
#pragma unroll
        for (int u = 0; u < R; ++u) {
            const int row = row0 + u * stride;
            if (row < MTOK) {
                float x[16], gt[16];
#pragma unroll
                for (int j = 0; j < 4; ++j) {
                    const f32x4 gg = (f32x4){__uint_as_float(gw[u][j].x << 16), __uint_as_float(gw[u][j].x & 0xffff0000u), __uint_as_float(gw[u][j].y << 16), __uint_as_float(gw[u][j].y & 0xffff0000u)};
#pragma unroll
                    for (int q = 0; q < 4; ++q) { x[j * 4 + q] = ov[u][j][q]; gt[j * 4 + q] = gg[q]; }
                }
                if (MIX == 2) {
                    const float inv = 1.f / fmaxf(fabsf(denv[u]), expf(-mtv[u]));
#pragma unroll
                    for (int j = 0; j < 16; ++j) x[j] *= inv;
                }
                float s1 = 0.f, s2 = 0.f;
#pragma unroll
                for (int j = 0; j < 16; ++j) { s1 += x[j]; s2 += x[j] * x[j]; }
                s1 += __shfl_xor(s1, 1); s1 += __shfl_xor(s1, 2); s1 += __shfl_xor(s1, 4);
                s2 += __shfl_xor(s2, 1); s2 += __shfl_xor(s2, 2); s2 += __shfl_xor(s2, 4);
                if (MIX == 3) { s1 += __shfl_xor(s1, 8); s2 += __shfl_xor(s2, 8); }
                constexpr float invn = (MIX == 3) ? (1.f / 256.f) : (1.f / 128.f);
                float outv[16];
                if (MIX == 2) {
                    const float mean = s1 * invn;
                    float q2 = 0.f;
#pragma unroll
                    for (int j = 0; j < 16; ++j) { const float d = x[j] - mean; q2 += d * d; }
                    q2 += __shfl_xor(q2, 1); q2 += __shfl_xor(q2, 2); q2 += __shfl_xor(q2, 4);
                    const float rs = rsqrtf(q2 * invn + 1e-6f);
#pragma unroll
                    for (int j = 0; j < 16; ++j) outv[j] = sigmoidf_(gt[j]) * ((x[j] - mean) * rs * ng[c0 + j]);
                } else {
                    const float rs = rsqrtf(s2 * invn + 1e-6f);
#pragma unroll
                    for (int j = 0; j < 16; ++j) {
                        const int gi = (MIX == 3) ? ((c0 + j) & 255) : ((c0 + j) & 127);
                        outv[j] = x[j] * rs * ng[gi] * siluf_(gt[j]);
                    }
                }
                uint4 w0, w1;
                w0.x = pack2bf(outv[0], outv[1]); w0.y = pack2bf(outv[2], outv[3]); w0.z = pack2bf(outv[4], outv[5]); w0.w = pack2bf(outv[6], outv[7]);
                w1.x = pack2bf(outv[8], outv[9]); w1.y = pack2bf(outv[10], outv[11]); w1.z = pack2bf(outv[12], outv[13]); w1.w = pack2bf(outv[14], outv[15]);
                *(uint4*)(A2 + (size_t)row * 1024 + c0) = w0; *(uint4*)(A2 + (size_t)row * 1024 + c0 + 8) = w1;
            }
        }
    }
    if (MIX == 1) {
        const float* cbuf = p.in[4];
        const int total = NSEQ * 3 * 3072;
        for (int i = blockIdx.x * NTH + TID; i < total; i += gridDim.x * NTH) {
            const int seq = i / (3 * 3072), rem = i % (3 * 3072), j = rem / 3072, cc = rem % 3072;
            if (seq < NB_P) p.out[OUT_P_CONV + (size_t)i] = bf2f(P[(size_t)(seq * T_P + T_P - 3 + j) * PLD + cc]);
            else {
                const int ss = seq - NB_P;
                const float v = (j < 2) ? cbuf[((size_t)ss * 3 + j + 1) * 3072 + cc] : bf2f(P[(size_t)(ROWS_P + ss) * PLD + cc]);
                p.out[OUT_S_CONV + ((size_t)ss * 3 + j) * 3072 + cc] = v;
            }
        }
    }
}

__device__ __forceinline__ void ln_phase(const Params& p, int layer, int which, bool dry) {
    const int TID = opaque_tid();
    unsigned char* ws = opaque_ptr(p.ws);
    const bf16_t* Hin = (const bf16_t*)(ws + OFF_HB);
    bf16_t* Hb = dry ? (bf16_t*)(ws + OFF_DRY + (size_t)MTOK * 4096) : (bf16_t*)(ws + OFF_HB);
    const float* Y = (const float*)(ws + OFF_O);
    const bf16_t* Fb = (const bf16_t*)(ws + OFF_F);
    const float* lg = p.in[35] + (size_t)(layer * 2 + which) * 1024;
    const float* lbias = p.in[36] + (size_t)(layer * 2 + which) * 1024;
    const int wave = TID >> 6, lane = TID & 63;
    constexpr int R = 3;
    const int stride = gridDim.x * 4;
    f32x4 gv[4], bv[4];
#pragma unroll
    for (int j = 0; j < 4; ++j) { gv[j] = *(const f32x4*)(lg + j * 256 + lane * 4); bv[j] = *(const f32x4*)(lbias + j * 256 + lane * 4); }
    for (int row0 = blockIdx.x * 4 + wave; row0 < MTOK; row0 += stride * R) {
        u32x2 hw[R][4], fw[R][4]; f32x4 yv[R][4];
#pragma unroll
        for (int u = 0; u < R; ++u) {
            const int row = (row0 + u * stride < MTOK) ? row0 + u * stride : row0;
#pragma unroll
            for (int j = 0; j < 4; ++j) {
                hw[u][j] = *(const u32x2*)(Hin + (size_t)row * 1024 + j * 256 + lane * 4);
                if (which) fw[u][j] = *(const u32x2*)(Fb + (size_t)row * 1024 + j * 256 + lane * 4);
                else yv[u][j] = *(const f32x4*)(Y + (size_t)row * 1024 + j * 256 + lane * 4);
            }
        }
#pragma unroll
        for (int u = 0; u < R; ++u) {
            const int row = row0 + u * stride;
            if (row < MTOK) {
                float z[16];
                float s1 = 0.f;
#pragma unroll
                for (int j = 0; j < 4; ++j) {
                    const f32x4 hv = (f32x4){__uint_as_float(hw[u][j].x << 16), __uint_as_float(hw[u][j].x & 0xffff0000u), __uint_as_float(hw[u][j].y << 16), __uint_as_float(hw[u][j].y & 0xffff0000u)};
                    f32x4 y4;
                    if (which) y4 = (f32x4){__uint_as_float(fw[u][j].x << 16), __uint_as_float(fw[u][j].x & 0xffff0000u), __uint_as_float(fw[u][j].y << 16), __uint_as_float(fw[u][j].y & 0xffff0000u)};
                    else y4 = yv[u][j];
#pragma unroll
                    for (int q = 0; q < 4; ++q) { z[j * 4 + q] = DN_ALPHA * hv[q] + y4[q]; s1 += z[j * 4 + q]; }
                }
                const float mean = wave_sum(s1) * (1.f / 1024.f);
                float s2 = 0.f;
#pragma unroll
                for (int j = 0; j < 16; ++j) { const float d = z[j] - mean; s2 += d * d; }
                const float rs = rsqrtf(wave_sum(s2) * (1.f / 1024.f) + 1e-5f);
                float o[16];
#pragma unroll
                for (int j = 0; j < 16; ++j) o[j] = (z[j] - mean) * rs * gv[j >> 2][j & 3] + bv[j >> 2][j & 3];
                if (!(which == 1 && layer == 3 && !dry))
#pragma unroll
                for (int j = 0; j < 4; ++j) { u32x2 w; w.x = pack2bf(o[4 * j], o[4 * j + 1]); w.y = pack2bf(o[4 * j + 2], o[4 * j + 3]); *(u32x2*)(Hb + (size_t)row * 1024 + j * 256 + lane * 4) = w; }
                if (which == 0 && !dry) {
#pragma unroll
                    for (int j = 0; j < 4; ++j)
                        *(unsigned*)(ws + OFF_HQ + (size_t)row * 1024 + j * 256 + lane * 4) = pack_i8x4(o[4 * j] * (1.f / XQ_SCALE), o[4 * j + 1] * (1.f / XQ_SCALE), o[4 * j + 2] * (1.f / XQ_SCALE), o[4 * j + 3] * (1.f / XQ_SCALE));
                }
                if (which == 1 && layer == 3 && !dry) {
                    float* dst = nullptr;
                    if (row < ROWS_P) { const int b = row / T_P, t = row % T_P; if (t >= 16) dst = p.out + OUT_YP + ((size_t)b * 2048 + (t - 16)) * 1024; }
                    else dst = p.out + OUT_YS + (size_t)(row - ROWS_P) * 1024;
                    if (dst) {
#pragma unroll
                        for (int j = 0; j < 4; ++j) *(f32x4*)(dst + j * 256 + lane * 4) = (f32x4){o[j * 4], o[j * 4 + 1], o[j * 4 + 2], o[j * 4 + 3]};
                    }
                }
            }
        }
    }
}

#define KINS16(V, x_) do { const float xk_ = (x_); \
    _Pragma("unroll") for (int q_ = 15; q_ >= 1; --q_) V[q_] = __builtin_amdgcn_fmed3f(V[q_ - 1], V[q_], xk_); \
    V[0] = fmaxf(V[0], xk_); } while (0)
__device__ __forceinline__ float key_pack(float v, unsigned mask, unsigned id) { return __uint_as_float((__float_as_uint(v) & ~mask) | id); }
__device__ __forceinline__ float key_val(float k, unsigned mask) { return __uint_as_float(__float_as_uint(k) & ~mask); }

__device__ __forceinline__ void topk_phase(const Params& p) {
    const int TID = opaque_tid();
    unsigned char* ws = opaque_ptr(p.ws);
    const float* S1 = (const float*)(ws + OFF_S1);
    const float* S2 = (const float*)(ws + OFF_S2);
    int* TI = (int*)(ws + OFF_TI);
    float* TW = (float*)(ws + OFF_TW);
    const int NR = MTOK * 8;
    for (int r = blockIdx.x * NTH + TID; r < NR; r += gridDim.x * NTH) {
        float k1[16], k2[16];
#pragma unroll
        for (int q = 0; q < 16; ++q) { k1[q] = -INFINITY; k2[q] = -INFINITY; }
        const float* s1p = S1 + (size_t)(r >> 7) * 16384 + (r & 127);
        const float* s2p = S2 + (size_t)(r >> 7) * 16384 + (r & 127);
#pragma unroll 1
        for (int jb = 0; jb < 128; jb += 16) {
            float xs[16], ys[16];
#pragma unroll
            for (int j = 0; j < 16; ++j) { xs[j] = s1p[(jb + j) * 128]; ys[j] = s2p[(jb + j) * 128]; }
#pragma unroll
            for (int j = 0; j < 16; ++j) { KINS16(k1, key_pack(xs[j], 127u, (unsigned)(jb + j))); KINS16(k2, key_pack(ys[j], 127u, (unsigned)(jb + j))); }
        }
        float kc[16];
#pragma unroll
        for (int q = 0; q < 16; ++q) kc[q] = -INFINITY;
        {
            int slot = 0;
#pragma unroll
            for (int a = 0; a < 16; ++a)
#pragma unroll
                for (int b = 0; b < 16; ++b)
                    if ((a + 1) * (b + 1) <= 16) { const float sv = key_val(k1[a], 127u) + key_val(k2[b], 127u); KINS16(kc, key_pack(sv, 63u, (unsigned)slot)); ++slot; }
        }
        const float tau = kc[15], vmax = key_val(k1[0], 127u) + key_val(k2[0], 127u);
        float sum = 0.f;
        {
            int slot = 0;
#pragma unroll
            for (int a = 0; a < 16; ++a)
#pragma unroll
                for (int b = 0; b < 16; ++b)
                    if ((a + 1) * (b + 1) <= 16) { const float sv = key_val(k1[a], 127u) + key_val(k2[b], 127u); const bool sel = key_pack(sv, 63u, (unsigned)slot) >= tau; sum += sel ? __expf(sv - vmax) : 0.f; ++slot; }
        }
        const float inv = 1.f / sum;
        {
            int slot = 0, cnt = 0;
#pragma unroll
            for (int a = 0; a < 16; ++a)
#pragma unroll
                for (int b = 0; b < 16; ++b)
                    if ((a + 1) * (b + 1) <= 16) {
                        const float sv = key_val(k1[a], 127u) + key_val(k2[b], 127u); const bool sel = key_pack(sv, 63u, (unsigned)slot) >= tau;
                        if (sel) { TI[(size_t)r * 16 + cnt] = (int)(((__float_as_uint(k1[a]) & 127u) << 7) | (__float_as_uint(k2[b]) & 127u)); TW[(size_t)r * 16 + cnt] = __expf(sv - vmax) * inv; ++cnt; }
                        ++slot;
                    }
        }
    }
}

constexpr int ST_RS = 68;
constexpr int ST_BYTES = 64 * ST_RS * 4;
static_assert(4 * ST_BYTES <= LDS_BYTES, "score tiles exceed the LDS budget");
__device__ __forceinline__ void scoretopk_phase(const Params& p, int layer, unsigned char* lds) {
    const int TID = opaque_tid();
    unsigned char* ws = opaque_ptr(p.ws);
    const int wave = TID >> 6, lane = TID & 63, q = lane >> 4, c = lane & 15;
    const bf16_t* Q = (const bf16_t*)(ws + OFF_Q);
    const bf16_t* keys = (const bf16_t*)(ws + OFF_KEYS) + (size_t)layer * 2 * 16384;
    unsigned short* TI = (unsigned short*)(ws + OFF_TI);
    float* TW = (float*)(ws + OFF_TW);
    float* st = (float*)(lds + wave * ST_BYTES);
    for (int item = blockIdx.x * 4 + wave; item < 2048; item += gridDim.x * 4) {
        const int r0 = item * 65;
        float k1[16], k2[16];
#pragma unroll
        for (int i = 0; i < 16; ++i) { k1[i] = -INFINITY; k2[i] = -INFINITY; }
        float xe[4];
#pragma unroll
        for (int ph = 0; ph < 2; ++ph) {
            bf16x8 a[5][4];
#pragma unroll
            for (int rt = 0; rt < 5; ++rt)
#pragma unroll
                for (int ks = 0; ks < 4; ++ks) a[rt][ks] = *(const bf16x8*)(Q + (size_t)(r0 + 16 * rt + c) * 256 + ph * 128 + ks * 32 + q * 8);
#pragma unroll
            for (int kh = 0; kh < 2; ++kh) {
#pragma unroll
                for (int kt = 0; kt < 4; ++kt) {
                    f32x4 acc[5];
#pragma unroll
                    for (int rt = 0; rt < 5; ++rt) acc[rt] = (f32x4){0.f, 0.f, 0.f, 0.f};
#pragma unroll
                    for (int ks = 0; ks < 4; ++ks) {
                        const bf16x8 b = *(const bf16x8*)(keys + ph * 16384 + (size_t)(kh * 64 + kt * 16 + c) * 128 + ks * 32 + q * 8);
#pragma unroll
                        for (int rt = 0; rt < 5; ++rt) acc[rt] = __builtin_amdgcn_mfma_f32_16x16x32_bf16(a[rt][ks], b, acc[rt], 0, 0, 0);
                    }
#pragma unroll
                    for (int rt = 0; rt < 4; ++rt) *(f32x4*)(st + (kt * 16 + c) * ST_RS + 16 * rt + 4 * q) = acc[rt];
                    if (q == 0) st[(kt * 16 + c) * ST_RS + 64] = acc[4][0];
                }
#pragma unroll 1
                for (int jb = 0; jb < 64; jb += 16) {
                    float xs[16];
#pragma unroll
                    for (int j = 0; j < 16; ++j) xs[j] = st[(jb + j) * ST_RS + lane];
#pragma unroll
                    for (int j = 0; j < 16; ++j) {
                        const float kx = key_pack(xs[j], 127u, (unsigned)(kh * 64 + jb + j));
                        if (ph == 0) KINS16(k1, kx); else KINS16(k2, kx);
                    }
                }
                xe[ph * 2 + kh] = key_pack(st[lane * ST_RS + 64], 127u, (unsigned)(kh * 64 + lane));
            }
        }
        {
            const int r = r0 + lane;
            float kc[16];
#pragma unroll
            for (int i = 0; i < 16; ++i) kc[i] = -INFINITY;
            unsigned ia_[16], ib_[16];
#pragma unroll
            for (int i = 0; i < 16; ++i) { ia_[i] = (__float_as_uint(k1[i]) & 127u) << 7; ib_[i] = __float_as_uint(k2[i]) & 127u; }
#pragma unroll
            for (int a_ = 0; a_ < 16; ++a_)
#pragma unroll
                for (int b_ = 0; b_ < 16; ++b_)
                    if ((a_ + 1) * (b_ + 1) <= 16) { const float sv = key_val(k1[a_], 127u) + key_val(k2[b_], 127u); KINS16(kc, key_pack(sv, 0x3fffu, ia_[a_] | ib_[b_])); }
            const float vmax = key_val(kc[0], 0x3fffu);
            float ew[16], sum = 0.f;
#pragma unroll
            for (int i = 0; i < 16; ++i) { ew[i] = __expf(key_val(kc[i], 0x3fffu) - vmax); sum += ew[i]; }
            const float inv = 1.f / sum;
            u32x4 t0, t1;
#pragma unroll
            for (int i = 0; i < 4; ++i) {
                t0[i] = (__float_as_uint(kc[2 * i]) & 0x3fffu) | ((__float_as_uint(kc[2 * i + 1]) & 0x3fffu) << 16);
                t1[i] = (__float_as_uint(kc[8 + 2 * i]) & 0x3fffu) | ((__float_as_uint(kc[8 + 2 * i + 1]) & 0x3fffu) << 16);
            }
            *(u32x4*)(TI + (size_t)r * 16) = t0; *(u32x4*)(TI + (size_t)r * 16 + 8) = t1;
#pragma unroll
            for (int i = 0; i < 4; ++i) *(f32x4*)(TW + (size_t)r * 16 + 4 * i) = (f32x4){ew[4 * i] * inv, ew[4 * i + 1] * inv, ew[4 * i + 2] * inv, ew[4 * i + 3] * inv};
        }
        {
            const int r = r0 + 64;
            float l1[16], l2[16];
            float xa = xe[0], xb = xe[1], ya = xe[2], yb = xe[3];
#pragma unroll
            for (int i = 0; i < 16; ++i) {
                const float m1 = wave_max_u(fmaxf(xa, xb)), m2 = wave_max_u(fmaxf(ya, yb));
                l1[i] = m1; l2[i] = m2;
                xa = (xa == m1) ? -INFINITY : xa; xb = (xb == m1) ? -INFINITY : xb;
                ya = (ya == m2) ? -INFINITY : ya; yb = (yb == m2) ? -INFINITY : yb;
            }
            const int s = lane;
            int ca, cb;
            if (s < 16) { ca = 0; cb = s; } else if (s < 24) { ca = 1; cb = s - 16; } else if (s < 29) { ca = 2; cb = s - 24; } else if (s < 33) { ca = 3; cb = s - 29; }
            else if (s < 36) { ca = 4; cb = s - 33; } else if (s < 42) { ca = 5 + ((s - 36) >> 1); cb = (s - 36) & 1; } else { ca = 8 + (s - 42); cb = 0; }
            float ka = l1[0], kb = l2[0];
#pragma unroll
            for (int i = 1; i < 16; ++i) { ka = (ca == i) ? l1[i] : ka; kb = (cb == i) ? l2[i] : kb; }
            const float sv = key_val(ka, 127u) + key_val(kb, 127u);
            const float ck = (s < 50) ? key_pack(sv, 0x3fffu, ((__float_as_uint(ka) & 127u) << 7) | (__float_as_uint(kb) & 127u)) : -INFINITY;
            float cx = ck, mine = 0.f, vmax = 0.f, sum = 0.f;
#pragma unroll
            for (int i = 0; i < 16; ++i) {
                const float mx = wave_max_u(cx);
                cx = (cx == mx) ? -INFINITY : cx;
                if (i == 0) vmax = key_val(mx, 0x3fffu);
                sum += __expf(key_val(mx, 0x3fffu) - vmax);
                mine = (lane == i) ? mx : mine;
            }
            if (lane < 16) { TI[(size_t)r * 16 + lane] = (unsigned short)(__float_as_uint(mine) & 0x3fffu); TW[(size_t)r * 16 + lane] = __expf(key_val(mine, 0x3fffu) - vmax) / sum; }
        }
    }
}

__device__ __forceinline__ float gelu_erf(float d) { return 0.5f * d * (1.f + erff(d * 0.70710678118654752f)); }
#define XCD_BAR_WORDS 3456
constexpr int GQ_TW = 16;
constexpr int GQ_PER_SLICE = MTOK / (4 * GQ_TW);
__device__ __forceinline__ unsigned gq_xcc_id() { return (unsigned)__builtin_amdgcn_s_getreg((3 << 11) | 20) & 0xFu; }
__device__ __forceinline__ int queue_take(unsigned* cnt, int own, volatile LDSP int* bc, int tid) {
    if (tid == 0) {
        int it = -1;
        for (int k = 0; k < 8 && it < 0; ++k) {
            const int s_ = (own + k) & 7; unsigned* c = cnt + s_ * 16;
            if (__hip_atomic_load(c, __ATOMIC_RELAXED, __HIP_MEMORY_SCOPE_AGENT) < (unsigned)GQ_PER_SLICE) {
                const unsigned v = __hip_atomic_fetch_add(c, 1u, __ATOMIC_RELAXED, __HIP_MEMORY_SCOPE_AGENT);
                if (v < (unsigned)GQ_PER_SLICE) it = s_ * GQ_PER_SLICE + (int)v;
            }
        }
        bc[0] = it;
    }
    __syncthreads();
    const int it = bc[0];
    __syncthreads();
    return it;
}
__device__ __forceinline__ float dpp_add(float v, int ctrl_sel) {
    const int x = __builtin_bit_cast(int, v);
    int y;
    if (ctrl_sel == 0) y = __builtin_amdgcn_update_dpp(0, x, 0xB1, 0xF, 0xF, true);
    else if (ctrl_sel == 1) y = __builtin_amdgcn_update_dpp(0, x, 0x4E, 0xF, 0xF, true);
    else y = __builtin_amdgcn_update_dpp(0, x, 0x141, 0xF, 0xF, true);
    return v + __builtin_bit_cast(float, y);
}
__device__ __forceinline__ float sum8(float v) { v = dpp_add(v, 0); v = dpp_add(v, 1); v = dpp_add(v, 2); return v; }
#define CVT8(w_, lo_, hi_) const f32x2 lo_ = __builtin_amdgcn_cvt_pk_f32_fp8((int)(w_), false), hi_ = __builtin_amdgcn_cvt_pk_f32_fp8((int)(w_), true)

__device__ __forceinline__ void gatherU_phase(const Params& p, int layer, unsigned char* lds, int rep) {
    const int TID = opaque_tid();
    unsigned char* ws = opaque_ptr(p.ws);
    const unsigned char* Hq = ws + OFF_HQ;
    const unsigned short* TI = (const unsigned short*)(ws + OFF_TI);
    unsigned* cnt = (unsigned*)(ws + OFF_BAR) + XCD_BAR_WORDS + (layer * 4 + 0 + rep) * 128;
    const int wave = TID >> 6, lane = TID & 63, e = lane >> 3, c = lane & 7;
    const int own = (int)(gq_xcc_id() & 7u);
    auto process = [&](const int sl, const int tbase, const int ntok) {
        const unsigned char* Us = ws + OFF_UB + ((size_t)(layer * 8 + sl) * NEXP) * 128;
        bf16_t* PD = (bf16_t*)(ws + OFF_PD) + (size_t)sl * MTOK * 128;
        int i0 = TI[(size_t)tbase * 128 + lane], i1 = TI[(size_t)tbase * 128 + 64 + lane];
        u32x4 ub[16]; u32x4 xq, nxq;
        xq = *(const u32x4*)(Hq + (size_t)tbase * 1024 + sl * 128 + c * 16);
#pragma unroll
        for (int ii = 0; ii < 16; ++ii) { const int ej = __shfl((ii < 8) ? i0 : i1, (ii & 7) * 8 + e); ub[ii] = *(const u32x4*)(Us + (unsigned)(ej * 128 + c * 16)); }
        int n0 = TI[(size_t)(tbase + 1) * 128 + lane], n1 = TI[(size_t)(tbase + 1) * 128 + 64 + lane];
#pragma unroll 1
        for (int i = 0; i < ntok; ++i) {
            const int t = tbase + i, tn = tbase + ((i + 1 < ntok) ? i + 1 : ntok - 1), tnn = tbase + ((i + 2 < ntok) ? i + 2 : ntok - 1);
            nxq = *(const u32x4*)(Hq + (size_t)tn * 1024 + sl * 128 + c * 16);
            const int nn0 = TI[(size_t)tnn * 128 + lane], nn1 = TI[(size_t)tnn * 128 + 64 + lane];
            float k0 = 0.f, k1 = 0.f;
#pragma unroll
            for (int ii = 0; ii < 16; ++ii) {
                int di = __builtin_amdgcn_sdot4((int)ub[ii][0], (int)xq[0], 0, false);
                di = __builtin_amdgcn_sdot4((int)ub[ii][1], (int)xq[1], di, false);
                int dj = __builtin_amdgcn_sdot4((int)ub[ii][2], (int)xq[2], 0, false);
                dj = __builtin_amdgcn_sdot4((int)ub[ii][3], (int)xq[3], dj, false);
                float d = (float)(di + dj);
                { const int ej = __shfl((ii < 8) ? n0 : n1, (ii & 7) * 8 + e); ub[ii] = *(const u32x4*)(Us + (unsigned)(ej * 128 + c * 16)); }
                d = sum8(d);
                if (ii < 8) k0 = (ii == c) ? d : k0; else k1 = ((ii - 8) == c) ? d : k1;
            }
            PD[(size_t)t * 128 + c * 8 + e] = f2bf(k0);
            PD[(size_t)t * 128 + 64 + c * 8 + e] = f2bf(k1);
            xq = nxq; n0 = nn0; n1 = nn1;
        }
    };
    volatile LDSP unsigned* st_ = (volatile LDSP unsigned*)(lds + LDS_BYTES);
    if (st_[3] != 0u) {
        process(own, 65 * ((int)st_[2] * 4 + wave), 65);
    } else for (;;) {
        const int item = __builtin_amdgcn_readfirstlane(queue_take(cnt, own, (volatile LDSP int*)lds, TID));
        if (item < 0) break;
        process(item / GQ_PER_SLICE, (item % GQ_PER_SLICE) * (4 * GQ_TW) + wave * GQ_TW, GQ_TW);
    }
}

__device__ __forceinline__ void gatherW_phase(const Params& p, int layer) {
    const int TID = opaque_tid();
    unsigned char* ws = opaque_ptr(p.ws);
    const unsigned short* TI = (const unsigned short*)(ws + OFF_TI);
    const float* TW = (const float*)(ws + OFF_TW);
    bf16_t* TWb = (bf16_t*)(ws + OFF_TI + (size_t)MTOK * 128 * 2);
    const float* SU = (const float*)(ws + OFF_SU) + (size_t)layer * NEXP;
    const float* SV = (const float*)(ws + OFF_SV) + (size_t)layer * NEXP;
    const bf16_t* PD = (const bf16_t*)(ws + OFF_PD);
    const int n = MTOK * 128;
    for (int i = blockIdx.x * NTH + TID; i < n; i += gridDim.x * NTH) {
        float d = 0.f;
#pragma unroll
        for (int s_ = 0; s_ < 8; ++s_) d += bf2f(PD[(size_t)s_ * n + i]);
        const int e = TI[i];
        TWb[i] = f2bf(TW[i] * SV[e] * gelu_erf(d * (SU[e] * XQ_SCALE)));
    }
}

__device__ __forceinline__ void gatherV_phase(const Params& p, int layer, unsigned char* lds, int rep) {
    const int TID = opaque_tid();
    unsigned char* ws = opaque_ptr(p.ws);
    const unsigned short* TI = (const unsigned short*)(ws + OFF_TI);
    const bf16_t* TW = (const bf16_t*)(ws + OFF_TI + (size_t)MTOK * 128 * 2);
    bf16_t* F = (bf16_t*)(ws + OFF_F);
    unsigned* cnt = (unsigned*)(ws + OFF_BAR) + XCD_BAR_WORDS + (layer * 4 + 2 + rep) * 128;
    const int wave = TID >> 6, lane = TID & 63, e = lane >> 3, c = lane & 7;
    const int own = (int)(gq_xcc_id() & 7u);
    auto process = [&](const int sl, const int tbase, const int ntok) {
        const unsigned char* Vs = ws + OFF_VB + ((size_t)(layer * 8 + sl) * NEXP) * 128;
        int i0 = TI[(size_t)tbase * 128 + lane], i1 = TI[(size_t)tbase * 128 + 64 + lane];
        float w0 = bf2f(TW[(size_t)tbase * 128 + lane]), w1 = bf2f(TW[(size_t)tbase * 128 + 64 + lane]);
        u32x4 vbA[8], vbB[8];
#pragma unroll
        for (int ii = 0; ii < 8; ++ii) { const int ej = __shfl(i0, ii * 8 + e); vbA[ii] = *(const u32x4*)(Vs + (unsigned)(ej * 128 + c * 16)); }
#pragma unroll 1
        for (int i = 0; i < ntok; ++i) {
            const int t = tbase + i, tn = tbase + ((i + 1 < ntok) ? i + 1 : ntok - 1);
#pragma unroll
            for (int ii = 0; ii < 8; ++ii) { const int ej = __shfl(i1, ii * 8 + e); vbB[ii] = *(const u32x4*)(Vs + (unsigned)(ej * 128 + c * 16)); }
            const int n0 = TI[(size_t)tn * 128 + lane], n1 = TI[(size_t)tn * 128 + 64 + lane];
            const float nw0 = bf2f(TW[(size_t)tn * 128 + lane]), nw1 = bf2f(TW[(size_t)tn * 128 + 64 + lane]);
            float acc[16];
#pragma unroll
            for (int j = 0; j < 16; ++j) acc[j] = 0.f;
#pragma unroll
            for (int ii = 0; ii < 8; ++ii) {
                const float wj = __shfl(w0, ii * 8 + e);
#pragma unroll
                for (int q = 0; q < 4; ++q) { CVT8(vbA[ii][q], lo, hi); acc[4 * q] += wj * lo[0]; acc[4 * q + 1] += wj * lo[1]; acc[4 * q + 2] += wj * hi[0]; acc[4 * q + 3] += wj * hi[1]; }
            }
            asm volatile("" ::: "memory");
#pragma unroll
            for (int ii = 0; ii < 8; ++ii) { const int ej = __shfl(n0, ii * 8 + e); vbA[ii] = *(const u32x4*)(Vs + (unsigned)(ej * 128 + c * 16)); }
#pragma unroll
            for (int ii = 0; ii < 8; ++ii) {
                const float wj = __shfl(w1, ii * 8 + e);
#pragma unroll
                for (int q = 0; q < 4; ++q) { CVT8(vbB[ii][q], lo, hi); acc[4 * q] += wj * lo[0]; acc[4 * q + 1] += wj * lo[1]; acc[4 * q + 2] += wj * hi[0]; acc[4 * q + 3] += wj * hi[1]; }
            }
            float r8[8], r4[4], r2[2];
#pragma unroll
            for (int j = 0; j < 8; ++j) { const bool up = lane >= 32; const float snd = up ? acc[j] : acc[j + 8], keep = up ? acc[j + 8] : acc[j]; r8[j] = keep + __shfl_xor(snd, 32); }
#pragma unroll
            for (int j = 0; j < 4; ++j) { const bool up = (lane & 16) != 0; const float snd = up ? r8[j] : r8[j + 4], keep = up ? r8[j + 4] : r8[j]; r4[j] = keep + __shfl_xor(snd, 16); }
#pragma unroll
            for (int j = 0; j < 2; ++j) { const bool up = (lane & 8) != 0; const float snd = up ? r4[j] : r4[j + 2], keep = up ? r4[j + 2] : r4[j]; r2[j] = keep + __shfl_xor(snd, 8); }
            const int col = sl * 128 + c * 16 + ((lane >> 5) & 1) * 8 + ((lane >> 4) & 1) * 4 + ((lane >> 3) & 1) * 2;
            *(unsigned*)(F + (size_t)t * 1024 + col) = cvt_pk_bf16(r2[0], r2[1]);
            w0 = nw0; w1 = nw1; i0 = n0; i1 = n1;
        }
    };
    volatile LDSP unsigned* st_ = (volatile LDSP unsigned*)(lds + LDS_BYTES);
    if (st_[3] != 0u) {
        process(own, 65 * ((int)st_[2] * 4 + wave), 65);
    } else for (;;) {
        const int item = __builtin_amdgcn_readfirstlane(queue_take(cnt, own, (volatile LDSP int*)lds, TID));
        if (item < 0) break;
        process(item / GQ_PER_SLICE, (item % GQ_PER_SLICE) * (4 * GQ_TW) + wave * GQ_TW, GQ_TW);
    }
}

#define XB_TMO      128
#define XB_XCNT(j)  (256  + 64 * (j))
#define XB_XSUB(j)  (1280 + 64 * (j))
#define XB_XGEN(j)  (2304 + 64 * (j))
#define XB_TOP      3328
#define XB_TOPGEN   3392
#define XB_SPIN_CAP (1u << 22)
__device__ __forceinline__ unsigned xb_ld(unsigned* p)              { return __hip_atomic_load(p, __ATOMIC_RELAXED, __HIP_MEMORY_SCOPE_AGENT); }
__device__ __forceinline__ unsigned xb_add(unsigned* p, unsigned v) { return __hip_atomic_fetch_add(p, v, __ATOMIC_RELAXED, __HIP_MEMORY_SCOPE_AGENT); }
__device__ __forceinline__ unsigned xb_xcc_id() { return (unsigned)__builtin_amdgcn_s_getreg((3 << 11) | 20) & 0xFu; }
#define XB_SPIN(cond, bar) do { unsigned _sp = 0; while (cond) { __builtin_amdgcn_s_sleep(1); \
    if ((++_sp & 255u) == 0u) { if (xb_ld(&(bar)[XB_TMO])) break; if (_sp > XB_SPIN_CAP) { atomicAdd(&(bar)[XB_TMO], 1u); break; } } } } while (0)
struct XcdBarrier { unsigned* bar; unsigned x; volatile LDSP unsigned* st; };
__device__ __forceinline__ XcdBarrier xcd_barrier_post(unsigned* bar, volatile LDSP unsigned* st) {
    XcdBarrier b; b.bar = bar; b.x = xb_xcc_id(); b.st = st;
    if (threadIdx.x == 0) st[2] = xb_add(&bar[XB_XCNT(b.x)], 1u);
    return b;
}
__device__ __forceinline__ void xcd_barrier_complete(unsigned* bar, unsigned x, unsigned& nloc, unsigned& nx, unsigned& balanced) {
    const unsigned G = gridDim.x * gridDim.y * gridDim.z;
    unsigned sum, cnt, mine, sp = 0u;
    for (;;) {
        sum = 0u; cnt = 0u; mine = 0u;
#pragma unroll
        for (unsigned j = 0; j < 16; ++j) { const unsigned c = xb_ld(&bar[XB_XCNT(j)]); sum += c; cnt += (c > 0u) ? 1u : 0u; mine = (j == x) ? c : mine; }
        if (sum == G) break;
        __builtin_amdgcn_s_sleep(1);
        if ((++sp & 255u) == 0u) { if (xb_ld(&bar[XB_TMO])) break; if (sp > XB_SPIN_CAP) { atomicAdd(&bar[XB_TMO], 1u); break; } }
    }
    nloc = mine > 0u ? mine : 1u; nx = cnt > 0u ? cnt : 1u;
    unsigned ok = 1u;
#pragma unroll
    for (unsigned j = 0; j < 8; ++j) ok &= (xb_ld(&bar[XB_XCNT(j)]) == 64u) ? 1u : 0u;
    balanced = (ok && G == 512u) ? 1u : 0u;
}
__device__ __forceinline__ void xcd_barrier(const XcdBarrier& b) {
    asm volatile("s_waitcnt vmcnt(0)" ::: "memory");
    __syncthreads();
    if (threadIdx.x == 0) {
        unsigned* bar = b.bar;
        __builtin_amdgcn_s_waitcnt(0);
        unsigned nloc = b.st[0], nx = b.st[1];
        if (nloc == 0u) { unsigned bal; xcd_barrier_complete(bar, b.x, nloc, nx, bal); b.st[0] = nloc; b.st[1] = nx; b.st[3] = bal; }
        const unsigned old = xb_add(&bar[XB_XSUB(b.x)], 1u);
        const unsigned gen = old / nloc;
        if (old + 1u == (gen + 1u) * nloc) {
            __builtin_amdgcn_fence(__ATOMIC_RELEASE, "agent");
            asm volatile("s_waitcnt vmcnt(0)" ::: "memory");
            const unsigned og = xb_add(&bar[XB_TOP], 1u);
            const unsigned tg = og / nx;
            if (og + 1u == (tg + 1u) * nx) xb_add(&bar[XB_TOPGEN], 1u);
            else XB_SPIN(xb_ld(&bar[XB_TOPGEN]) == tg, bar);
            __builtin_amdgcn_fence(__ATOMIC_ACQUIRE, "agent");
            xb_add(&bar[XB_XGEN(b.x)], 1u);
            asm volatile("s_waitcnt vmcnt(0)" ::: "memory");
        } else {
            XB_SPIN(xb_ld(&bar[XB_XGEN(b.x)]) == gen, bar);
            __builtin_amdgcn_fence(__ATOMIC_ACQUIRE, "agent");
            asm volatile("s_waitcnt vmcnt(0)" ::: "memory");
        }
    }
    __syncthreads();
}

constexpr int NSUB = 13;
constexpr int NPHASE = 1 + 4 * NSUB;
static_assert(OFF_DF + (size_t)NCHUNK_MAX * 128 * 4 <= OFF_KF, "chunk record overlay overflow");
static_assert(WS_NEED <= (size_t)940 * 1024 * 1024, "workspace map exceeds the guaranteed workspace (sum of inputs = 946 MiB)");

__device__ __forceinline__ void run_phase(const Params& p, int ph, unsigned char* lds, bool dry) {
    unsigned char* ws = opaque_ptr(p.ws);
    if (ph == 0) { phase_prologue(p, (float*)lds); return; }
    const int layer = (ph - 1) / NSUB, pos = (ph - 1) % NSUB;
    const int sub = (pos < 2) ? pos : (pos == 2) ? 9 : (pos < 10) ? pos - 1 : pos;
    const bf16_t* Hb = (const bf16_t*)(ws + OFF_HB);
    switch (sub) {
    case 0: {
        const int wrow = (layer == 0) ? WIN_ROWS0 : (layer == 1) ? WIN_ROWS1 : (layer == 2) ? WIN_ROWS2 : WIN_ROWS3;
        const int nmain = (layer == 3) ? 3072 : 4096;
        const bool sk_first = ((blockIdx.x >> 8) & 1) == 0;
        if (layer > 0 && sk_first) skinny16_phase((const bf16_t*)(ws + OFF_WIN) + (size_t)(wrow + 3072) * 1024, Hb, (float*)(ws + OFF_PG), 16);
        gemm130_phase<true>((const bf16_t*)(ws + OFF_WIN) + (size_t)wrow * 1024, Hb, ws + OFF_P, PLD, nmain, 1024, lds, LnEpi{}, (layer == 1 || layer == 2) ? 3072 : (1 << 30));
        if (layer > 0 && !sk_first) skinny16_phase((const bf16_t*)(ws + OFF_WIN) + (size_t)(wrow + 3072) * 1024, Hb, (float*)(ws + OFF_PG), 16);
    } break;
    case 1:
        if (layer == 0) scanA_phase<0>(p, (float*)lds); else if (layer == 1) scanA_phase<1>(p, (float*)lds);
        else if (layer == 2) scanA_phase<2>(p, (float*)lds); else scanA_phase<3>(p, (float*)lds);
        break;
    case 9:
#if PROBE_LITE
        if (dry) { if (layer == 0) seq_phase<0, true>(p, lds); else if (layer == 3) seq_phase<3, true>(p, lds); break; }
#endif
        if (layer == 0) seq_phase<0>(p, lds); else if (layer == 1) seq_phase<1>(p, lds);
        else if (layer == 2) seq_phase<2>(p, lds); else seq_phase<3>(p, lds);
        break;
    case 2:
        if (layer == 0) normgate_phase<0>(p); else if (layer == 1) normgate_phase<1>(p);
        else if (layer == 2) normgate_phase<2>(p); else normgate_phase<3>(p);
        break;
    case 3:
        if (gridDim.x >= 512 && !dry) {
            LnEpi le; le.H = (float*)(ws + OFF_H); le.Hb = (bf16_t*)(ws + OFF_HB); le.Hq = ws + OFF_HQ; le.g = p.in[35] + (size_t)(layer * 2) * 1024; le.b = p.in[36] + (size_t)(layer * 2) * 1024;
            le.xch = (unsigned long long*)(ws + OFF_XCH) + (size_t)layer * 128 * 4 * 144; le.cnt = (unsigned*)(ws + OFF_BAR) + XCD_BAR_WORDS + 2048 + layer * 128;
            gemm130_phase<false, true>((const bf16_t*)(ws + OFF_WOUT) + (size_t)layer * 1024 * 1024, (const bf16_t*)(ws + OFF_A2), nullptr, 1024, 1024, 1024, lds, le);
        } else gemm130_phase<false>((const bf16_t*)(ws + OFF_WOUT) + (size_t)layer * 1024 * 1024, (const bf16_t*)(ws + OFF_A2), ws + OFF_O, 1024, 1024, 1024, lds);
        break;
    case 4: if (gridDim.x < 512) ln_phase(p, layer, 0, dry); break;
    case 5:
        gemm130_phase<true>((const bf16_t*)(ws + OFF_WQ) + (size_t)layer * 2048 * 1024, Hb, ws + OFF_Q, 2048, 2048, 1024, lds);
        break;
    case 6: break;
    case 7: scoretopk_phase(p, layer, lds); break;
    case 8: gatherU_phase(p, layer, lds, dry ? 1 : 0); break;
    case 10: if (!dry) gatherW_phase(p, layer); break;
    case 11: gatherV_phase(p, layer, lds, dry ? 1 : 0); break;
    case 12: ln_phase(p, layer, 1, dry); break;
    }
}

__global__ void __launch_bounds__(NTH, 2) mega_kernel(Params p, int ph_lo, int ph_hi) {
    __shared__ __attribute__((aligned(16))) unsigned char lds[LDS_BYTES + 16];
    cg::grid_group grid = cg::this_grid();
    volatile LDSP unsigned* st = (volatile LDSP unsigned*)(lds + LDS_BYTES);
    if (threadIdx.x < 4) st[threadIdx.x] = 0u;
    if (ph_lo == 0 && blockIdx.x == 0) {
        unsigned* bw = (unsigned*)(p.ws + OFF_BAR);
        for (int i = threadIdx.x; i < XCD_BAR_WORDS + 2048 + 512; i += NTH) bw[i] = 0u;
    }
    __syncthreads();
    XcdBarrier xb{};
    if (ph_lo != 0) xb = xcd_barrier_post((unsigned*)(p.ws + OFF_BAR), st);
    for (int ph = ph_lo; ph < ph_hi; ++ph) {
        if (ph > 0 && (ph - 1) % NSUB == 5 && gridDim.x >= 512) continue;
        if (ph > 0 && (ph - 1) % NSUB == 7) continue;
        int reps = 1;
#if PROBE_MASK
        if (ph > 0 && ((PROBE_MASK >> ((ph - 1) % NSUB)) & 1)) reps = 2;
        if (ph == 0 && (PROBE_MASK & 8192)) reps = 2;
#endif
        for (int rep = 0; rep < reps; ++rep) {
            if (rep) xcd_barrier(xb);
            run_phase(p, ph, lds, rep > 0);
        }
        if (ph + 1 < ph_hi) { if (ph == ph_lo) { grid.sync(); if (ph_lo == 0) xb = xcd_barrier_post((unsigned*)(p.ws + OFF_BAR), st); } else xcd_barrier(xb); }
#if PROBE_BARRIERS
        if (ph == 7) { for (int k_ = 0; k_ < PROBE_BARRIERS; ++k_) xcd_barrier(xb); }
#endif
    }
}

extern "C" void kernel_launch(void* const* d_in, const int* in_sizes, int n_in, void* d_out, int out_size, void* d_ws, size_t ws_size, hipStream_t stream) {
    static int grid_blocks = 0;
    if (!grid_blocks) {
        int dev = 0, cus = 0, per_cu = 0;
        hipGetDevice(&dev);
        hipDeviceGetAttribute(&cus, hipDeviceAttributeMultiprocessorCount, dev);
        hipOccupancyMaxActiveBlocksPerMultiprocessor(&per_cu, mega_kernel, NTH, 0);
        if (per_cu > 2) per_cu = 2;
        if (per_cu < 1) per_cu = 1;
        grid_blocks = cus * per_cu;
    }
    if (ws_size < WS_NEED) { fprintf(stderr, "workspace too small: %zu < %zu\n", ws_size, (size_t)WS_NEED); return; }
    if ((size_t)out_size != OUT_TOTAL) fprintf(stderr, "unexpected out_size %d vs %zu\n", out_size, (size_t)OUT_TOTAL);
    Params p{};
    for (int i = 0; i < 37; ++i) p.in[i] = (const float*)d_in[i];
    p.out = (float*)d_out;
    p.ws = (unsigned char*)d_ws;
#if SINGLE_LAUNCH
    int lo = 0, hi = NPHASE;
    void* args[] = {&p, &lo, &hi};
    hipError_t e = hipLaunchCooperativeKernel((void*)mega_kernel, dim3(grid_blocks), dim3(NTH), args, 0, stream);
    if (e != hipSuccess) fprintf(stderr, "cooperative launch failed: %s (grid %d)\n", hipGetErrorString(e), grid_blocks);
#else
    for (int ph = 0; ph < NPHASE; ++ph) mega_kernel<<<grid_blocks, NTH, 0, stream>>>(p, ph, ph + 1);
#endif
}
```
